# Optimizing an MI355X kernel written in HIP

```python
import math
import jax
import jax.numpy as jnp
from jax import lax
import numpy as np

D_MODEL = 1024
BATCH = 8
SEQ = 8192
DEPTH = 4

CTX_LEN = 256
GRID_W = 64
ROPE_BASE = 10000.0
NORM_EPS = 1e-6

MLA_HEADS = 6
MLA_NOPE = 64
MLA_ROPE = 32
MLA_QK = MLA_NOPE + MLA_ROPE
MLA_V = 64
MLA_Q_RANK = 384
MLA_KV_RANK = 256
DENSE_BLOCK = 128

S5_GROUPS = 16
S5_GROUP_CH = 16
S5_CH = S5_GROUPS * S5_GROUP_CH
S5_STATE = 64

SWA_HEADS = 6
SWA_KV_HEADS = 2
SWA_HEAD_DIM = 64
SWA_WINDOW = 128
SWA_BLOCK = 128

MIX_W = MLA_HEADS * MLA_V + S5_CH + SWA_HEADS * SWA_HEAD_DIM
IN_SPLITS = (MLA_Q_RANK, MLA_KV_RANK, MLA_ROPE, S5_CH,
             SWA_HEADS * SWA_HEAD_DIM, SWA_KV_HEADS * SWA_HEAD_DIM, SWA_KV_HEADS * SWA_HEAD_DIM)
IN_W = sum(IN_SPLITS)
IN_OFFSETS = tuple(int(o) for o in np.cumsum(IN_SPLITS)[:-1])

D_FF = 2816

kernel_name = 'hybrid_mla_s5_swa_diffusion_trunk'

F32 = jnp.float32


def rms_norm(x, g):
    xf = x.astype(F32)
    y = xf * lax.rsqrt(jnp.mean(xf * xf, axis=-1, keepdims=True) + NORM_EPS)
    return (y * g.astype(F32)).astype(x.dtype)


def axial_rope_tables(rows, cols, rot_dim):
    n_freq = rot_dim // 4
    inv = ROPE_BASE ** (-jnp.arange(n_freq, dtype=F32) / n_freq)
    ang = jnp.concatenate([rows.astype(F32)[:, None] * inv[None, :],
                           cols.astype(F32)[:, None] * inv[None, :]], axis=-1)
    return jnp.cos(ang), jnp.sin(ang)


def apply_rope(x, tables):
    cos, sin = tables
    cos = cos[None, :, None, :].astype(x.dtype)
    sin = sin[None, :, None, :].astype(x.dtype)
    x1, x2 = jnp.split(x, 2, axis=-1)
    return jnp.concatenate([x1 * cos - x2 * sin, x1 * sin + x2 * cos], axis=-1)


def mla_queries(c_q, g_lora, w_uq, g_qk, rope):
    b, t, _ = c_q.shape
    q = (rms_norm(c_q, g_lora) @ w_uq).reshape(b, t, MLA_HEADS, MLA_QK)
    q = rms_norm(q, g_qk)
    if rope is not None:
        q = jnp.concatenate([q[..., :MLA_NOPE], apply_rope(q[..., MLA_NOPE:], rope)], axis=-1)
    return q


def mla_keys_values(c_kv, k_rope, g_lora, w_ukv, g_qk, rope):
    b, t, _ = c_kv.shape
    kv = (rms_norm(c_kv, g_lora) @ w_ukv).reshape(b, t, MLA_HEADS, MLA_NOPE + MLA_V)
    k_nope, v = kv[..., :MLA_NOPE], kv[..., MLA_NOPE:]
    k_r = jnp.broadcast_to(k_rope[:, :, None, :], (b, t, MLA_HEADS, MLA_ROPE))
    k = rms_norm(jnp.concatenate([k_nope, k_r], axis=-1), g_qk)
    if rope is not None:
        k = jnp.concatenate([k[..., :MLA_NOPE], apply_rope(k[..., MLA_NOPE:], rope)], axis=-1)
    return k, v


def mla_latent_attention(q, k_lat, v_lat, k_ctx, v_ctx):
    b, t, h, _ = q.shape
    keys = jnp.concatenate([k_lat, k_ctx], axis=1)
    vals = jnp.concatenate([v_lat, v_ctx], axis=1)
    n_blk = t // DENSE_BLOCK
    q_blocks = jnp.moveaxis(q.reshape(b, n_blk, DENSE_BLOCK, h, MLA_QK), 1, 0)

    def one_block(qb):
        s = jnp.einsum('bqhd,bkhd->bhqk', qb, keys).astype(F32) * (MLA_QK ** -0.5)
        p = jax.nn.softmax(s, axis=-1).astype(vals.dtype)
        return jnp.einsum('bhqk,bkhd->bqhd', p, vals)

    out = lax.map(one_block, q_blocks)
    return jnp.moveaxis(out, 0, 1).reshape(b, t, h * MLA_V)


def mla_context_attention(q, k, v):
    b, t, h, _ = q.shape
    s = jnp.einsum('bqhd,bkhd->bhqk', q, k).astype(F32) * (MLA_QK ** -0.5)
    p = jax.nn.softmax(s, axis=-1).astype(v.dtype)
    return jnp.einsum('bhqk,bkhd->bqhd', p, v).reshape(b, t, h * MLA_V)


def s5_discretize(a_re, a_im, log_dt, b_re, b_im):
    lam = lax.complex(a_re.astype(F32), a_im.astype(F32))
    dt = jnp.exp(log_dt.astype(F32))[:, None]
    a_bar = jnp.exp(lam * dt)
    b_mat = lax.complex(b_re.astype(F32), b_im.astype(F32))
    b_bar = ((a_bar - 1.0) / lam)[:, :, None] * b_mat
    return a_bar, b_bar


def _linear_recurrence_combine(e1, e2):
    a1, b1 = e1
    a2, b2 = e2
    return a1 * a2, a2[:, None] * b1 + b2


def s5_scan(u, a_bar, b_bar, h0, reverse):
    bu = jnp.einsum('btgh,gph->tbgp', u.astype(jnp.complex64), b_bar)
    if h0 is not None:
        bu = bu.at[-1 if reverse else 0].add(a_bar * h0)
    a = jnp.broadcast_to(a_bar, (bu.shape[0],) + a_bar.shape)
    _, h = lax.associative_scan(_linear_recurrence_combine, (a, bu), reverse=reverse, axis=0)
    return h


def s5_readout(h, c_mat):
    return jnp.real(jnp.einsum('tbgp,ghp->btgh', h, c_mat))


def s5_bidirectional(u_lat, u_ctx, a_re, a_im, log_dt, b_re, b_im, c_re, c_im, d_skip, w_glu, b_glu,
                     need_ctx):
    b, t, _ = u_lat.shape
    n_ctx = u_ctx.shape[1]
    ul = u_lat.astype(F32)
    uc = u_ctx.astype(F32)
    ul_g = ul.reshape(b, t, S5_GROUPS, S5_GROUP_CH)
    uc_g = uc.reshape(b, n_ctx, S5_GROUPS, S5_GROUP_CH)
    d32 = d_skip.astype(F32)
    y_lat = d32 * ul
    y_ctx = d32 * uc if need_ctx else None
    for direction in range(2):
        reverse = direction == 1
        a_bar, b_bar = s5_discretize(a_re[direction], a_im[direction], log_dt[direction],
                                     b_re[direction], b_im[direction])
        c_mat = lax.complex(c_re[direction].astype(F32), c_im[direction].astype(F32))
        h_ctx = s5_scan(uc_g, a_bar, b_bar, None, reverse)
        h0 = h_ctx[0] if reverse else h_ctx[-1]
        h_lat = s5_scan(ul_g, a_bar, b_bar, h0, reverse)
        y_lat = y_lat + s5_readout(h_lat, c_mat).reshape(b, t, S5_CH)
        if need_ctx:
            y_ctx = y_ctx + s5_readout(h_ctx, c_mat).reshape(b, n_ctx, S5_CH)

    def half_glu(y):
        z = jax.nn.gelu(y)
        return z * jax.nn.sigmoid(z @ w_glu.astype(F32) + b_glu.astype(F32))

    out_lat = half_glu(y_lat).astype(u_lat.dtype)
    out_ctx = half_glu(y_ctx).astype(u_ctx.dtype) if need_ctx else None
    return out_lat, out_ctx


def swa_queries(q_raw, g_qk, rope):
    b, t, _ = q_raw.shape
    q = rms_norm(q_raw.reshape(b, t, SWA_HEADS, SWA_HEAD_DIM), g_qk)
    return apply_rope(q, rope) if rope is not None else q


def swa_keys_values(k_raw, v_raw, g_qk, rope):
    b, t, _ = k_raw.shape
    k = rms_norm(k_raw.reshape(b, t, SWA_KV_HEADS, SWA_HEAD_DIM), g_qk)
    if rope is not None:
        k = apply_rope(k, rope)
    return k, v_raw.reshape(b, t, SWA_KV_HEADS, SWA_HEAD_DIM)


def swa_latent_attention(q, k, v, k_ctx, v_ctx, sink):
    b, t, h, d = q.shape
    blk = SWA_BLOCK
    n_blk = t // blk
    rep = h // SWA_KV_HEADS
    n_ctx = k_ctx.shape[1]
    qb = q.reshape(b, n_blk, blk, SWA_KV_HEADS, rep, d)

    def band(z):
        zp = jnp.pad(z, ((0, 0), (blk, blk), (0, 0), (0, 0))).reshape(b, n_blk + 2, blk, SWA_KV_HEADS, d)
        return jnp.concatenate([zp[:, :-2], zp[:, 1:-1], zp[:, 2:]], axis=2)

    kb, vb = band(k), band(v)
    q_pos = jnp.arange(n_blk)[:, None] * blk + jnp.arange(blk)[None, :]
    k_pos = jnp.arange(n_blk)[:, None] * blk - blk + jnp.arange(3 * blk)[None, :]
    rel = k_pos[:, None, :] - q_pos[:, :, None]
    valid = (jnp.abs(rel) <= SWA_WINDOW) & (k_pos[:, None, :] >= 0) & (k_pos[:, None, :] < t)
    scale = d ** -0.5
    s_band = jnp.einsum('bnqgrd,bnkgd->bngrqk', qb, kb).astype(F32) * scale
    s_band = jnp.where(valid[None, :, None, None], s_band, -jnp.inf)
    s_ctx = jnp.einsum('bnqgrd,blgd->bngrql', qb, k_ctx).astype(F32) * scale
    s_sink = jnp.broadcast_to(sink.astype(F32).reshape(SWA_KV_HEADS, rep)[None, None, :, :, None, None],
                              s_ctx.shape[:-1] + (1,))
    p = jax.nn.softmax(jnp.concatenate([s_sink, s_ctx, s_band], axis=-1), axis=-1).astype(v.dtype)
    out = (jnp.einsum('bngrql,blgd->bnqgrd', p[..., 1:1 + n_ctx], v_ctx)
           + jnp.einsum('bngrqk,bnkgd->bnqgrd', p[..., 1 + n_ctx:], vb))
    return out.reshape(b, t, h * d)


def swa_context_attention(q, k, v, sink):
    b, t, h, d = q.shape
    rep = h // SWA_KV_HEADS
    qg = q.reshape(b, t, SWA_KV_HEADS, rep, d)
    s = jnp.einsum('bqgrd,bkgd->bgrqk', qg, k).astype(F32) * (d ** -0.5)
    s_sink = jnp.broadcast_to(sink.astype(F32).reshape(SWA_KV_HEADS, rep)[None, :, :, None, None],
                              s.shape[:-1] + (1,))
    p = jax.nn.softmax(jnp.concatenate([s_sink, s], axis=-1), axis=-1)[..., 1:].astype(v.dtype)
    return jnp.einsum('bgrqk,bkgd->bqgrd', p, v).reshape(b, t, h * d)


def conv_ffn(h, w_up, conv_w, conv_b, w_down):
    u = h @ w_up
    up = jnp.pad(u, ((0, 0), (1, 1), (0, 0)))
    u = up[:, :-2] * conv_w[0] + up[:, 1:-1] * conv_w[1] + up[:, 2:] * conv_w[2] + conv_b
    a, g = jnp.split(u, 2, axis=-1)
    return (jax.nn.silu(g) * a) @ w_down


def setup_inputs(seed: int = 0) -> dict:
    key = jax.random.key(seed)
    keys = iter(jax.random.split(key, 48))

    def nrm(shape, scale):
        return scale * jax.random.normal(next(keys), shape, F32)

    L, D = DEPTH, D_MODEL
    G, P, Hg = S5_GROUPS, S5_STATE, S5_GROUP_CH
    state_idx = jnp.arange(P, dtype=F32)
    return {
        'x': nrm((BATCH, SEQ, D), 1.0),
        'c': nrm((BATCH, D), 1.0),
        'ctx': nrm((BATCH, CTX_LEN, D), 1.0),
        'c_ctx': nrm((D,), 1.0),
        'w_mod': nrm((L, D, 6 * D), 0.5 * D ** -0.5),
        'b_mod': nrm((L, 6 * D), 0.01),
        'norm1': 1.0 + nrm((L, D), 0.1),
        'w_in': nrm((L, D, IN_W), D ** -0.5),
        'mla_q_lora_g': 1.0 + nrm((L, MLA_Q_RANK), 0.1),
        'mla_w_uq': nrm((L, MLA_Q_RANK, MLA_HEADS * MLA_QK), MLA_Q_RANK ** -0.5),
        'mla_kv_lora_g': 1.0 + nrm((L, MLA_KV_RANK), 0.1),
        'mla_w_ukv': nrm((L, MLA_KV_RANK, MLA_HEADS * (MLA_NOPE + MLA_V)), MLA_KV_RANK ** -0.5),
        'mla_q_norm': 1.0 + nrm((L, MLA_QK), 0.1),
        'mla_k_norm': 1.0 + nrm((L, MLA_QK), 0.1),
        's5_a_re': -0.5 + nrm((L, 2, G, P), 0.01),
        's5_a_im': math.pi * state_idx + nrm((L, 2, G, P), 0.01),
        's5_log_dt': jax.random.uniform(next(keys), (L, 2, G), F32, math.log(1e-3), math.log(1e-1)),
        's5_b_re': nrm((L, 2, G, P, Hg), (2 * Hg) ** -0.5),
        's5_b_im': nrm((L, 2, G, P, Hg), (2 * Hg) ** -0.5),
        's5_c_re': nrm((L, 2, G, Hg, P), P ** -0.5),
        's5_c_im': nrm((L, 2, G, Hg, P), P ** -0.5),
        's5_d': nrm((L, S5_CH), 1.0),
        's5_w_glu': nrm((L, S5_CH, S5_CH), S5_CH ** -0.5),
        's5_b_glu': nrm((L, S5_CH), 0.01),
        'swa_q_norm': 1.0 + nrm((L, SWA_HEAD_DIM), 0.1),
        'swa_k_norm': 1.0 + nrm((L, SWA_HEAD_DIM), 0.1),
        'swa_sink': nrm((L, SWA_HEADS), 0.5),
        'w_out': nrm((L, MIX_W, D), MIX_W ** -0.5),
        'norm2': 1.0 + nrm((L, D), 0.1),
        'w_up': nrm((L, D, 2 * D_FF), D ** -0.5),
        'conv_w': jnp.array([0.0, 1.0, 0.0], F32)[None, :, None] + nrm((L, 3, 2 * D_FF), 0.2),
        'conv_b': nrm((L, 2 * D_FF), 0.01),
        'w_down': nrm((L, D_FF, D), D_FF ** -0.5),
    }


def reference(x, c, ctx, c_ctx, w_mod, b_mod, norm1, w_in, mla_q_lora_g, mla_w_uq, mla_kv_lora_g,
              mla_w_ukv, mla_q_norm, mla_k_norm, s5_a_re, s5_a_im, s5_log_dt, s5_b_re, s5_b_im,
              s5_c_re, s5_c_im, s5_d, s5_w_glu, s5_b_glu, swa_q_norm, swa_k_norm, swa_sink, w_out,
              norm2, w_up, conv_w, conv_b, w_down):
    n_lat = x.shape[1]
    ROWS = n_lat // GRID_W
    rows = jnp.repeat(jnp.arange(ROWS), GRID_W)
    cols = jnp.tile(jnp.arange(GRID_W), ROWS)
    rope_mla = axial_rope_tables(rows, cols, MLA_ROPE)
    rope_swa = axial_rope_tables(rows, cols, SWA_HEAD_DIM)

    s_lat = jax.nn.silu(c)[:, None, :]
    s_ctx = jax.nn.silu(c_ctx)
    x_lat, x_ctx = x, ctx
    for l in range(DEPTH):
        need_ctx = l < DEPTH - 1
        sh1, sc1, g1, sh2, sc2, g2 = jnp.split(s_lat @ w_mod[l] + b_mod[l], 6, axis=-1)
        csh1, csc1, cg1, csh2, csc2, cg2 = jnp.split(s_ctx @ w_mod[l] + b_mod[l], 6, axis=-1)

        h_lat = rms_norm(x_lat, norm1[l]) * (1.0 + sc1) + sh1
        h_ctx = rms_norm(x_ctx, norm1[l]) * (1.0 + csc1) + csh1
        cq_l, ckv_l, kr_l, u_l, qs_l, ks_l, vs_l = jnp.split(h_lat @ w_in[l], IN_OFFSETS, axis=-1)
        cq_c, ckv_c, kr_c, u_c, qs_c, ks_c, vs_c = jnp.split(h_ctx @ w_in[l], IN_OFFSETS, axis=-1)

        qa = mla_queries(cq_l, mla_q_lora_g[l], mla_w_uq[l], mla_q_norm[l], rope_mla)
        ka, va = mla_keys_values(ckv_l, kr_l, mla_kv_lora_g[l], mla_w_ukv[l], mla_k_norm[l], rope_mla)
        ka_c, va_c = mla_keys_values(ckv_c, kr_c, mla_kv_lora_g[l], mla_w_ukv[l], mla_k_norm[l], None)
        ya = mla_latent_attention(qa, ka, va, ka_c, va_c)

        yb, yb_c = s5_bidirectional(u_l, u_c, s5_a_re[l], s5_a_im[l], s5_log_dt[l], s5_b_re[l], s5_b_im[l],
                                    s5_c_re[l], s5_c_im[l], s5_d[l], s5_w_glu[l], s5_b_glu[l], need_ctx)

        qs = swa_queries(qs_l, swa_q_norm[l], rope_swa)
        ks, vs = swa_keys_values(ks_l, vs_l, swa_k_norm[l], rope_swa)
        ks_cc, vs_cc = swa_keys_values(ks_c, vs_c, swa_k_norm[l], None)
        yc = swa_latent_attention(qs, ks, vs, ks_cc, vs_cc, swa_sink[l])

        x_lat = x_lat + g1 * (jnp.concatenate([ya, yb, yc], axis=-1) @ w_out[l])
        if need_ctx:
            qa_c = mla_queries(cq_c, mla_q_lora_g[l], mla_w_uq[l], mla_q_norm[l], None)
            ya_c = mla_context_attention(qa_c, ka_c, va_c)
            qs_cc = swa_queries(qs_c, swa_q_norm[l], None)
            yc_c = swa_context_attention(qs_cc, ks_cc, vs_cc, swa_sink[l])
            x_ctx = x_ctx + cg1 * (jnp.concatenate([ya_c, yb_c, yc_c], axis=-1) @ w_out[l])

        h_lat = rms_norm(x_lat, norm2[l]) * (1.0 + sc2) + sh2
        x_lat = x_lat + g2 * conv_ffn(h_lat, w_up[l], conv_w[l], conv_b[l], w_down[l])
        if need_ctx:
            h_ctx = rms_norm(x_ctx, norm2[l]) * (1.0 + csc2) + csh2
            x_ctx = x_ctx + cg2 * conv_ffn(h_ctx, w_up[l], conv_w[l], conv_b[l], w_down[l])
    return x_lat
```

```cpp
#include <hip/hip_runtime.h>
#include <hip/hip_cooperative_groups.h>
#include <cstdio>
#include <cstdint>
namespace cg = cooperative_groups;

typedef unsigned short u16;
typedef short bf16x8 __attribute__((ext_vector_type(8)));
typedef short s16x4 __attribute__((ext_vector_type(4)));
typedef float f32x16 __attribute__((ext_vector_type(16)));
typedef float f32x4 __attribute__((ext_vector_type(4)));
typedef float f32x2 __attribute__((ext_vector_type(2)));
typedef unsigned u32x4 __attribute__((ext_vector_type(4)));
typedef unsigned u32x2 __attribute__((ext_vector_type(2)));
typedef __bf16 bf16x2_t __attribute__((ext_vector_type(2)));
#define DI __device__ __forceinline__
#define LAS __attribute__((address_space(3)))

constexpr int DM = 1024, NBATCH = 8, TLAT = 8192, NLAYER = 4, TCTX = 256;
constexpr int MLAT = NBATCH * TLAT, MCTX = NBATCH * TCTX, MTOT = MLAT + MCTX;
constexpr int PROJ_LD = 928, DFF = 2816;
constexpr float EPS = 1e-6f, LOG2E = 1.4426950408889634f;
constexpr int NTHREADS = 512;
constexpr int PITCH = 144;
constexpr int LDS_SCR = 2048;
constexpr int LDS_TOTAL = LDS_SCR + 256 * 528;

constexpr size_t al256(size_t x) { return (x + 255) / 256 * 256; }
constexpr size_t OFF_CTXX = 0;
constexpr size_t OFF_MOD = OFF_CTXX + (size_t)MCTX * DM * 4;
constexpr size_t OFF_ROPE = OFF_MOD + al256((size_t)NLAYER * 9 * 6144 * 4);
constexpr size_t ROPE_COSA = 0, ROPE_SINA = (size_t)TLAT * 16 * 4, ROPE_COSS = 2 * ROPE_SINA, ROPE_SINS = ROPE_COSS + (size_t)TLAT * 32 * 4;
constexpr size_t OFF_S5PW = OFF_ROPE + 2 * (size_t)TLAT * 16 * 4 + 2 * (size_t)TLAT * 32 * 4;
constexpr size_t OFF_S5Q = OFF_S5PW + (size_t)NLAYER * 2 * 16 * 64 * 65 * 16;
constexpr size_t OFF_W = OFF_S5Q + (size_t)NLAYER * 2 * 16 * 64 * 16;
constexpr size_t W_IN = 0, W_OUT = W_IN + (size_t)1664 * 1024, W_UP = W_OUT + (size_t)1024 * 1024, W_DN = W_UP + (size_t)5632 * 1024,
                 W_UQ = W_DN + (size_t)1024 * 2816, W_UKV = W_UQ + (size_t)576 * 384, W_GLU = W_UKV + (size_t)768 * 256, W_LAYER = W_GLU + (size_t)256 * 256;
constexpr size_t OFF_S5T = OFF_W + (size_t)NLAYER * W_LAYER * 2;
constexpr size_t S5_KC = 0, S5_BST = S5_KC + (size_t)16 * 127 * 256, S5_MRD = S5_BST + (size_t)16 * 256 * 1024, S5_LAYER = S5_MRD + (size_t)16 * 1024 * 256;
constexpr size_t OFF_H = OFF_S5T + (size_t)NLAYER * S5_LAYER * 2;
constexpr size_t OFF_MIX = OFF_H + (size_t)MTOT * 1024 * 2;
constexpr size_t OFF_SST = OFF_MIX + (size_t)MTOT * 1024 * 2;
constexpr size_t OFF_HIN = OFF_SST + (size_t)1056 * 16 * 256 * 4;
constexpr size_t OFF_ZB = OFF_HIN + (size_t)1056 * 16 * 256 * 2;
constexpr size_t OFF_BIG = OFF_ZB + (size_t)MTOT * 256 * 2;
constexpr size_t OFF_PROJ = OFF_BIG;
constexpr size_t OFF_QM = OFF_PROJ + (size_t)MTOT * PROJ_LD * 2;
constexpr size_t OFF_KM = OFF_QM + (size_t)MTOT * 576 * 2;
constexpr size_t OFF_VM = OFF_KM + (size_t)MTOT * 576 * 2;
constexpr size_t OFF_QS = OFF_VM + (size_t)MTOT * 384 * 2;
constexpr size_t OFF_KS = OFF_QS + (size_t)MTOT * 384 * 2;
constexpr size_t OFF_VS = OFF_KS + (size_t)MTOT * 128 * 2;
constexpr size_t OFF_END1 = OFF_VS + (size_t)MTOT * 128 * 2;
constexpr size_t OFF_ACT = OFF_BIG;
constexpr size_t OFF_END2 = OFF_ACT + (size_t)MTOT * DFF * 2;
constexpr size_t OFF_ZERO = OFF_END1 > OFF_END2 ? OFF_END1 : OFF_END2;
constexpr size_t WS_NEED = OFF_ZERO + 8192;

struct P {
  const float *x, *c, *ctx, *c_ctx, *w_mod, *b_mod, *norm1, *w_in, *q_lora_g, *w_uq, *kv_lora_g, *w_ukv, *q_norm, *k_norm, *a_re, *a_im, *log_dt, *b_re, *b_im, *c_re,
      *c_im, *s5_d, *w_glu, *b_glu, *sq_norm, *sk_norm, *sink, *w_out, *norm2, *w_up, *conv_w, *conv_b, *w_down;
  float* out;
  char* ws;
};

DI unsigned pk2(float a, float b) { f32x2 v = {a, b}; bf16x2_t r = __builtin_convertvector(v, bf16x2_t); return __builtin_bit_cast(unsigned, r); }
DI float bflo(unsigned w) { return __uint_as_float(w << 16); }
DI float bfhi(unsigned w) { return __uint_as_float(w & 0xffff0000u); }
DI int otid() { int t = threadIdx.x; asm volatile("" : "+v"(t)); return t; }
DI int crow(int r, int hi) { return (r & 3) + 8 * (r >> 2) + 4 * hi; }
DI f32x16 mfma(bf16x8 a, bf16x8 b, f32x16 c) { return __builtin_amdgcn_mfma_f32_32x32x16_bf16(a, b, c, 0, 0, 0); }
DI float ex2(float x) { return __builtin_amdgcn_exp2f(x); }
DI float rcpf_(float x) { return __builtin_amdgcn_rcpf(x); }
DI float xsum32(float v) { auto rr = __builtin_amdgcn_permlane32_swap(__float_as_uint(v), __float_as_uint(v), false, false); return __uint_as_float(rr[0]) + __uint_as_float(rr[1]); }
DI float xmax32(float v) { auto rr = __builtin_amdgcn_permlane32_swap(__float_as_uint(v), __float_as_uint(v), false, false); return fmaxf(__uint_as_float(rr[0]), __uint_as_float(rr[1])); }
DI void st4(u16* p, float a, float b, float c, float d) { u32x2 w = {pk2(a, b), pk2(c, d)}; *(u32x2*)p = w; }
DI float silu_f(float g) { return g * rcpf_(1.f + ex2(-g * LOG2E)); }
DI float sigmoid_f(float g) { return rcpf_(1.f + ex2(-g * LOG2E)); }
DI float gelu_tanh(float x) { const float u = 0.7978845608028654f * (x + 0.044715f * x * x * x); const float th = 1.f - 2.f * rcpf_(1.f + ex2(2.f * LOG2E * u)); return 0.5f * x * (1.f + th); }
DI float* xrow(const P& p, int m) { return m < MLAT ? p.out + (size_t)m * DM : (float*)(p.ws + OFF_CTXX) + (size_t)(m - MLAT) * DM; }
DI int modidx(int m) { return m < MLAT ? (m >> 13) : 8; }
DI const float* modv(const P& p, int l, int mi) { return (const float*)(p.ws + OFF_MOD) + ((size_t)l * 9 + mi) * 6144; }
DI size_t head_row(int m, int h, int H) {
  if (m < MLAT) return ((size_t)((m >> 13) * H + h) << 13) + (m & 8191);
  const int r = m - MLAT; return (size_t)NBATCH * H * TLAT + (size_t)((r >> 8) * H + h) * TCTX + (r & 255);
}
DI u16* wl(const P& p, int l) { return (u16*)(p.ws + OFF_W) + (size_t)l * W_LAYER; }
DI u16* s5t(const P& p, int l) { return (u16*)(p.ws + OFF_S5T) + (size_t)l * S5_LAYER; }
DI int s5_tokbase(int row) { return row < 1024 ? (row >> 7) * TLAT + (row & 127) * 64 : MLAT + ((row - 1024) >> 2) * TCTX + ((row - 1024) & 3) * 64; }

DI int tile_steps(int MT, int NT, int RM, int RN) {
  if (gridDim.x == 256) { const int SM = (MT + RM - 1) / RM, SN = (NT + RN - 1) / RN; return (SM * SN + 7) >> 3; }
  return (MT * NT + gridDim.x - 1) / gridDim.x;
}
DI bool tile_get(int s, int MT, int NT, int RM, int RN, int& mt, int& nt) {
  if (gridDim.x == 256) {
    const int xcd = blockIdx.x & 7, slot = blockIdx.x >> 3; const int SM = (MT + RM - 1) / RM, SN = (NT + RN - 1) / RN;
    const int st = s * 8 + xcd; if (st >= SM * SN) return false;
    mt = (st / SN) * RM + slot % RM; nt = (st % SN) * RN + slot / RM;
    return mt < MT && nt < NT;
  }
  const int it = s * gridDim.x + blockIdx.x; if (it >= MT * NT) return false;
  mt = it / NT; nt = it % NT; return true;
}

struct LdRows {
  const u16* p[4];
  DI u32x4 load(int j, int kc) const { return *(const u32x4*)(p[j] + (size_t)kc * 8); }
};
struct LdS5A {
  const u16* pu[4]; const u16* ph[4];
  DI u32x4 load(int j, int kc) const {
    const u16* q = kc < 128 ? pu[j] + (size_t)(kc >> 1) * PROJ_LD + (kc & 1) * 8 : ph[j] + (kc - 128) * 8;
    return *(const u32x4*)q;
  }
};
struct LdS5B {
  const u16* pk[2]; const u16* pm[2];
  DI u32x4 load(int j, int kc) const {
    const u16* q = kc < 128 ? pk[j] - (kc >> 1) * 256 + (kc & 1) * 8 : pm[j] + (kc - 128) * 8;
    return *(const u32x4*)q;
  }
};

template <int NA, int NB, class AL, class BL>
DI void gemm_issue(int tid, const AL& al, const BL& bl, int nk, u32x4 (&ra0)[NA], u32x4 (&rb0)[NB], u32x4 (&ra1)[NA], u32x4 (&rb1)[NB]) {
  const int lc = tid & 7, k1 = nk > 1 ? 1 : 0;
#pragma unroll
  for (int j = 0; j < NA; ++j) ra0[j] = al.load(j, lc);
#pragma unroll
  for (int j = 0; j < NB; ++j) rb0[j] = bl.load(j, lc);
#pragma unroll
  for (int j = 0; j < NA; ++j) ra1[j] = al.load(j, k1 * 8 + lc);
#pragma unroll
  for (int j = 0; j < NB; ++j) rb1[j] = bl.load(j, k1 * 8 + lc);
}
template <int WM, int WN, int TM, int TN, bool SW = false, class AL, class BL>
DI void gemm_run(int tid, char* lds, const AL& al, const BL& bl, int nk, f32x16 (&acc)[TM][TN], u32x4 (&ra0)[WM * TM / 2], u32x4 (&rb0)[WN * TN / 2], u32x4 (&ra1)[WM * TM / 2], u32x4 (&rb1)[WN * TN / 2]) {
  constexpr int BM = WM * TM * 32, BN = WN * TN * 32, NA = BM / 64, NB = BN / 64;
  constexpr int AB = BM * PITCH, STAGE = (BM + BN) * PITCH;
  const int lane = tid & 63, wid = tid >> 6, r32 = lane & 31, hi = lane >> 5;
  const int wm = wid / WN, wn = wid % WN, lr = tid >> 3, lc = tid & 7;
  char* const wa = lds + lr * PITCH + lc * 16;
  const int aoff = (wm * TM * 32 + r32) * PITCH + hi * 16;
  const int boff = AB + (wn * TN * 32 + r32) * PITCH + hi * 16;
#define GLOAD(RA, RB, KT) do { const int kc_ = (KT) * 8 + lc; _Pragma("unroll") for (int j = 0; j < NA; ++j) RA[j] = al.load(j, kc_); _Pragma("unroll") for (int j = 0; j < NB; ++j) RB[j] = bl.load(j, kc_); } while (0)
#define LWRITE(RA, RB, BUF) do { char* w_ = wa + (BUF) * STAGE; _Pragma("unroll") for (int j = 0; j < NA; ++j) *(u32x4*)(w_ + j * 64 * PITCH) = RA[j]; _Pragma("unroll") for (int j = 0; j < NB; ++j) *(u32x4*)(w_ + AB + j * 64 * PITCH) = RB[j]; } while (0)
#define COMPUTE(BUF, RA, RB, WBUF) do { const char* sb = lds + (BUF) * STAGE; char* w_ = wa + (WBUF) * STAGE; _Pragma("unroll") for (int ks = 0; ks < 4; ++ks) { bf16x8 wf[TN], xf[TM]; \
    _Pragma("unroll") for (int tn = 0; tn < TN; ++tn) wf[tn] = *(const bf16x8*)(sb + boff + tn * 32 * PITCH + ks * 32); \
    _Pragma("unroll") for (int tm = 0; tm < TM; ++tm) xf[tm] = *(const bf16x8*)(sb + aoff + tm * 32 * PITCH + ks * 32); \
    _Pragma("unroll") for (int tm = 0; tm < TM; ++tm) _Pragma("unroll") for (int tn = 0; tn < TN; ++tn) acc[tm][tn] = SW ? mfma(xf[tm], wf[tn], acc[tm][tn]) : mfma(wf[tn], xf[tm], acc[tm][tn]); \
    _Pragma("unroll") for (int j = 0; j < NA; ++j) if (1 + j % 3 == ks) *(u32x4*)(w_ + j * 64 * PITCH) = RA[j]; \
    _Pragma("unroll") for (int j = 0; j < NB; ++j) if (1 + (NA + j) % 3 == ks) *(u32x4*)(w_ + AB + j * 64 * PITCH) = RB[j]; } } while (0)
  const int kl = nk - 1;
  LWRITE(ra0, rb0, 0);
  __syncthreads();
#pragma unroll 1
  for (int kt = 0; kt < nk; kt += 2) {
    GLOAD(ra0, rb0, (kt + 2 < kl ? kt + 2 : kl));
    COMPUTE(0, ra1, rb1, 1);
    __syncthreads();
    if (kt + 1 >= nk) break;
    GLOAD(ra1, rb1, (kt + 3 < kl ? kt + 3 : kl));
    COMPUTE(1, ra0, rb0, 0);
    __syncthreads();
  }
#undef GLOAD
#undef LWRITE
#undef COMPUTE
}
template <int WM, int WN, int TM, int TN, bool SW = false, class AL, class BL>
DI void gemm_main(int tid, char* lds, const AL& al, const BL& bl, int nk, f32x16 (&acc)[TM][TN]) {
  constexpr int NA = WM * TM / 2, NB = WN * TN / 2;
  u32x4 ra0[NA], rb0[NB], ra1[NA], rb1[NB];
  gemm_issue<NA, NB>(tid, al, bl, nk, ra0, rb0, ra1, rb1);
  gemm_run<WM, WN, TM, TN, SW>(tid, lds, al, bl, nk, acc, ra0, rb0, ra1, rb1);
}
DI int tile_next(int s, int ns, int MT, int NT, int RM, int RN, int& mt, int& nt) {
  for (; s < ns; ++s) if (tile_get(s, MT, NT, RM, RN, mt, nt)) return s;
  return -1;
}
template <int TM, int TN> DI void zero_acc(f32x16 (&acc)[TM][TN]) {
#pragma unroll
  for (int a = 0; a < TM; ++a)
#pragma unroll
    for (int b = 0; b < TN; ++b)
#pragma unroll
      for (int r = 0; r < 16; ++r) acc[a][b][r] = 0.f;
}

struct dc { double re, im; };
DI dc cmul(dc a, dc b) { return {a.re * b.re - a.im * b.im, a.re * b.im + a.im * b.re}; }

static __device__ __forceinline__ void phase_pre(const P& p) {
  const int gt = blockIdx.x * NTHREADS + threadIdx.x;
  if (gt < 512) ((u32x4*)(p.ws + OFF_ZERO))[gt] = u32x4{0, 0, 0, 0};
  if (gt < NLAYER * 2 * 16 * 64) {
    const int ldg = gt >> 6;
    const double lre = p.a_re[gt], lim = p.a_im[gt];
    const double dt = exp((double)p.log_dt[ldg]);
    double s, c; sincos(lim * dt, &s, &c);
    const double e = exp(lre * dt);
    const dc a = {e * c, e * s};
    const double den = lre * lre + lim * lim;
    const dc am1 = {a.re - 1.0, a.im};
    const dc q = {(am1.re * lre + am1.im * lim) / den, (am1.im * lre - am1.re * lim) / den};
    dc* pw = (dc*)(p.ws + OFF_S5PW) + (size_t)gt * 65;
    dc r = {1.0, 0.0};
    for (int k = 0; k <= 64; ++k) { pw[k] = r; r = cmul(r, a); }
    ((dc*)(p.ws + OFF_S5Q))[gt] = q;
  }
}

DI int nmap_in(int n) { return n < 640 ? n : (n < 1536 ? n + 32 : n - 896); }
DI int nmap_up(int n) { const int q = n >> 6, r = n & 63; return r < 32 ? 32 * q + r : DFF + 32 * q + (r - 32); }

static __device__ __forceinline__ void transpose_tile(const float* src, int ldsrc, int K, int Nd, int nmap, const float* kscale, u16* dst, int kt, int ntile, char* lds) {
  float* tile = (float*)lds;
  const int tid = threadIdx.x;
  __syncthreads();
  {
    const int n = tid & 63, kk = tid >> 6;
    const int nd = ntile * 64 + n;
    const int ns = nmap == 1 ? nmap_in(nd) : (nmap == 2 ? nmap_up(nd) : nd);
#pragma unroll
    for (int j = 0; j < 8; ++j) {
      const int k = kk + 8 * j, kg = kt * 64 + k;
      float v = 0.f;
      if (nd < Nd) { v = src[(size_t)kg * ldsrc + ns]; if (kscale) v *= kscale[kg]; }
      tile[k * 65 + n] = v;
    }
  }
  __syncthreads();
  {
    const int n = tid >> 3, kc = tid & 7, nd = ntile * 64 + n;
    if (nd < Nd) {
      const float* t = tile + (kc * 8) * 65 + n;
      u32x4 w = {pk2(t[0], t[65]), pk2(t[130], t[195]), pk2(t[260], t[325]), pk2(t[390], t[455])};
      *(u32x4*)(dst + (size_t)nd * K + kt * 64 + kc * 8) = w;
    }
  }
}

static __device__ __forceinline__ void mod_item(const P& p, int it, char* lds) {
  const int l = it / 96, n0 = (it % 96) * 64, tid = threadIdx.x;
  float* sv = (float*)lds;
  float* red = sv + 9 * 1024;
  __syncthreads();
  for (int i = tid; i < 9 * 1024; i += NTHREADS) { const int j = i >> 10, k = i & 1023; const float v = j < 8 ? p.c[j * 1024 + k] : p.c_ctx[k]; sv[i] = v / (1.f + expf(-v)); }
  __syncthreads();
  const int c = tid & 63, kg = tid >> 6;
  float acc[9];
#pragma unroll
  for (int j = 0; j < 9; ++j) acc[j] = 0.f;
  const float* w = p.w_mod + ((size_t)l * 1024 + kg * 128) * 6144 + n0 + c;
  for (int kk = 0; kk < 128; ++kk) {
    const float wv = w[(size_t)kk * 6144];
#pragma unroll
    for (int j = 0; j < 9; ++j) acc[j] += sv[j * 1024 + kg * 128 + kk] * wv;
  }
#pragma unroll
  for (int j = 0; j < 9; ++j) red[(kg * 9 + j) * 64 + c] = acc[j];
  __syncthreads();
  for (int q = tid; q < 576; q += NTHREADS) {
    const int j = q >> 6, cc = q & 63; float s = 0.f;
#pragma unroll
    for (int g = 0; g < 8; ++g) s += red[(g * 9 + j) * 64 + cc];
    ((float*)(p.ws + OFF_MOD))[((size_t)l * 9 + j) * 6144 + n0 + cc] = s + p.b_mod[l * 6144 + n0 + cc];
  }
}

static __device__ __forceinline__ void phase0(const P& p, char* lds) {
  constexpr int NMOD = 384, TPL = 2886;
  for (int it = blockIdx.x; it < NMOD + NLAYER * TPL; it += gridDim.x) {
    if (it < NMOD) { mod_item(p, it, lds); continue; }
    const int u = it - NMOD, l = u / TPL, r = u % TPL;
    u16* W = wl(p, l);
    if (r < 400) transpose_tile(p.w_in + (size_t)l * 1024 * 1568, 1568, 1024, 1568, 1, nullptr, W + W_IN, r / 25, r % 25, lds);
    else if (r < 656) { const int q = r - 400; transpose_tile(p.w_out + (size_t)l * 1024 * 1024, 1024, 1024, 1024, 0, nullptr, W + W_OUT, q / 16, q % 16, lds); }
    else if (r < 2064) { const int q = r - 656; transpose_tile(p.w_up + (size_t)l * 1024 * 5632, 5632, 1024, 5632, 2, nullptr, W + W_UP, q / 88, q % 88, lds); }
    else if (r < 2768) { const int q = r - 2064; transpose_tile(p.w_down + (size_t)l * 2816 * 1024, 1024, 2816, 1024, 0, nullptr, W + W_DN, q / 16, q % 16, lds); }
    else if (r < 2822) { const int q = r - 2768; transpose_tile(p.w_uq + (size_t)l * 384 * 576, 576, 384, 576, 0, p.q_lora_g + l * 384, W + W_UQ, q / 9, q % 9, lds); }
    else if (r < 2870) { const int q = r - 2822; transpose_tile(p.w_ukv + (size_t)l * 256 * 768, 768, 256, 768, 0, p.kv_lora_g + l * 256, W + W_UKV, q / 12, q % 12, lds); }
    else { const int q = r - 2870; transpose_tile(p.w_glu + (size_t)l * 256 * 256, 256, 256, 256, 0, nullptr, W + W_GLU, q / 4, q % 4, lds); }
  }
  const size_t gt = (size_t)blockIdx.x * NTHREADS + threadIdx.x, gn = (size_t)gridDim.x * NTHREADS;
  for (size_t i = gt; i < (size_t)MLAT * DM / 4; i += gn) ((f32x4*)p.out)[i] = ((const f32x4*)p.x)[i];
  for (size_t i = gt; i < (size_t)MCTX * DM / 4; i += gn) ((f32x4*)(p.ws + OFF_CTXX))[i] = ((const f32x4*)p.ctx)[i];
  for (size_t i = gt; i < (size_t)TLAT * 48; i += gn) {
    const int t = (int)(i / 48), j = (int)(i % 48);
    const int row = t >> 6, col = t & 63;
    int pos; double ex; float* cd; float* sd;
    if (j < 16) { const int f = j & 7; pos = j < 8 ? row : col; ex = -(double)f / 8.0; cd = (float*)(p.ws + OFF_ROPE + ROPE_COSA) + t * 16 + j; sd = (float*)(p.ws + OFF_ROPE + ROPE_SINA) + t * 16 + j; }
    else { const int jj = j - 16, f = jj & 15; pos = jj < 16 ? row : col; ex = -(double)f / 16.0; cd = (float*)(p.ws + OFF_ROPE + ROPE_COSS) + t * 32 + jj; sd = (float*)(p.ws + OFF_ROPE + ROPE_SINS) + t * 32 + jj; }
    const float inv = (float)exp(ex * 9.210340371976184);
    const float ang = (float)pos * inv;
    double s, c; sincos((double)ang, &s, &c);
    *cd = (float)c; *sd = (float)s;
  }
  const dc* PW = (const dc*)(p.ws + OFF_S5PW); const dc* QQ = (const dc*)(p.ws + OFF_S5Q);
  for (size_t i = gt; i < (size_t)NLAYER * 16 * 127 * 16; i += gn) {
    const int ii = (int)(i & 15); const int rest = (int)(i >> 4); const int dd = rest % 127, lg = rest / 127, g = lg & 15, l = lg >> 4;
    const int d = dd - 63;
    double acc[16];
#pragma unroll
    for (int o = 0; o < 16; ++o) acc[o] = 0.0;
    for (int dir = 0; dir < 2; ++dir) {
      if ((dir == 0 && d < 0) || (dir == 1 && d > 0)) continue;
      const int base = ((l * 2 + dir) * 16 + g) * 64; const int ad = d < 0 ? -d : d;
      const float* cr = p.c_re + (size_t)((l * 2 + dir) * 16 + g) * 16 * 64; const float* ci_ = p.c_im + (size_t)((l * 2 + dir) * 16 + g) * 16 * 64;
      for (int pp = 0; pp < 64; ++pp) {
        const dc a = PW[(size_t)(base + pp) * 65 + ad], q = QQ[base + pp];
        const size_t bi = (size_t)(base + pp) * 16 + ii; const dc B = {(double)p.b_re[bi], (double)p.b_im[bi]};
        const dc t1 = cmul(cmul(a, q), B);
#pragma unroll
        for (int o = 0; o < 16; ++o) acc[o] += (double)cr[o * 64 + pp] * t1.re - (double)ci_[o * 64 + pp] * t1.im;
      }
    }
    if (d == 0) acc[ii] += (double)p.s5_d[l * 256 + g * 16 + ii];
    u16* dst = s5t(p, l) + S5_KC + (size_t)(g * 127 + dd) * 256 + ii;
#pragma unroll
    for (int o = 0; o < 16; ++o) dst[o * 16] = (u16)(pk2((float)acc[o], 0.f) & 0xffff);
  }
  for (size_t i = gt; i < (size_t)NLAYER * 16 * 256 * 1024; i += gn) {
    const int k = (int)(i & 1023), n = (int)((i >> 10) & 255), g = (int)((i >> 18) & 15), l = (int)(i >> 22);
    const int dir = n >> 7, pp = (n >> 1) & 63, reim = n & 1, s = k >> 4, ii = k & 15;
    const int base = ((l * 2 + dir) * 16 + g) * 64 + pp; const int e = dir == 0 ? 63 - s : s;
    const size_t bi = (size_t)base * 16 + ii; const dc B = {(double)p.b_re[bi], (double)p.b_im[bi]};
    const dc v = cmul(cmul(PW[(size_t)base * 65 + e], QQ[base]), B);
    (s5t(p, l) + S5_BST)[((size_t)g * 256 + n) * 1024 + k] = (u16)(pk2((float)(reim ? v.im : v.re), 0.f) & 0xffff);
  }
  for (size_t i = gt; i < (size_t)NLAYER * 16 * 1024 * 256; i += gn) {
    const int k = (int)(i & 255), n = (int)((i >> 8) & 1023), g = (int)((i >> 18) & 15), l = (int)(i >> 22);
    const int dir = k >> 7, pp = (k >> 1) & 63, reim = k & 1, t = n >> 4, o = n & 15;
    const int base = ((l * 2 + dir) * 16 + g) * 64 + pp; const int e = dir == 0 ? t + 1 : 64 - t;
    const size_t ci = ((size_t)(((l * 2 + dir) * 16 + g) * 16 + o)) * 64 + pp; const dc C = {(double)p.c_re[ci], (double)p.c_im[ci]};
    const dc v = cmul(C, PW[(size_t)base * 65 + e]);
    (s5t(p, l) + S5_MRD)[((size_t)g * 1024 + n) * 256 + k] = (u16)(pk2((float)(reim ? -v.im : v.re), 0.f) & 0xffff);
  }
}

static __device__ __forceinline__ void phase_norm(const P& p, int l, int which) {
  const int tid = otid(), lane = tid & 63, wid = tid >> 6;
  const float* gw = (which ? p.norm2 : p.norm1) + l * 1024;
  u16* H = (u16*)(p.ws + OFF_H);
  const int mend = (which == 1 && l == NLAYER - 1) ? MLAT : MTOT;
  for (int m = blockIdx.x * 8 + wid; m < mend; m += gridDim.x * 8) {
    const float* xr = xrow(p, m);
    const float* mv = modv(p, l, modidx(m)) + which * 3072;
    f32x4 v[4]; float ss = 0.f;
#pragma unroll
    for (int j = 0; j < 4; ++j) { v[j] = *(const f32x4*)(xr + j * 256 + lane * 4); ss += v[j][0] * v[j][0] + v[j][1] * v[j][1] + v[j][2] * v[j][2] + v[j][3] * v[j][3]; }
#pragma unroll
    for (int o = 32; o > 0; o >>= 1) ss += __shfl_xor(ss, o);
    const float rs = rsqrtf(ss * (1.f / 1024.f) + EPS);
    f32x4 gq[4], shq[4], scq[4];
#pragma unroll
    for (int j = 0; j < 4; ++j) { const int c = j * 256 + lane * 4; gq[j] = *(const f32x4*)(gw + c); shq[j] = *(const f32x4*)(mv + c); scq[j] = *(const f32x4*)(mv + 1024 + c); }
#pragma unroll
    for (int j = 0; j < 4; ++j) {
      const int c = j * 256 + lane * 4;
      float o[4];
#pragma unroll
      for (int e = 0; e < 4; ++e) o[e] = v[j][e] * rs * gq[j][e] * (1.f + scq[j][e]) + shq[j][e];
      st4(H + (size_t)m * 1024 + c, o[0], o[1], o[2], o[3]);
    }
  }
}

static __device__ __forceinline__ void phase_inproj(const P& p, int l, char* lds) {
  const int tid = otid(), lane = tid & 63, wid = tid >> 6, r32 = lane & 31, hi = lane >> 5, wm = wid >> 1, wn = wid & 1, lr = tid >> 3;
  const u16* H = (const u16*)(p.ws + OFF_H); const u16* W = wl(p, l) + W_IN;
  u16* proj = (u16*)(p.ws + OFF_PROJ);
  const float* cosS = (const float*)(p.ws + OFF_ROPE + ROPE_COSS); const float* sinS = (const float*)(p.ws + OFF_ROPE + ROPE_SINS);
  const int ns = tile_steps(264, 12, 16, 2);
  u32x4 ra0[4], rb0[2], ra1[4], rb1[2];
  LdRows al, bl; int mt, nt;
  auto mk = [&](int mt_, int nt_, LdRows& a_, LdRows& b_) {
#pragma unroll
    for (int j = 0; j < 4; ++j) a_.p[j] = H + (size_t)(mt_ * 256 + lr + 64 * j) * 1024;
#pragma unroll
    for (int j = 0; j < 2; ++j) b_.p[j] = W + (size_t)(nt_ * 128 + lr + 64 * j) * 1024;
    b_.p[2] = b_.p[3] = b_.p[0];
  };
  int s = tile_next(0, ns, 264, 12, 16, 2, mt, nt);
  if (s >= 0) { mk(mt, nt, al, bl); gemm_issue<4, 2>(tid, al, bl, 16, ra0, rb0, ra1, rb1); }
  while (s >= 0) {
    f32x16 acc[2][2]; zero_acc(acc);
    __syncthreads();
    gemm_run<4, 2, 2, 2>(tid, lds + LDS_SCR, al, bl, 16, acc, ra0, rb0, ra1, rb1);
    int mt2 = 0, nt2 = 0; const int s2 = tile_next(s + 1, ns, 264, 12, 16, 2, mt2, nt2);
    if (s2 >= 0) { mk(mt2, nt2, al, bl); gemm_issue<4, 2>(tid, al, bl, 16, ra0, rb0, ra1, rb1); }
    const int n0w = nt * 128 + wn * 64, mw = mt * 256 + wm * 64;
    if (n0w < 896) {
#pragma unroll
      for (int tm = 0; tm < 2; ++tm) {
        const int m = mw + 32 * tm + r32;
        u16* dst = proj + (size_t)m * PROJ_LD + n0w;
#pragma unroll
        for (int tn = 0; tn < 2; ++tn) {
#pragma unroll
          for (int rg = 0; rg < 4; ++rg) st4(dst + 32 * tn + 8 * rg + 4 * hi, acc[tm][tn][4 * rg], acc[tm][tn][4 * rg + 1], acc[tm][tn][4 * rg + 2], acc[tm][tn][4 * rg + 3]);
        }
      }
    } else if (n0w < 1408) {
      const bool isq = n0w < 1280; const int head = isq ? (n0w - 896) >> 6 : (n0w - 1280) >> 6;
      const float* g = (isq ? p.sq_norm : p.sk_norm) + l * 64;
      u16* dbase = (u16*)(p.ws + (isq ? OFF_QS : OFF_KS));
      const float osc = isq ? 0.125f * LOG2E : 1.f;
#pragma unroll
      for (int tm = 0; tm < 2; ++tm) {
        const int m = mw + 32 * tm + r32;
        float ss = 0.f;
#pragma unroll
        for (int r = 0; r < 16; ++r) ss += acc[tm][0][r] * acc[tm][0][r] + acc[tm][1][r] * acc[tm][1][r];
        ss = xsum32(ss);
        const float rs = rsqrtf(ss * (1.f / 64.f) + EPS);
        u16* dst = dbase + head_row(m, head, isq ? 6 : 2) * 64;
        const bool lat = m < MLAT; const int t = m & 8191;
        f32x4 g1q[4], g2q[4], csq[4], snq[4];
#pragma unroll
        for (int rg = 0; rg < 4; ++rg) {
          const int d = 8 * rg + 4 * hi;
          g1q[rg] = *(const f32x4*)(g + d); g2q[rg] = *(const f32x4*)(g + 32 + d);
          csq[rg] = f32x4{1.f, 1.f, 1.f, 1.f}; snq[rg] = f32x4{0.f, 0.f, 0.f, 0.f};
          if (lat) { csq[rg] = *(const f32x4*)(cosS + t * 32 + d); snq[rg] = *(const f32x4*)(sinS + t * 32 + d); }
        }
#pragma unroll
        for (int rg = 0; rg < 4; ++rg) {
          const int d = 8 * rg + 4 * hi;
          const f32x4 g1 = g1q[rg], g2 = g2q[rg], cs = csq[rg], sn = snq[rg];
          float y1[4], y2[4];
#pragma unroll
          for (int e = 0; e < 4; ++e) {
            const float x1 = acc[tm][0][4 * rg + e] * rs * g1[e], x2 = acc[tm][1][4 * rg + e] * rs * g2[e];
            y1[e] = (x1 * cs[e] - x2 * sn[e]) * osc; y2[e] = (x1 * sn[e] + x2 * cs[e]) * osc;
          }
          st4(dst + d, y1[0], y1[1], y1[2], y1[3]); st4(dst + 32 + d, y2[0], y2[1], y2[2], y2[3]);
        }
      }
    } else if (n0w < 1536) {
      const int head = (n0w - 1408) >> 6;
      u16* dbase = (u16*)(p.ws + OFF_VS);
#pragma unroll
      for (int tm = 0; tm < 2; ++tm) {
        const int m = mw + 32 * tm + r32;
        u16* dst = dbase + head_row(m, head, 2) * 64;
#pragma unroll
        for (int tn = 0; tn < 2; ++tn)
#pragma unroll
          for (int rg = 0; rg < 4; ++rg) st4(dst + 32 * tn + 8 * rg + 4 * hi, acc[tm][tn][4 * rg], acc[tm][tn][4 * rg + 1], acc[tm][tn][4 * rg + 2], acc[tm][tn][4 * rg + 3]);
      }
    }
    s = s2; mt = mt2; nt = nt2;
  }
  for (int it = blockIdx.x; it < 264; it += gridDim.x) {
    LdRows a2, b2;
#pragma unroll
    for (int j = 0; j < 4; ++j) a2.p[j] = H + (size_t)(it * 256 + lr + 64 * j) * 1024;
    b2.p[0] = W + (size_t)(1536 + (lr < 32 ? lr : 31)) * 1024; b2.p[1] = b2.p[2] = b2.p[3] = b2.p[0];
    f32x16 acc2[1][2]; zero_acc(acc2);
    __syncthreads();
    gemm_main<8, 1, 1, 2>(tid, lds + LDS_SCR, a2, b2, 16, acc2);
    u16* dst = proj + (size_t)(it * 256 + wid * 32 + r32) * PROJ_LD + 896;
#pragma unroll
    for (int rg = 0; rg < 4; ++rg) st4(dst + 8 * rg + 4 * hi, acc2[0][0][4 * rg], acc2[0][0][4 * rg + 1], acc2[0][0][4 * rg + 2], acc2[0][0][4 * rg + 3]);
  }
}

template <int NCOLS>
DI void lora_rstd(int tid, const u16* proj, int m0, int col0, float* scr) {
  constexpr int NCH = NCOLS / 64;
  const int sub = tid & 7, rs = tid >> 3;
  u32x4 w[4][NCH];
#pragma unroll
  for (int j = 0; j < 4; ++j) {
    const u16* src = proj + (size_t)(m0 + rs + 64 * j) * PROJ_LD + col0 + sub * 8;
#pragma unroll
    for (int c = 0; c < NCH; ++c) w[j][c] = *(const u32x4*)(src + c * 64);
  }
#pragma unroll
  for (int j = 0; j < 4; ++j) {
    float ss = 0.f;
#pragma unroll
    for (int c = 0; c < NCH; ++c)
#pragma unroll
      for (int e = 0; e < 4; ++e) { const float a = bflo(w[j][c][e]), b = bfhi(w[j][c][e]); ss += a * a + b * b; }
    ss += __shfl_xor(ss, 1); ss += __shfl_xor(ss, 2); ss += __shfl_xor(ss, 4);
    if (sub == 0) scr[rs + 64 * j] = rsqrtf(ss * (1.f / (float)NCOLS) + EPS);
  }
}

static __device__ __forceinline__ void phase_mla_prep(const P& p, int l, char* lds) {
  const int tid = otid(), lane = tid & 63, wid = tid >> 6, r32 = lane & 31, hi = lane >> 5, lr = tid >> 3;
  const u16* proj = (const u16*)(p.ws + OFF_PROJ);
  float* scr = (float*)lds;
  const float* cosA = (const float*)(p.ws + OFF_ROPE + ROPE_COSA); const float* sinA = (const float*)(p.ws + OFF_ROPE + ROPE_SINA);
  {
    const u16* W = wl(p, l) + W_UQ; const float* g = p.q_norm + l * 96; u16* Qm = (u16*)(p.ws + OFF_QM);
    const int wm = wid >> 1, wn = wid & 1;
    const float osc = 0.10206207261596577f * LOG2E;
    for (int s = 0, ns = tile_steps(264, 3, 32, 1); s < ns; ++s) {
      int mt, nt; if (!tile_get(s, 264, 3, 32, 1, mt, nt)) continue;
      const int m0 = mt * 256;
      __syncthreads();
      lora_rstd<384>(tid, proj, m0, 0, scr);
      LdRows al, bl;
#pragma unroll
      for (int j = 0; j < 4; ++j) al.p[j] = proj + (size_t)(m0 + lr + 64 * j) * PROJ_LD;
#pragma unroll
      for (int j = 0; j < 3; ++j) bl.p[j] = W + (size_t)(nt * 192 + lr + 64 * j) * 384;
      bl.p[3] = bl.p[0];
      f32x16 acc[2][3]; zero_acc(acc);
      gemm_main<4, 2, 2, 3>(tid, lds + LDS_SCR, al, bl, 6, acc);
      const int head = nt * 2 + wn;
#pragma unroll
      for (int tm = 0; tm < 2; ++tm) {
        const int rl = wm * 64 + 32 * tm + r32, m = m0 + rl;
        const float rlo = scr[rl];
        float ss = 0.f;
#pragma unroll
        for (int tn = 0; tn < 3; ++tn)
#pragma unroll
          for (int r = 0; r < 16; ++r) ss += acc[tm][tn][r] * acc[tm][tn][r];
        ss = xsum32(ss);
        const float f = rlo * rsqrtf(rlo * rlo * ss * (1.f / 96.f) + EPS);
        u16* dst = Qm + head_row(m, head, 6) * 96;
        const bool lat = m < MLAT; const int t = m & 8191;
        f32x4 gq[2][4], r1q[2], r2q[2], csq[2], snq[2];
#pragma unroll
        for (int tn = 0; tn < 2; ++tn)
#pragma unroll
          for (int rg = 0; rg < 4; ++rg) gq[tn][rg] = *(const f32x4*)(g + 32 * tn + 8 * rg + 4 * hi);
#pragma unroll
        for (int rg = 0; rg < 2; ++rg) {
          const int j = 8 * rg + 4 * hi; r1q[rg] = *(const f32x4*)(g + 64 + j); r2q[rg] = *(const f32x4*)(g + 80 + j);
          csq[rg] = f32x4{1.f, 1.f, 1.f, 1.f}; snq[rg] = f32x4{0.f, 0.f, 0.f, 0.f};
          if (lat) { csq[rg] = *(const f32x4*)(cosA + t * 16 + j); snq[rg] = *(const f32x4*)(sinA + t * 16 + j); }
        }
#pragma unroll
        for (int tn = 0; tn < 2; ++tn)
#pragma unroll
          for (int rg = 0; rg < 4; ++rg) {
            const int d = 32 * tn + 8 * rg + 4 * hi; const f32x4 gv = gq[tn][rg];
            st4(dst + d, acc[tm][tn][4 * rg] * f * gv[0] * osc, acc[tm][tn][4 * rg + 1] * f * gv[1] * osc, acc[tm][tn][4 * rg + 2] * f * gv[2] * osc, acc[tm][tn][4 * rg + 3] * f * gv[3] * osc);
          }
#pragma unroll
        for (int rg = 0; rg < 2; ++rg) {
          const int j = 8 * rg + 4 * hi; const f32x4 g1 = r1q[rg], g2 = r2q[rg], cs = csq[rg], sn = snq[rg];
          float y1[4], y2[4];
#pragma unroll
          for (int e = 0; e < 4; ++e) {
            const float x1 = acc[tm][2][4 * rg + e] * f * g1[e], x2 = acc[tm][2][8 + 4 * rg + e] * f * g2[e];
            y1[e] = (x1 * cs[e] - x2 * sn[e]) * osc; y2[e] = (x1 * sn[e] + x2 * cs[e]) * osc;
          }
          st4(dst + 64 + j, y1[0], y1[1], y1[2], y1[3]); st4(dst + 80 + j, y2[0], y2[1], y2[2], y2[3]);
        }
      }
    }
  }
  {
    const u16* W = wl(p, l) + W_UKV; const float* g = p.k_norm + l * 96; u16* Km = (u16*)(p.ws + OFF_KM); u16* Vm = (u16*)(p.ws + OFF_VM);
    for (int s = 0, ns = tile_steps(264, 6, 16, 2); s < ns; ++s) {
      int mt, head; if (!tile_get(s, 264, 6, 16, 2, mt, head)) continue;
      const int m0 = mt * 256;
      __syncthreads();
      lora_rstd<256>(tid, proj, m0, 384, scr);
      LdRows al, bl;
#pragma unroll
      for (int j = 0; j < 4; ++j) al.p[j] = proj + (size_t)(m0 + lr + 64 * j) * PROJ_LD + 384;
#pragma unroll
      for (int j = 0; j < 2; ++j) bl.p[j] = W + (size_t)(head * 128 + lr + 64 * j) * 256;
      bl.p[2] = bl.p[3] = bl.p[0];
      f32x16 acc[1][4]; zero_acc(acc);
      gemm_main<8, 1, 1, 4>(tid, lds + LDS_SCR, al, bl, 4, acc);
      const int rl = wid * 32 + r32, m = m0 + rl;
      const float rlo = scr[rl];
      float ssr = 0.f; u32x4 wx1, wx2;
      {
        const u16* kp = proj + (size_t)m * PROJ_LD + 896;
        const u32x4 w0 = *(const u32x4*)(kp), w1 = *(const u32x4*)(kp + 8), w2 = *(const u32x4*)(kp + 16), w3 = *(const u32x4*)(kp + 24);
#pragma unroll
        for (int e = 0; e < 4; ++e) {
          ssr += bflo(w0[e]) * bflo(w0[e]) + bfhi(w0[e]) * bfhi(w0[e]) + bflo(w1[e]) * bflo(w1[e]) + bfhi(w1[e]) * bfhi(w1[e]);
          ssr += bflo(w2[e]) * bflo(w2[e]) + bfhi(w2[e]) * bfhi(w2[e]) + bflo(w3[e]) * bflo(w3[e]) + bfhi(w3[e]) * bfhi(w3[e]);
        }
        wx1 = hi ? w1 : w0; wx2 = hi ? w3 : w2;
      }
      float ss = 0.f;
#pragma unroll
      for (int tn = 0; tn < 2; ++tn)
#pragma unroll
        for (int r = 0; r < 16; ++r) ss += acc[0][tn][r] * acc[0][tn][r];
      ss = xsum32(ss);
      const float rk = rsqrtf((rlo * rlo * ss + ssr) * (1.f / 96.f) + EPS);
      const size_t hr = head_row(m, head, 6);
      u16* kd = Km + hr * 96; u16* vd = Vm + hr * 64;
      const bool lat = m < MLAT; const int t = m & 8191;
      f32x4 gq[2][4]; float gr1[8], gr2[8], csr[8], snr[8];
#pragma unroll
      for (int tn = 0; tn < 2; ++tn)
#pragma unroll
        for (int rg = 0; rg < 4; ++rg) gq[tn][rg] = *(const f32x4*)(g + 32 * tn + 8 * rg + 4 * hi);
#pragma unroll
      for (int e = 0; e < 8; ++e) {
        const int j = 8 * hi + e; gr1[e] = g[64 + j]; gr2[e] = g[80 + j]; csr[e] = 1.f; snr[e] = 0.f;
        if (lat) { csr[e] = cosA[t * 16 + j]; snr[e] = sinA[t * 16 + j]; }
      }
#pragma unroll
      for (int tn = 0; tn < 2; ++tn)
#pragma unroll
        for (int rg = 0; rg < 4; ++rg) {
          const int d = 32 * tn + 8 * rg + 4 * hi; const f32x4 gv = gq[tn][rg]; const float f = rlo * rk;
          st4(kd + d, acc[0][tn][4 * rg] * f * gv[0], acc[0][tn][4 * rg + 1] * f * gv[1], acc[0][tn][4 * rg + 2] * f * gv[2], acc[0][tn][4 * rg + 3] * f * gv[3]);
          st4(vd + d, acc[0][2 + tn][4 * rg] * rlo, acc[0][2 + tn][4 * rg + 1] * rlo, acc[0][2 + tn][4 * rg + 2] * rlo, acc[0][2 + tn][4 * rg + 3] * rlo);
        }
      {
        float y1[8], y2[8];
#pragma unroll
        for (int e = 0; e < 8; ++e) {
          const int j = 8 * hi + e;
          const float k1 = (e & 1) ? bfhi(wx1[e >> 1]) : bflo(wx1[e >> 1]), k2 = (e & 1) ? bfhi(wx2[e >> 1]) : bflo(wx2[e >> 1]);
          const float x1 = k1 * rk * gr1[e], x2 = k2 * rk * gr2[e];
          const float cs = csr[e], sn = snr[e];
          y1[e] = x1 * cs - x2 * sn; y2[e] = x1 * sn + x2 * cs;
        }
        u32x4 w1 = {pk2(y1[0], y1[1]), pk2(y1[2], y1[3]), pk2(y1[4], y1[5]), pk2(y1[6], y1[7])};
        u32x4 w2 = {pk2(y2[0], y2[1]), pk2(y2[2], y2[3]), pk2(y2[4], y2[5]), pk2(y2[6], y2[7])};
        *(u32x4*)(kd + 64 + 8 * hi) = w1; *(u32x4*)(kd + 80 + 8 * hi) = w2;
      }
    }
  }
}

static __device__ __forceinline__ void phase_s5_states(const P& p, int l, char* lds) {
  const int tid = otid(), lane = tid & 63, wid = tid >> 6, r32 = lane & 31, hi = lane >> 5, wm = wid >> 1, wn = wid & 1, lr = tid >> 3;
  const u16* proj = (const u16*)(p.ws + OFF_PROJ); float* Sst = (float*)(p.ws + OFF_SST);
  for (int it = blockIdx.x; it < 160; it += gridDim.x) {
    const int g = it / 10, r = it % 10, mt = r >> 1, nt = r & 1;
    LdS5A al; LdRows bl;
#pragma unroll
    for (int j = 0; j < 4; ++j) { const int row = mt * 256 + lr + 64 * j; al.pu[j] = proj + (size_t)s5_tokbase(row < 1056 ? row : 0) * PROJ_LD + 640 + g * 16; al.ph[j] = al.pu[j]; }
    const u16* B = s5t(p, l) + S5_BST + (size_t)g * 256 * 1024;
#pragma unroll
    for (int j = 0; j < 2; ++j) bl.p[j] = B + (size_t)(nt * 128 + lr + 64 * j) * 1024;
    bl.p[2] = bl.p[3] = bl.p[0];
    f32x16 acc[2][2]; zero_acc(acc);
    __syncthreads();
    gemm_main<4, 2, 2, 2>(tid, lds + LDS_SCR, al, bl, 16, acc);
#pragma unroll
    for (int tm = 0; tm < 2; ++tm) {
      const int row = mt * 256 + wm * 64 + 32 * tm + r32;
      if (row < 1056) {
        float* dst = Sst + ((size_t)row * 16 + g) * 256 + nt * 128 + wn * 64;
#pragma unroll
        for (int tn = 0; tn < 2; ++tn)
#pragma unroll
          for (int rg = 0; rg < 4; ++rg) { f32x4 v = {acc[tm][tn][4 * rg], acc[tm][tn][4 * rg + 1], acc[tm][tn][4 * rg + 2], acc[tm][tn][4 * rg + 3]}; *(f32x4*)(dst + 32 * tn + 8 * rg + 4 * hi) = v; }
      }
    }
  }
}

static __device__ __forceinline__ void s5_scan_item(const P& p, int l, int blk) {
  const int gt = blk * NTHREADS + otid();
  const int pp = gt & 63, dir = (gt >> 6) & 1, g = (gt >> 7) & 15, b = gt >> 11;
  const dc a64d = ((const dc*)(p.ws + OFF_S5PW))[(size_t)((((l * 2 + dir) * 16 + g) * 64) + pp) * 65 + 64];
  const float ar = (float)a64d.re, ai = (float)a64d.im;
  const float* Sst = (const float*)(p.ws + OFF_SST); unsigned* Hin = (unsigned*)(p.ws + OFF_HIN);
  const int col = g * 256 + dir * 128 + 2 * pp;
  float hr = 0.f, hi_ = 0.f;
#pragma unroll 1
  for (int s0 = 0; s0 < 132; s0 += 4) {
    int rows[4]; f32x2 sv[4];
#pragma unroll
    for (int e = 0; e < 4; ++e) {
      const int st = s0 + e; int row;
      if (st < 4) { const int c = dir ? 3 - st : st; row = 1024 + b * 4 + c; } else { const int s2 = st - 4; const int c = dir ? 127 - s2 : s2; row = b * 128 + c; }
      rows[e] = row; sv[e] = *(const f32x2*)(Sst + (size_t)row * 4096 + col);
    }
#pragma unroll
    for (int e = 0; e < 4; ++e) {
      Hin[((size_t)rows[e] * 4096 + col) >> 1] = pk2(hr, hi_);
      const float nr = ar * hr - ai * hi_ + sv[e][0], ni = ar * hi_ + ai * hr + sv[e][1];
      hr = nr; hi_ = ni;
    }
  }
}

static __device__ __forceinline__ void phase_s5_out(const P& p, int l, char* lds) {
  const int tid = otid(), lane = tid & 63, wid = tid >> 6, r32 = lane & 31, hi = lane >> 5, wm = wid >> 1, wn = wid & 1, lr = tid >> 3;
  const u16* proj = (const u16*)(p.ws + OFF_PROJ); const u16* Hin = (const u16*)(p.ws + OFF_HIN); u16* zb = (u16*)(p.ws + OFF_ZB);
  const int per_g = l == NLAYER - 1 ? 32 : 40;
  for (int it = blockIdx.x; it < 16 * per_g; it += gridDim.x) {
    const int g = it / per_g, r = it % per_g, mt = r >> 3, nt = r & 7;
    LdS5A al; LdS5B bl;
#pragma unroll
    for (int j = 0; j < 4; ++j) {
      const int row = mt * 256 + lr + 64 * j;
      al.pu[j] = proj + (size_t)s5_tokbase(row < 1056 ? row : 0) * PROJ_LD + 640 + g * 16;
      al.ph[j] = Hin + ((size_t)(row < 1056 ? row : 0) * 16 + g) * 256;
    }
    const u16* Kc = s5t(p, l) + S5_KC + (size_t)g * 127 * 256; const u16* Mrd = s5t(p, l) + S5_MRD + (size_t)g * 1024 * 256;
#pragma unroll
    for (int j = 0; j < 2; ++j) { const int n = nt * 128 + lr + 64 * j; bl.pk[j] = Kc + ((n >> 4) + 63) * 256 + (n & 15) * 16; bl.pm[j] = Mrd + (size_t)n * 256; }
    f32x16 acc[2][2]; zero_acc(acc);
    __syncthreads();
    gemm_main<4, 2, 2, 2>(tid, lds + LDS_SCR, al, bl, 20, acc);
#pragma unroll
    for (int tm = 0; tm < 2; ++tm) {
      const int row = mt * 256 + wm * 64 + 32 * tm + r32;
      if (row < 1056) {
        const int tb = s5_tokbase(row);
#pragma unroll
        for (int tn = 0; tn < 2; ++tn)
#pragma unroll
          for (int rg = 0; rg < 4; ++rg) {
            const int n = nt * 128 + wn * 64 + 32 * tn + 8 * rg + 4 * hi;
            u16* dst = zb + (size_t)(tb + (n >> 4)) * 256 + g * 16 + (n & 15);
            st4(dst, gelu_tanh(acc[tm][tn][4 * rg]), gelu_tanh(acc[tm][tn][4 * rg + 1]), gelu_tanh(acc[tm][tn][4 * rg + 2]), gelu_tanh(acc[tm][tn][4 * rg + 3]));
          }
      }
    }
  }
}

static __device__ __forceinline__ void phase_glu(const P& p, int l, char* lds) {
  const int tid = otid(), lane = tid & 63, wid = tid >> 6, r32 = lane & 31, hi = lane >> 5, wm = wid >> 1, wn = wid & 1, lr = tid >> 3;
  const u16* zb = (const u16*)(p.ws + OFF_ZB); const u16* W = wl(p, l) + W_GLU; u16* mix = (u16*)(p.ws + OFF_MIX); const float* bg = p.b_glu + l * 256;
  const int MT = l == NLAYER - 1 ? 256 : 264;
  for (int s = 0, ns = tile_steps(MT, 2, 16, 2); s < ns; ++s) {
    int mt, nt; if (!tile_get(s, MT, 2, 16, 2, mt, nt)) continue;
    LdRows al, bl;
#pragma unroll
    for (int j = 0; j < 4; ++j) al.p[j] = zb + (size_t)(mt * 256 + lr + 64 * j) * 256;
#pragma unroll
    for (int j = 0; j < 2; ++j) bl.p[j] = W + (size_t)(nt * 128 + lr + 64 * j) * 256;
    bl.p[2] = bl.p[3] = bl.p[0];
    f32x16 acc[2][2]; zero_acc(acc);
    __syncthreads();
    gemm_main<4, 2, 2, 2>(tid, lds + LDS_SCR, al, bl, 4, acc);
    u32x2 zq[2][2][4]; f32x4 bq[2][4];
#pragma unroll
    for (int tn = 0; tn < 2; ++tn)
#pragma unroll
      for (int rg = 0; rg < 4; ++rg) {
        const int n = nt * 128 + wn * 64 + 32 * tn + 8 * rg + 4 * hi; bq[tn][rg] = *(const f32x4*)(bg + n);
#pragma unroll
        for (int tm = 0; tm < 2; ++tm) zq[tm][tn][rg] = *(const u32x2*)(zb + (size_t)(mt * 256 + wm * 64 + 32 * tm + r32) * 256 + n);
      }
#pragma unroll
    for (int tm = 0; tm < 2; ++tm) {
      const int m = mt * 256 + wm * 64 + 32 * tm + r32;
#pragma unroll
      for (int tn = 0; tn < 2; ++tn)
#pragma unroll
        for (int rg = 0; rg < 4; ++rg) {
          const int n = nt * 128 + wn * 64 + 32 * tn + 8 * rg + 4 * hi;
          const u32x2 zw = zq[tm][tn][rg]; const f32x4 bv = bq[tn][rg];
          const float z0 = bflo(zw[0]), z1 = bfhi(zw[0]), z2 = bflo(zw[1]), z3 = bfhi(zw[1]);
          st4(mix + (size_t)m * 1024 + 384 + n, z0 * sigmoid_f(acc[tm][tn][4 * rg] + bv[0]), z1 * sigmoid_f(acc[tm][tn][4 * rg + 1] + bv[1]), z2 * sigmoid_f(acc[tm][tn][4 * rg + 2] + bv[2]),
              z3 * sigmoid_f(acc[tm][tn][4 * rg + 3] + bv[3]));
        }
    }
  }
}

template <int DQK>
DI void attn_unit(int tid, char* lds, const u16* Qp, const u16* K1, const u16* V1, int nt1, int kpos0, const u16* K2, const u16* V2, int nt2, int qpos0, bool mask, float m_init, float l_init, u16* Op) {
  constexpr int KP = DQK * 2 + 16, KB = 64 * KP, VB = 8192, SB = KB + VB, NCH = DQK / 8, NKC = 64 * NCH, ND = DQK / 16;
  const int lane = tid & 63, wid = tid >> 6, r32 = lane & 31, hi = lane >> 5;
  bf16x8 qr[ND];
  {
    const u16* qrow = Qp + (size_t)(wid * 32 + r32) * DQK + hi * 8;
#pragma unroll
    for (int d0 = 0; d0 < ND; ++d0) qr[d0] = *(const bf16x8*)(qrow + d0 * 16);
  }
  const int kk0 = tid / NCH, kc0 = tid % NCH;
  const int id1 = tid + NTHREADS; const bool has1 = id1 < NKC; const int kk1 = id1 / NCH, kc1 = id1 % NCH;
  const int idl = has1 ? id1 : tid;
  const int vkey = tid >> 3, vc = tid & 7;
  const int vst = ((vkey >> 3) * 2 + (vc >> 2)) * 512 + (vkey & 7) * 64 + (vc & 3) * 16;
  const int vrb = ((lane & 3) << 3) | (((lane >> 2) & 3) << 6) | (((lane >> 4) & 1) << 5) | (((lane >> 5) & 1) << 8);
  const int kw0 = kk0 * KP + kc0 * 16, kw1 = kk1 * KP + kc1 * 16, kro = r32 * KP + hi * 16;
  f32x16 o0, o1;
#pragma unroll
  for (int r = 0; r < 16; ++r) { o0[r] = 0.f; o1[r] = 0.f; }
  constexpr float THR = 8.f;
  float mrun = m_init, lrun = hi == 0 ? l_init : 0.f;
  f32x16 negm;
#pragma unroll
  for (int r = 0; r < 16; ++r) negm[r] = -mrun;
  const int NT = nt1 + nt2;
  const int qpos = qpos0 + wid * 32 + r32;
  u32x4 sk0, sk1, sv;
  auto gl = [&](int i) {
    const u16* kp; const u16* vp;
    if (i < nt1) { kp = K1 + (size_t)i * 64 * DQK; vp = V1 + (size_t)i * 4096; } else { kp = K2 + (size_t)(i - nt1) * 64 * DQK; vp = V2 + (size_t)(i - nt1) * 4096; }
    sk0 = *(const u32x4*)(kp + (size_t)tid * 8); sk1 = *(const u32x4*)(kp + (size_t)idl * 8); sv = *(const u32x4*)(vp + (size_t)tid * 8);
  };
  auto sw = [&](int st) {
    char* b = lds + st * SB;
    *(u32x4*)(b + kw0) = sk0; if (has1) *(u32x4*)(b + kw1) = sk1; *(u32x4*)(b + KB + vst) = sv;
  };
  auto qk = [&](int st, f32x16& p0, f32x16& p1) {
    const char* Kb = lds + st * SB + kro;
#pragma unroll
    for (int d0 = 0; d0 < ND; ++d0) {
      const bf16x8 a0 = *(const bf16x8*)(Kb + d0 * 32);
      const bf16x8 a1 = *(const bf16x8*)(Kb + 32 * KP + d0 * 32);
      if (d0 == 0) { p0 = mfma(a0, qr[0], negm); p1 = mfma(a1, qr[0], negm); } else { p0 = mfma(a0, qr[d0], p0); p1 = mfma(a1, qr[d0], p1); }
    }
  };
  const int qw0 = qpos0 + wid * 32;
  auto live = [&](int i) { if (!mask || i >= nt1) return true; const int kb = kpos0 + i * 64; return kb + 63 >= qw0 - 128 && kb <= qw0 + 31 + 128; };
  auto step = [&](f32x16& c0, f32x16& c1, f32x16& n0, f32x16& n1, int i, int s_cur, int s_nxt, int s_wr) {
    const bool has_nxt = i + 1 < NT, has_wr = i + 2 < NT;
    if (has_wr) gl(i + 2);
    if (has_nxt && live(i + 1)) qk(s_nxt, n0, n1);
    if (live(i)) {
    if (mask && i < nt1) {
      const int kb = kpos0 + i * 64 - qpos;
#pragma unroll
      for (int r = 0; r < 16; ++r) {
        const int d0_ = kb + crow(r, hi), d1_ = d0_ + 32;
        if (d0_ > 128 || d0_ < -128) c0[r] = -1e30f;
        if (d1_ > 128 || d1_ < -128) c1[r] = -1e30f;
      }
    }
    float mt = c0[0];
#pragma unroll
    for (int r = 1; r < 16; ++r) mt = fmaxf(mt, c0[r]);
#pragma unroll
    for (int r = 0; r < 16; ++r) mt = fmaxf(mt, c1[r]);
    mt = xmax32(mt);
    if (__any(mt > THR)) {
      const float delta = fmaxf(mt, 0.f), alpha = ex2(-delta);
      mrun += delta; lrun *= alpha;
#pragma unroll
      for (int r = 0; r < 16; ++r) { o0[r] *= alpha; o1[r] *= alpha; c0[r] -= delta; c1[r] -= delta; n0[r] -= delta; n1[r] -= delta; negm[r] = -mrun; }
    }
    float ls = 0.f;
#pragma unroll
    for (int r = 0; r < 16; ++r) { c0[r] = ex2(c0[r]); c1[r] = ex2(c1[r]); ls += c0[r] + c1[r]; }
    lrun += ls;
    bf16x8 pb[4];
    { u32x4 w = {pk2(c0[0], c0[1]), pk2(c0[2], c0[3]), pk2(c0[4], c0[5]), pk2(c0[6], c0[7])}; pb[0] = __builtin_bit_cast(bf16x8, w); }
    { u32x4 w = {pk2(c0[8], c0[9]), pk2(c0[10], c0[11]), pk2(c0[12], c0[13]), pk2(c0[14], c0[15])}; pb[1] = __builtin_bit_cast(bf16x8, w); }
    { u32x4 w = {pk2(c1[0], c1[1]), pk2(c1[2], c1[3]), pk2(c1[4], c1[5]), pk2(c1[6], c1[7])}; pb[2] = __builtin_bit_cast(bf16x8, w); }
    { u32x4 w = {pk2(c1[8], c1[9]), pk2(c1[10], c1[11]), pk2(c1[12], c1[13]), pk2(c1[14], c1[15])}; pb[3] = __builtin_bit_cast(bf16x8, w); }
    LAS char* Vb = (LAS char*)(lds + s_cur * SB + KB + vrb);
#pragma unroll
    for (int ks = 0; ks < 4; ++ks) {
      const s16x4 l0 = __builtin_amdgcn_ds_read_tr16_b64_v4i16((LAS s16x4*)(Vb + ((2 * ks) * 2 + 0) * 512));
      const s16x4 h0 = __builtin_amdgcn_ds_read_tr16_b64_v4i16((LAS s16x4*)(Vb + ((2 * ks + 1) * 2 + 0) * 512));
      const s16x4 l1 = __builtin_amdgcn_ds_read_tr16_b64_v4i16((LAS s16x4*)(Vb + ((2 * ks) * 2 + 1) * 512));
      const s16x4 h1 = __builtin_amdgcn_ds_read_tr16_b64_v4i16((LAS s16x4*)(Vb + ((2 * ks + 1) * 2 + 1) * 512));
      const bf16x8 va0 = {l0[0], l0[1], l0[2], l0[3], h0[0], h0[1], h0[2], h0[3]};
      const bf16x8 va1 = {l1[0], l1[1], l1[2], l1[3], h1[0], h1[1], h1[2], h1[3]};
      o0 = mfma(va0, pb[ks], o0); o1 = mfma(va1, pb[ks], o1);
    }
    }
    if (has_wr) sw(s_wr);
    __syncthreads();
  };
  gl(0); sw(0);
  if (NT > 1) { gl(1); sw(1); }
  __syncthreads();
  f32x16 pA0, pA1, pB0, pB1;
#pragma unroll
  for (int r = 0; r < 16; ++r) { pB0[r] = 0.f; pB1[r] = 0.f; }
  if (live(0)) qk(0, pA0, pA1);
  int s_cur = 0, s_nxt = 1, s_wr = 2;
#pragma unroll 1
  for (int i = 0; i < NT; i += 2) {
    step(pA0, pA1, pB0, pB1, i, s_cur, s_nxt, s_wr);
    if (i + 1 >= NT) break;
    step(pB0, pB1, pA0, pA1, i + 1, s_nxt, s_wr, s_cur);
    const int t_ = s_cur; s_cur = s_wr; s_wr = s_nxt; s_nxt = t_;
  }
  const float inv = rcpf_(xsum32(lrun));
  u16* orow = Op + (size_t)(wid * 32 + r32) * 1024;
#pragma unroll
  for (int rg = 0; rg < 4; ++rg) {
    st4(orow + 8 * rg + 4 * hi, o0[4 * rg] * inv, o0[4 * rg + 1] * inv, o0[4 * rg + 2] * inv, o0[4 * rg + 3] * inv);
    st4(orow + 32 + 8 * rg + 4 * hi, o1[4 * rg] * inv, o1[4 * rg + 1] * inv, o1[4 * rg + 2] * inv, o1[4 * rg + 3] * inv);
  }
}

static __device__ __forceinline__ void phase_attn(const P& p, int l, char* lds) {
  if (blockIdx.x < 32) s5_scan_item(p, l, blockIdx.x);
  const int tid = otid();
  const u16* Qm = (const u16*)(p.ws + OFF_QM); const u16* Km = (const u16*)(p.ws + OFF_KM); const u16* Vm = (const u16*)(p.ws + OFF_VM);
  const u16* Qs = (const u16*)(p.ws + OFF_QS); const u16* Ks = (const u16*)(p.ws + OFF_KS); const u16* Vs = (const u16*)(p.ws + OFF_VS);
  u16* mix = (u16*)(p.ws + OFF_MIX);
  constexpr size_t CTX6 = (size_t)NBATCH * 6 * TLAT, CTX2 = (size_t)NBATCH * 2 * TLAT;
  const int nunits = l == NLAYER - 1 ? 3072 : 3168;
  for (int it = blockIdx.x; it < nunits; it += gridDim.x) {
    __syncthreads();
    if (it < 3072) {
      const int u = it < 1536 ? it : it - 1536;
      const int rr = u >> 8, bb = u & 255, bh = rr * 8 + (bb & 7), qb = bb >> 3, b = bh / 6, h = bh % 6, q0 = qb * 256;
      if (it < 1536) {
        const size_t r0 = (size_t)bh * TLAT, c0 = CTX6 + (size_t)bh * TCTX;
        attn_unit<96>(tid, lds, Qm + (r0 + q0) * 96, Km + r0 * 96, Vm + r0 * 64, 128, 0, Km + c0 * 96, Vm + c0 * 64, 4, q0, false, 0.f, 0.f, mix + (size_t)(b * TLAT + q0) * 1024 + h * 64);
      } else {
        const int kvh = h / 3, lo = q0 - 128 < 0 ? 0 : q0 - 128, hi_ = q0 + 384 > TLAT ? TLAT : q0 + 384;
        const size_t r0 = (size_t)(b * 2 + kvh) * TLAT, c0 = CTX2 + (size_t)(b * 2 + kvh) * TCTX;
        attn_unit<64>(tid, lds, Qs + ((size_t)bh * TLAT + q0) * 64, Ks + (r0 + lo) * 64, Vs + (r0 + lo) * 64, (hi_ - lo) >> 6, lo, Ks + c0 * 64, Vs + c0 * 64, 4, q0, true, p.sink[l * 6 + h] * LOG2E, 1.f,
                      mix + (size_t)(b * TLAT + q0) * 1024 + 640 + h * 64);
      }
    } else {
      const int u = it - 3072, ty = u / 48, bh = u % 48, b = bh / 6, h = bh % 6;
      if (ty == 0) {
        const size_t c0 = CTX6 + (size_t)bh * TCTX;
        attn_unit<96>(tid, lds, Qm + c0 * 96, Km + c0 * 96, Vm + c0 * 64, 4, 0, Km, Vm, 0, 0, false, 0.f, 0.f, mix + (size_t)(MLAT + b * TCTX) * 1024 + h * 64);
      } else {
        const int kvh = h / 3; const size_t c0 = CTX2 + (size_t)(b * 2 + kvh) * TCTX;
        attn_unit<64>(tid, lds, Qs + (CTX6 + (size_t)bh * TCTX) * 64, Ks + c0 * 64, Vs + c0 * 64, 4, 0, Ks, Vs, 0, 0, false, p.sink[l * 6 + h] * LOG2E, 1.f, mix + (size_t)(MLAT + b * TCTX) * 1024 + 640 + h * 64);
      }
    }
  }
}

static __device__ __forceinline__ void phase_resid_gemm(const P& p, int l, const u16* A, const u16* W, int ldk, int gate_off, char* lds) {
  const int tid = otid(), lane = tid & 63, wid = tid >> 6, r32 = lane & 31, hi = lane >> 5, wm = wid >> 1, wn = wid & 1, lr = tid >> 3;
  const int MT = l == NLAYER - 1 ? 256 : 264;
  const int ns = tile_steps(MT, 8, 4, 8), nk = ldk >> 6;
  u32x4 ra0[4], rb0[2], ra1[4], rb1[2];
  LdRows al, bl; int mt, nt;
  auto mk = [&](int mt_, int nt_, LdRows& a_, LdRows& b_) {
#pragma unroll
    for (int j = 0; j < 4; ++j) a_.p[j] = A + (size_t)(mt_ * 256 + lr + 64 * j) * ldk;
#pragma unroll
    for (int j = 0; j < 2; ++j) b_.p[j] = W + (size_t)(nt_ * 128 + lr + 64 * j) * ldk;
    b_.p[2] = b_.p[3] = b_.p[0];
  };
  int s = tile_next(0, ns, MT, 8, 4, 8, mt, nt);
  if (s >= 0) { mk(mt, nt, al, bl); gemm_issue<4, 2>(tid, al, bl, nk, ra0, rb0, ra1, rb1); }
  while (s >= 0) {
    f32x16 acc[2][2]; zero_acc(acc);
    __syncthreads();
    gemm_run<4, 2, 2, 2, true>(tid, lds + LDS_SCR, al, bl, nk, acc, ra0, rb0, ra1, rb1);
    int mt2 = 0, nt2 = 0; const int s2 = tile_next(s + 1, ns, MT, 8, 4, 8, mt2, nt2);
    if (s2 >= 0) { mk(mt2, nt2, al, bl); gemm_issue<4, 2>(tid, al, bl, nk, ra0, rb0, ra1, rb1); }
    float* xb = xrow(p, mt * 256); const float* gv = modv(p, l, modidx(mt * 256)) + gate_off;
#pragma unroll
    for (int tn = 0; tn < 2; ++tn) {
      const int n = nt * 128 + wn * 64 + 32 * tn + r32; const float g = gv[n];
      float* xp = xb + (size_t)(wm * 64 + 4 * hi) * DM + n;
      float xv[2][16];
#pragma unroll
      for (int tm = 0; tm < 2; ++tm)
#pragma unroll
        for (int r = 0; r < 16; ++r) xv[tm][r] = xp[(size_t)(32 * tm + (r & 3) + 8 * (r >> 2)) * DM];
#pragma unroll
      for (int tm = 0; tm < 2; ++tm)
#pragma unroll
        for (int r = 0; r < 16; ++r) xp[(size_t)(32 * tm + (r & 3) + 8 * (r >> 2)) * DM] = xv[tm][r] + g * acc[tm][tn][r];
    }
    s = s2; mt = mt2; nt = nt2;
  }
}

static __device__ __forceinline__ void phase_ffn_up(const P& p, int l, char* lds) {
  const int tid = otid(), lane = tid & 63, wid = tid >> 6, r32 = lane & 31, hi = lane >> 5, wm = wid >> 1, wn = wid & 1, lr = tid >> 3;
  const u16* H = (const u16*)(p.ws + OFF_H); const u16* W = wl(p, l) + W_UP; u16* act = (u16*)(p.ws + OFF_ACT);
  const float* cw = p.conv_w + (size_t)l * 3 * 5632; const float* cb = p.conv_b + (size_t)l * 5632;
  char* tile = lds + LDS_SCR;
  const int MEND = l == NLAYER - 1 ? MLAT : MTOT;
  const int RT = (MEND + 253) / 254;
  const int ns = tile_steps(RT, 44, 8, 4);
  u32x4 ra0[4], rb0[2], ra1[4], rb1[2];
  LdRows al, bl; int rt, nt;
  auto mk = [&](int rt_, int nt_, LdRows& a_, LdRows& b_) {
    const int ts_ = 254 * rt_ - 1;
#pragma unroll
    for (int j = 0; j < 4; ++j) { const int tt = ts_ + lr + 64 * j; a_.p[j] = (tt >= 0 && tt < MTOT) ? H + (size_t)tt * 1024 : (const u16*)(p.ws + OFF_ZERO); }
#pragma unroll
    for (int j = 0; j < 2; ++j) b_.p[j] = W + (size_t)(nt_ * 128 + lr + 64 * j) * 1024;
    b_.p[2] = b_.p[3] = b_.p[0];
  };
  int s = tile_next(0, ns, RT, 44, 8, 4, rt, nt);
  if (s >= 0) { mk(rt, nt, al, bl); gemm_issue<4, 2>(tid, al, bl, 16, ra0, rb0, ra1, rb1); }
  while (s >= 0) {
    const int tstart = 254 * rt - 1;
    f32x16 acc[2][2]; zero_acc(acc);
    __syncthreads();
    gemm_run<4, 2, 2, 2>(tid, lds + LDS_SCR, al, bl, 16, acc, ra0, rb0, ra1, rb1);
    int rt2 = 0, nt2 = 0; const int s2 = tile_next(s + 1, ns, RT, 44, 8, 4, rt2, nt2);
    if (s2 >= 0) { mk(rt2, nt2, al, bl); gemm_issue<4, 2>(tid, al, bl, 16, ra0, rb0, ra1, rb1); }
#pragma unroll
    for (int tm = 0; tm < 2; ++tm) {
      char* trow = tile + (wm * 64 + 32 * tm + r32) * 528;
#pragma unroll
      for (int tn = 0; tn < 2; ++tn)
#pragma unroll
        for (int rg = 0; rg < 4; ++rg) { f32x4 v = {acc[tm][tn][4 * rg], acc[tm][tn][4 * rg + 1], acc[tm][tn][4 * rg + 2], acc[tm][tn][4 * rg + 3]}; *(f32x4*)(trow + (wn * 64 + 32 * tn + 8 * rg + 4 * hi) * 4) = v; }
    }
    __syncthreads();
    {
      const int cgp = tid & 7, wn2 = cgp >> 2, j0 = (cgp & 3) * 8;
      const int ca0 = nt * 64 + wn2 * 32 + j0;
      const int lca = (wn2 * 64 + j0) * 4, lcg = lca + 128;
      float wa0[8], wa1[8], wa2[8], ba[8], wg0[8], wg1[8], wg2[8], bg[8];
#pragma unroll
      for (int e = 0; e < 8; ++e) {
        wa0[e] = cw[ca0 + e]; wa1[e] = cw[5632 + ca0 + e]; wa2[e] = cw[2 * 5632 + ca0 + e]; ba[e] = cb[ca0 + e];
        wg0[e] = cw[DFF + ca0 + e]; wg1[e] = cw[5632 + DFF + ca0 + e]; wg2[e] = cw[2 * 5632 + DFF + ca0 + e]; bg[e] = cb[DFF + ca0 + e];
      }
#pragma unroll
      for (int jj = 0; jj < 4; ++jj) {
        const int r = (tid >> 3) + 64 * jj, tt = tstart + r;
        if (r >= 1 && r <= 254 && tt < MEND) {
          const int pos = tt < MLAT ? (tt & (TLAT - 1)) : ((tt - MLAT) & (TCTX - 1)), slen = tt < MLAT ? TLAT : TCTX;
          const float fm = pos == 0 ? 0.f : 1.f, fp = pos == slen - 1 ? 0.f : 1.f;
          const char* rp = tile + r * 528;
          float o[8];
#pragma unroll
          for (int hf = 0; hf < 2; ++hf) {
            const f32x4 am = *(const f32x4*)(rp - 528 + lca + hf * 16), a0 = *(const f32x4*)(rp + lca + hf * 16), ap = *(const f32x4*)(rp + 528 + lca + hf * 16);
            const f32x4 gm = *(const f32x4*)(rp - 528 + lcg + hf * 16), g0 = *(const f32x4*)(rp + lcg + hf * 16), gp = *(const f32x4*)(rp + 528 + lcg + hf * 16);
#pragma unroll
            for (int e = 0; e < 4; ++e) {
              const int q = hf * 4 + e;
              const float ua = wa0[q] * (fm * am[e]) + wa1[q] * a0[e] + wa2[q] * (fp * ap[e]) + ba[q];
              const float ug = wg0[q] * (fm * gm[e]) + wg1[q] * g0[e] + wg2[q] * (fp * gp[e]) + bg[q];
              o[q] = silu_f(ug) * ua;
            }
          }
          u32x4 w = {pk2(o[0], o[1]), pk2(o[2], o[3]), pk2(o[4], o[5]), pk2(o[6], o[7])};
          *(u32x4*)(act + (size_t)tt * DFF + ca0) = w;
        }
      }
    }
    s = s2; rt = rt2; nt = nt2;
  }
}

__global__ void __launch_bounds__(NTHREADS) fwd_kernel(P p) {
  extern __shared__ __attribute__((aligned(16))) char lds[];
  cg::grid_group grid = cg::this_grid();
  phase_pre(p);
  grid.sync();
  phase0(p, lds);
  grid.sync();
  for (int l = 0; l < NLAYER; ++l) {
    phase_norm(p, l, 0);
    grid.sync();
    phase_inproj(p, l, lds);
    grid.sync();
    phase_mla_prep(p, l, lds);
    phase_s5_states(p, l, lds);
    grid.sync();
    phase_attn(p, l, lds);
    grid.sync();
    phase_s5_out(p, l, lds);
    grid.sync();
    phase_glu(p, l, lds);
    grid.sync();
    phase_resid_gemm(p, l, (const u16*)(p.ws + OFF_MIX), wl(p, l) + W_OUT, 1024, 2048, lds);
    grid.sync();
    phase_norm(p, l, 1);
    grid.sync();
    phase_ffn_up(p, l, lds);
    grid.sync();
    phase_resid_gemm(p, l, (const u16*)(p.ws + OFF_ACT), wl(p, l) + W_DN, DFF, 5120, lds);
    grid.sync();
  }
}

extern "C" void kernel_launch(void* const* d_in, const int* in_sizes, int n_in, void* d_out, int out_size, void* d_ws, size_t ws_size, hipStream_t stream) {
  static int grid_blocks = 0;
  if (!grid_blocks) {
    if (ws_size < WS_NEED) { fprintf(stderr, "kernel_launch: workspace too small: %zu < %zu\n", ws_size, (size_t)WS_NEED); return; }
    if (hipFuncSetAttribute((const void*)fwd_kernel, hipFuncAttributeMaxDynamicSharedMemorySize, LDS_TOTAL) != hipSuccess) { fprintf(stderr, "kernel_launch: LDS attribute failed\n"); return; }
    int dev = 0, cus = 0, per_cu = 0;
    hipGetDevice(&dev);
    hipDeviceGetAttribute(&cus, hipDeviceAttributeMultiprocessorCount, dev);
    hipOccupancyMaxActiveBlocksPerMultiprocessor(&per_cu, fwd_kernel, NTHREADS, LDS_TOTAL);
    if (per_cu < 1) { fprintf(stderr, "kernel_launch: occupancy 0\n"); return; }
    grid_blocks = cus;
  }
  P p{};
  const float** fp = (const float**)&p;
  for (int i = 0; i < 33; ++i) fp[i] = (const float*)d_in[i];
  p.out = (float*)d_out; p.ws = (char*)d_ws;
  void* args[] = {&p};
  hipError_t e = hipLaunchCooperativeKernel((void*)fwd_kernel, dim3(grid_blocks), dim3(NTHREADS), args, LDS_TOTAL, stream);
  if (e != hipSuccess) fprintf(stderr, "cooperative launch failed: %s (grid %d)\n", hipGetErrorString(e), grid_blocks);
}
```

```cpp
#include <hip/hip_runtime.h>
#include <hip/hip_cooperative_groups.h>
#include <cstdio>
#include <cstdint>
namespace cg = cooperative_groups;

typedef unsigned short u16;
typedef short bf16x8 __attribute__((ext_vector_type(8)));
typedef short s16x4 __attribute__((ext_vector_type(4)));
typedef float f32x16 __attribute__((ext_vector_type(16)));
typedef float f32x4 __attribute__((ext_vector_type(4)));
typedef float f32x2 __attribute__((ext_vector_type(2)));
typedef unsigned u32x4 __attribute__((ext_vector_type(4)));
typedef unsigned u32x2 __attribute__((ext_vector_type(2)));
typedef __bf16 bf16x2_t __attribute__((ext_vector_type(2)));
#define DI __device__ __forceinline__
#define LAS __attribute__((address_space(3)))

constexpr int DM = 1024, NBATCH = 8, TLAT = 8192, NLAYER = 4, TCTX = 256;
constexpr int MLAT = NBATCH * TLAT, MCTX = NBATCH * TCTX, MTOT = MLAT + MCTX;
constexpr int PROJ_LD = 928, DFF = 2816;
constexpr float EPS = 1e-6f, LOG2E = 1.4426950408889634f;
constexpr int NTHREADS = 512;
constexpr int PITCH = 144;
constexpr int LDS_SCR = 2048;
constexpr int LDS_FRONT = 256;
constexpr int LDS_TOTAL = LDS_FRONT + LDS_SCR + 256 * 528;

constexpr size_t al256(size_t x) { return (x + 255) / 256 * 256; }
constexpr size_t OFF_CTXX = 0;
constexpr size_t OFF_MOD = OFF_CTXX + (size_t)MCTX * DM * 4;
constexpr size_t OFF_ROPE = OFF_MOD + al256((size_t)NLAYER * 9 * 6144 * 4);
constexpr size_t ROPE_COSA = 0, ROPE_SINA = (size_t)TLAT * 16 * 4, ROPE_COSS = 2 * ROPE_SINA, ROPE_SINS = ROPE_COSS + (size_t)TLAT * 32 * 4;
constexpr size_t OFF_S5PW = OFF_ROPE + 2 * (size_t)TLAT * 16 * 4 + 2 * (size_t)TLAT * 32 * 4;
constexpr size_t OFF_S5Q = OFF_S5PW + (size_t)NLAYER * 2 * 16 * 64 * 65 * 16;
constexpr size_t OFF_W = OFF_S5Q + (size_t)NLAYER * 2 * 16 * 64 * 16;
constexpr size_t W_IN = 0, W_OUT = W_IN + (size_t)1664 * 1024, W_UP = W_OUT + (size_t)1024 * 1024, W_DN = W_UP + (size_t)5632 * 1024,
                 W_UQ = W_DN + (size_t)1024 * 2816, W_UKV = W_UQ + (size_t)576 * 384, W_GLU = W_UKV + (size_t)768 * 256, W_LAYER = W_GLU + (size_t)256 * 256;
constexpr size_t OFF_S5T = OFF_W + (size_t)NLAYER * W_LAYER * 2;
constexpr size_t S5_KC = 0, S5_BST = S5_KC + (size_t)16 * 127 * 256, S5_MRD = S5_BST + (size_t)16 * 256 * 1024, S5_LAYER = S5_MRD + (size_t)16 * 1024 * 256;
constexpr size_t OFF_H = OFF_S5T + (size_t)NLAYER * S5_LAYER * 2;
constexpr size_t OFF_MIX = OFF_H + (size_t)MTOT * 1024 * 2;
constexpr size_t OFF_SST = OFF_MIX + (size_t)MTOT * 1024 * 2;
constexpr size_t OFF_HIN = OFF_SST + (size_t)1056 * 16 * 256 * 4;
constexpr size_t OFF_ZB = OFF_HIN + (size_t)1056 * 16 * 256 * 2;
constexpr size_t OFF_BIG = OFF_ZB + (size_t)MTOT * 256 * 2;
constexpr size_t OFF_PROJ = OFF_BIG;
constexpr size_t OFF_QM = OFF_PROJ + (size_t)MTOT * PROJ_LD * 2;
constexpr size_t OFF_KM = OFF_QM + (size_t)MTOT * 576 * 2;
constexpr size_t OFF_VM = OFF_KM + (size_t)MTOT * 576 * 2;
constexpr size_t OFF_QS = OFF_VM + (size_t)MTOT * 384 * 2;
constexpr size_t OFF_KS = OFF_QS + (size_t)MTOT * 384 * 2;
constexpr size_t OFF_VS = OFF_KS + (size_t)MTOT * 128 * 2;
constexpr size_t OFF_END1 = OFF_VS + (size_t)MTOT * 128 * 2;
constexpr size_t OFF_ACT = OFF_BIG;
constexpr size_t OFF_END2 = OFF_ACT + (size_t)MTOT * DFF * 2;
constexpr size_t OFF_ZERO = OFF_END1 > OFF_END2 ? OFF_END1 : OFF_END2;
constexpr size_t OFF_BAR = OFF_ZERO + 8192;
constexpr size_t WS_NEED = OFF_BAR + 16384;

struct P {
  const float *x, *c, *ctx, *c_ctx, *w_mod, *b_mod, *norm1, *w_in, *q_lora_g, *w_uq, *kv_lora_g, *w_ukv, *q_norm, *k_norm, *a_re, *a_im, *log_dt, *b_re, *b_im, *c_re,
      *c_im, *s5_d, *w_glu, *b_glu, *sq_norm, *sk_norm, *sink, *w_out, *norm2, *w_up, *conv_w, *conv_b, *w_down;
  float* out;
  char* ws;
};

DI unsigned pk2(float a, float b) { f32x2 v = {a, b}; bf16x2_t r = __builtin_convertvector(v, bf16x2_t); return __builtin_bit_cast(unsigned, r); }
DI float bflo(unsigned w) { return __uint_as_float(w << 16); }
DI float bfhi(unsigned w) { return __uint_as_float(w & 0xffff0000u); }
DI int otid() { int t = threadIdx.x; asm volatile("" : "+v"(t)); return t; }
DI int crow(int r, int hi) { return (r & 3) + 8 * (r >> 2) + 4 * hi; }
DI f32x16 mfma(bf16x8 a, bf16x8 b, f32x16 c) { return __builtin_amdgcn_mfma_f32_32x32x16_bf16(a, b, c, 0, 0, 0); }
DI float ex2(float x) { return __builtin_amdgcn_exp2f(x); }
DI float rcpf_(float x) { return __builtin_amdgcn_rcpf(x); }
DI float xsum32(float v) { auto rr = __builtin_amdgcn_permlane32_swap(__float_as_uint(v), __float_as_uint(v), false, false); return __uint_as_float(rr[0]) + __uint_as_float(rr[1]); }
DI float xmax32(float v) { auto rr = __builtin_amdgcn_permlane32_swap(__float_as_uint(v), __float_as_uint(v), false, false); return fmaxf(__uint_as_float(rr[0]), __uint_as_float(rr[1])); }
DI void st4(u16* p, float a, float b, float c, float d) { u32x2 w = {pk2(a, b), pk2(c, d)}; *(u32x2*)p = w; }
DI float silu_f(float g) { return g * rcpf_(1.f + ex2(-g * LOG2E)); }
DI float sigmoid_f(float g) { return rcpf_(1.f + ex2(-g * LOG2E)); }
DI float gelu_tanh(float x) { const float u = 0.7978845608028654f * (x + 0.044715f * x * x * x); const float th = 1.f - 2.f * rcpf_(1.f + ex2(2.f * LOG2E * u)); return 0.5f * x * (1.f + th); }
DI float* xrow(const P& p, int m) { return m < MLAT ? p.out + (size_t)m * DM : (float*)(p.ws + OFF_CTXX) + (size_t)(m - MLAT) * DM; }
DI int modidx(int m) { return m < MLAT ? (m >> 13) : 8; }
DI const float* modv(const P& p, int l, int mi) { return (const float*)(p.ws + OFF_MOD) + ((size_t)l * 9 + mi) * 6144; }
DI size_t head_row(int m, int h, int H) {
  if (m < MLAT) return ((size_t)((m >> 13) * H + h) << 13) + (m & 8191);
  const int r = m - MLAT; return (size_t)NBATCH * H * TLAT + (size_t)((r >> 8) * H + h) * TCTX + (r & 255);
}
DI u16* wl(const P& p, int l) { return (u16*)(p.ws + OFF_W) + (size_t)l * W_LAYER; }
DI u16* s5t(const P& p, int l) { return (u16*)(p.ws + OFF_S5T) + (size_t)l * S5_LAYER; }
DI int s5_tokbase(int row) { return row < 1024 ? (row >> 7) * TLAT + (row & 127) * 64 : MLAT + ((row - 1024) >> 2) * TCTX + ((row - 1024) & 3) * 64; }

DI int tile_steps(int MT, int NT, int RM, int RN) {
  if (gridDim.x == 256) { const int SM = (MT + RM - 1) / RM, SN = (NT + RN - 1) / RN; return (SM * SN + 7) >> 3; }
  return (MT * NT + gridDim.x - 1) / gridDim.x;
}
DI bool tile_get(int s, int MT, int NT, int RM, int RN, int& mt, int& nt) {
  if (gridDim.x == 256) {
    const int xcd = blockIdx.x & 7, slot = blockIdx.x >> 3; const int SM = (MT + RM - 1) / RM, SN = (NT + RN - 1) / RN;
    const int st = s * 8 + xcd; if (st >= SM * SN) return false;
    mt = (st / SN) * RM + slot % RM; nt = (st % SN) * RN + slot / RM;
    return mt < MT && nt < NT;
  }
  const int it = s * gridDim.x + blockIdx.x; if (it >= MT * NT) return false;
  mt = it / NT; nt = it % NT; return true;
}

struct LdRows {
  const u16* p[4];
  DI u32x4 load(int j, int kc) const { return *(const u32x4*)(p[j] + (size_t)kc * 8); }
};
struct LdS5A {
  const u16* pu[4]; const u16* ph[4];
  DI u32x4 load(int j, int kc) const {
    const u16* q = kc < 128 ? pu[j] + (size_t)(kc >> 1) * PROJ_LD + (kc & 1) * 8 : ph[j] + (kc - 128) * 8;
    return *(const u32x4*)q;
  }
};
struct LdS5B {
  const u16* pk[2]; const u16* pm[2];
  DI u32x4 load(int j, int kc) const {
    const u16* q = kc < 128 ? pk[j] - (kc >> 1) * 256 + (kc & 1) * 8 : pm[j] + (kc - 128) * 8;
    return *(const u32x4*)q;
  }
};

template <int NA, int NB, class AL, class BL>
DI void gemm_issue(int tid, const AL& al, const BL& bl, int nk, u32x4 (&ra0)[NA], u32x4 (&rb0)[NB], u32x4 (&ra1)[NA], u32x4 (&rb1)[NB]) {
  const int lc = tid & 7, k1 = nk > 1 ? 1 : 0;
#pragma unroll
  for (int j = 0; j < NA; ++j) ra0[j] = al.load(j, lc);
#pragma unroll
  for (int j = 0; j < NB; ++j) rb0[j] = bl.load(j, lc);
#pragma unroll
  for (int j = 0; j < NA; ++j) ra1[j] = al.load(j, k1 * 8 + lc);
#pragma unroll
  for (int j = 0; j < NB; ++j) rb1[j] = bl.load(j, k1 * 8 + lc);
}
template <int WM, int WN, int TM, int TN, bool SW = false, class AL, class BL>
DI void gemm_run(int tid, char* lds, const AL& al, const BL& bl, int nk, f32x16 (&acc)[TM][TN], u32x4 (&ra0)[WM * TM / 2], u32x4 (&rb0)[WN * TN / 2], u32x4 (&ra1)[WM * TM / 2], u32x4 (&rb1)[WN * TN / 2]) {
  constexpr int BM = WM * TM * 32, BN = WN * TN * 32, NA = BM / 64, NB = BN / 64;
  constexpr int AB = BM * PITCH, STAGE = (BM + BN) * PITCH;
  const int lane = tid & 63, wid = tid >> 6, r32 = lane & 31, hi = lane >> 5;
  const int wm = wid / WN, wn = wid % WN, lr = tid >> 3, lc = tid & 7;
  char* const wa = lds + lr * PITCH + lc * 16;
  const int aoff = (wm * TM * 32 + r32) * PITCH + hi * 16;
  const int boff = AB + (wn * TN * 32 + r32) * PITCH + hi * 16;
#define GLOAD(RA, RB, KT) do { const int kc_ = (KT) * 8 + lc; _Pragma("unroll") for (int j = 0; j < NA; ++j) RA[j] = al.load(j, kc_); _Pragma("unroll") for (int j = 0; j < NB; ++j) RB[j] = bl.load(j, kc_); } while (0)
#define LWRITE(RA, RB, BUF) do { char* w_ = wa + (BUF) * STAGE; _Pragma("unroll") for (int j = 0; j < NA; ++j) *(u32x4*)(w_ + j * 64 * PITCH) = RA[j]; _Pragma("unroll") for (int j = 0; j < NB; ++j) *(u32x4*)(w_ + AB + j * 64 * PITCH) = RB[j]; } while (0)
#define COMPUTE(BUF, RA, RB, WBUF) do { const char* sb = lds + (BUF) * STAGE; char* w_ = wa + (WBUF) * STAGE; _Pragma("unroll") for (int ks = 0; ks < 4; ++ks) { bf16x8 wf[TN], xf[TM]; \
    _Pragma("unroll") for (int tn = 0; tn < TN; ++tn) wf[tn] = *(const bf16x8*)(sb + boff + tn * 32 * PITCH + ks * 32); \
    _Pragma("unroll") for (int tm = 0; tm < TM; ++tm) xf[tm] = *(const bf16x8*)(sb + aoff + tm * 32 * PITCH + ks * 32); \
    _Pragma("unroll") for (int tm = 0; tm < TM; ++tm) _Pragma("unroll") for (int tn = 0; tn < TN; ++tn) acc[tm][tn] = SW ? mfma(xf[tm], wf[tn], acc[tm][tn]) : mfma(wf[tn], xf[tm], acc[tm][tn]); \
    _Pragma("unroll") for (int j = 0; j < NA; ++j) if (1 + j % 3 == ks) *(u32x4*)(w_ + j * 64 * PITCH) = RA[j]; \
    _Pragma("unroll") for (int j = 0; j < NB; ++j) if (1 + (NA + j) % 3 == ks) *(u32x4*)(w_ + AB + j * 64 * PITCH) = RB[j]; } } while (0)
  const int kl = nk - 1;
  LWRITE(ra0, rb0, 0);
  __syncthreads();
#pragma unroll 1
  for (int kt = 0; kt < nk; kt += 2) {
    GLOAD(ra0, rb0, (kt + 2 < kl ? kt + 2 : kl));
    COMPUTE(0, ra1, rb1, 1);
    __syncthreads();
    if (kt + 1 >= nk) break;
    GLOAD(ra1, rb1, (kt + 3 < kl ? kt + 3 : kl));
    COMPUTE(1, ra0, rb0, 0);
    __syncthreads();
  }
#undef GLOAD
#undef LWRITE
#undef COMPUTE
}
template <int WM, int WN, int TM, int TN, bool SW = false, class AL, class BL>
DI void gemm_main(int tid, char* lds, const AL& al, const BL& bl, int nk, f32x16 (&acc)[TM][TN]) {
  constexpr int NA = WM * TM / 2, NB = WN * TN / 2;
  u32x4 ra0[NA], rb0[NB], ra1[NA], rb1[NB];
  gemm_issue<NA, NB>(tid, al, bl, nk, ra0, rb0, ra1, rb1);
  gemm_run<WM, WN, TM, TN, SW>(tid, lds, al, bl, nk, acc, ra0, rb0, ra1, rb1);
}
DI int tile_next(int s, int ns, int MT, int NT, int RM, int RN, int& mt, int& nt) {
  for (; s < ns; ++s) if (tile_get(s, MT, NT, RM, RN, mt, nt)) return s;
  return -1;
}
template <int TM, int TN> DI void zero_acc(f32x16 (&acc)[TM][TN]) {
#pragma unroll
  for (int a = 0; a < TM; ++a)
#pragma unroll
    for (int b = 0; b < TN; ++b)
#pragma unroll
      for (int r = 0; r < 16; ++r) acc[a][b][r] = 0.f;
}

struct dc { double re, im; };
DI dc cmul(dc a, dc b) { return {a.re * b.re - a.im * b.im, a.re * b.im + a.im * b.re}; }

static __device__ __forceinline__ void phase_pre(const P& p) {
  const int gt = blockIdx.x * NTHREADS + threadIdx.x;
  if (gt < 512) ((u32x4*)(p.ws + OFF_ZERO))[gt] = u32x4{0, 0, 0, 0};
  if (gt < NLAYER * 2 * 16 * 64) {
    const int ldg = gt >> 6;
    const double lre = p.a_re[gt], lim = p.a_im[gt];
    const double dt = exp((double)p.log_dt[ldg]);
    double s, c; sincos(lim * dt, &s, &c);
    const double e = exp(lre * dt);
    const dc a = {e * c, e * s};
    const double den = lre * lre + lim * lim;
    const dc am1 = {a.re - 1.0, a.im};
    const dc q = {(am1.re * lre + am1.im * lim) / den, (am1.im * lre - am1.re * lim) / den};
    dc* pw = (dc*)(p.ws + OFF_S5PW) + (size_t)gt * 65;
    dc r = {1.0, 0.0};
    for (int k = 0; k <= 64; ++k) { pw[k] = r; r = cmul(r, a); }
    ((dc*)(p.ws + OFF_S5Q))[gt] = q;
  }
}

DI int nmap_in(int n) { return n < 640 ? n : (n < 1536 ? n + 32 : n - 896); }
DI int nmap_up(int n) { const int q = n >> 6, r = n & 63; return r < 32 ? 32 * q + r : DFF + 32 * q + (r - 32); }

static __device__ __forceinline__ void transpose_tile(const float* src, int ldsrc, int K, int Nd, int nmap, const float* kscale, u16* dst, int kt, int ntile, char* lds) {
  float* tile = (float*)lds;
  const int tid = threadIdx.x;
  __syncthreads();
  {
    const int n = tid & 63, kk = tid >> 6;
    const int nd = ntile * 64 + n;
    const int ns = nmap == 1 ? nmap_in(nd) : (nmap == 2 ? nmap_up(nd) : nd);
#pragma unroll
    for (int j = 0; j < 8; ++j) {
      const int k = kk + 8 * j, kg = kt * 64 + k;
      float v = 0.f;
      if (nd < Nd) { v = src[(size_t)kg * ldsrc + ns]; if (kscale) v *= kscale[kg]; }
      tile[k * 65 + n] = v;
    }
  }
  __syncthreads();
  {
    const int n = tid >> 3, kc = tid & 7, nd = ntile * 64 + n;
    if (nd < Nd) {
      const float* t = tile + (kc * 8) * 65 + n;
      u32x4 w = {pk2(t[0], t[65]), pk2(t[130], t[195]), pk2(t[260], t[325]), pk2(t[390], t[455])};
      *(u32x4*)(dst + (size_t)nd * K + kt * 64 + kc * 8) = w;
    }
  }
}

static __device__ __forceinline__ void mod_item(const P& p, int it, char* lds) {
  const int l = it / 96, n0 = (it % 96) * 64, tid = threadIdx.x;
  float* sv = (float*)lds;
  float* red = sv + 9 * 1024;
  __syncthreads();
  for (int i = tid; i < 9 * 1024; i += NTHREADS) { const int j = i >> 10, k = i & 1023; const float v = j < 8 ? p.c[j * 1024 + k] : p.c_ctx[k]; sv[i] = v / (1.f + expf(-v)); }
  __syncthreads();
  const int c = tid & 63, kg = tid >> 6;
  float acc[9];
#pragma unroll
  for (int j = 0; j < 9; ++j) acc[j] = 0.f;
  const float* w = p.w_mod + ((size_t)l * 1024 + kg * 128) * 6144 + n0 + c;
  for (int kk = 0; kk < 128; ++kk) {
    const float wv = w[(size_t)kk * 6144];
#pragma unroll
    for (int j = 0; j < 9; ++j) acc[j] += sv[j * 1024 + kg * 128 + kk] * wv;
  }
#pragma unroll
  for (int j = 0; j < 9; ++j) red[(kg * 9 + j) * 64 + c] = acc[j];
  __syncthreads();
  for (int q = tid; q < 576; q += NTHREADS) {
    const int j = q >> 6, cc = q & 63; float s = 0.f;
#pragma unroll
    for (int g = 0; g < 8; ++g) s += red[(g * 9 + j) * 64 + cc];
    ((float*)(p.ws + OFF_MOD))[((size_t)l * 9 + j) * 6144 + n0 + cc] = s + p.b_mod[l * 6144 + n0 + cc];
  }
}

static __device__ __forceinline__ void phase0(const P& p, char* lds) {
  constexpr int NMOD = 384, TPL = 2886;
  for (int it = blockIdx.x; it < NMOD + NLAYER * TPL; it += gridDim.x) {
    if (it < NMOD) { mod_item(p, it, lds); continue; }
    const int u = it - NMOD, l = u / TPL, r = u % TPL;
    u16* W = wl(p, l);
    if (r < 400) transpose_tile(p.w_in + (size_t)l * 1024 * 1568, 1568, 1024, 1568, 1, nullptr, W + W_IN, r / 25, r % 25, lds);
    else if (r < 656) { const int q = r - 400; transpose_tile(p.w_out + (size_t)l * 1024 * 1024, 1024, 1024, 1024, 0, nullptr, W + W_OUT, q / 16, q % 16, lds); }
    else if (r < 2064) { const int q = r - 656; transpose_tile(p.w_up + (size_t)l * 1024 * 5632, 5632, 1024, 5632, 2, nullptr, W + W_UP, q / 88, q % 88, lds); }
    else if (r < 2768) { const int q = r - 2064; transpose_tile(p.w_down + (size_t)l * 2816 * 1024, 1024, 2816, 1024, 0, nullptr, W + W_DN, q / 16, q % 16, lds); }
    else if (r < 2822) { const int q = r - 2768; transpose_tile(p.w_uq + (size_t)l * 384 * 576, 576, 384, 576, 0, p.q_lora_g + l * 384, W + W_UQ, q / 9, q % 9, lds); }
    else if (r < 2870) { const int q = r - 2822; transpose_tile(p.w_ukv + (size_t)l * 256 * 768, 768, 256, 768, 0, p.kv_lora_g + l * 256, W + W_UKV, q / 12, q % 12, lds); }
    else { const int q = r - 2870; transpose_tile(p.w_glu + (size_t)l * 256 * 256, 256, 256, 256, 0, nullptr, W + W_GLU, q / 4, q % 4, lds); }
  }
  const size_t gt = (size_t)blockIdx.x * NTHREADS + threadIdx.x, gn = (size_t)gridDim.x * NTHREADS;
  for (size_t i = gt; i < (size_t)MLAT * DM / 4; i += gn) ((f32x4*)p.out)[i] = ((const f32x4*)p.x)[i];
  for (size_t i = gt; i < (size_t)MCTX * DM / 4; i += gn) ((f32x4*)(p.ws + OFF_CTXX))[i] = ((const f32x4*)p.ctx)[i];
  for (size_t i = gt; i < (size_t)TLAT * 48; i += gn) {
    const int t = (int)(i / 48), j = (int)(i % 48);
    const int row = t >> 6, col = t & 63;
    int pos; double ex; float* cd; float* sd;
    if (j < 16) { const int f = j & 7; pos = j < 8 ? row : col; ex = -(double)f / 8.0; cd = (float*)(p.ws + OFF_ROPE + ROPE_COSA) + t * 16 + j; sd = (float*)(p.ws + OFF_ROPE + ROPE_SINA) + t * 16 + j; }
    else { const int jj = j - 16, f = jj & 15; pos = jj < 16 ? row : col; ex = -(double)f / 16.0; cd = (float*)(p.ws + OFF_ROPE + ROPE_COSS) + t * 32 + jj; sd = (float*)(p.ws + OFF_ROPE + ROPE_SINS) + t * 32 + jj; }
    const float inv = (float)exp(ex * 9.210340371976184);
    const float ang = (float)pos * inv;
    double s, c; sincos((double)ang, &s, &c);
    *cd = (float)c; *sd = (float)s;
  }
  const dc* PW = (const dc*)(p.ws + OFF_S5PW); const dc* QQ = (const dc*)(p.ws + OFF_S5Q);
  for (size_t i = gt; i < (size_t)NLAYER * 16 * 127 * 16; i += gn) {
    const int ii = (int)(i & 15); const int rest = (int)(i >> 4); const int dd = rest % 127, lg = rest / 127, g = lg & 15, l = lg >> 4;
    const int d = dd - 63;
    double acc[16];
#pragma unroll
    for (int o = 0; o < 16; ++o) acc[o] = 0.0;
    for (int dir = 0; dir < 2; ++dir) {
      if ((dir == 0 && d < 0) || (dir == 1 && d > 0)) continue;
      const int base = ((l * 2 + dir) * 16 + g) * 64; const int ad = d < 0 ? -d : d;
      const float* cr = p.c_re + (size_t)((l * 2 + dir) * 16 + g) * 16 * 64; const float* ci_ = p.c_im + (size_t)((l * 2 + dir) * 16 + g) * 16 * 64;
      for (int pp = 0; pp < 64; ++pp) {
        const dc a = PW[(size_t)(base + pp) * 65 + ad], q = QQ[base + pp];
        const size_t bi = (size_t)(base + pp) * 16 + ii; const dc B = {(double)p.b_re[bi], (double)p.b_im[bi]};
        const dc t1 = cmul(cmul(a, q), B);
#pragma unroll
        for (int o = 0; o < 16; ++o) acc[o] += (double)cr[o * 64 + pp] * t1.re - (double)ci_[o * 64 + pp] * t1.im;
      }
    }
    if (d == 0) acc[ii] += (double)p.s5_d[l * 256 + g * 16 + ii];
    u16* dst = s5t(p, l) + S5_KC + (size_t)(g * 127 + dd) * 256 + ii;
#pragma unroll
    for (int o = 0; o < 16; ++o) dst[o * 16] = (u16)(pk2((float)acc[o], 0.f) & 0xffff);
  }
  for (size_t i = gt; i < (size_t)NLAYER * 16 * 256 * 1024; i += gn) {
    const int k = (int)(i & 1023), n = (int)((i >> 10) & 255), g = (int)((i >> 18) & 15), l = (int)(i >> 22);
    const int dir = n >> 7, pp = (n >> 1) & 63, reim = n & 1, s = k >> 4, ii = k & 15;
    const int base = ((l * 2 + dir) * 16 + g) * 64 + pp; const int e = dir == 0 ? 63 - s : s;
    const size_t bi = (size_t)base * 16 + ii; const dc B = {(double)p.b_re[bi], (double)p.b_im[bi]};
    const dc v = cmul(cmul(PW[(size_t)base * 65 + e], QQ[base]), B);
    (s5t(p, l) + S5_BST)[((size_t)g * 256 + n) * 1024 + k] = (u16)(pk2((float)(reim ? v.im : v.re), 0.f) & 0xffff);
  }
  for (size_t i = gt; i < (size_t)NLAYER * 16 * 1024 * 256; i += gn) {
    const int k = (int)(i & 255), n = (int)((i >> 8) & 1023), g = (int)((i >> 18) & 15), l = (int)(i >> 22);
    const int dir = k >> 7, pp = (k >> 1) & 63, reim = k & 1, t = n >> 4, o = n & 15;
    const int base = ((l * 2 + dir) * 16 + g) * 64 + pp; const int e = dir == 0 ? t + 1 : 64 - t;
    const size_t ci = ((size_t)(((l * 2 + dir) * 16 + g) * 16 + o)) * 64 + pp; const dc C = {(double)p.c_re[ci], (double)p.c_im[ci]};
    const dc v = cmul(C, PW[(size_t)base * 65 + e]);
    (s5t(p, l) + S5_MRD)[((size_t)g * 1024 + n) * 256 + k] = (u16)(pk2((float)(reim ? -v.im : v.re), 0.f) & 0xffff);
  }
}

static __device__ __forceinline__ void phase_norm(const P& p, int l, int which) {
  const int tid = otid(), lane = tid & 63, wid = tid >> 6;
  const float* gw = (which ? p.norm2 : p.norm1) + l * 1024;
  u16* H = (u16*)(p.ws + OFF_H);
  const int mend = (which == 1 && l == NLAYER - 1) ? MLAT : MTOT;
  for (int m = blockIdx.x * 8 + wid; m < mend; m += gridDim.x * 8) {
    const float* xr = xrow(p, m);
    const float* mv = modv(p, l, modidx(m)) + which * 3072;
    f32x4 v[4]; float ss = 0.f;
#pragma unroll
    for (int j = 0; j < 4; ++j) { v[j] = *(const f32x4*)(xr + j * 256 + lane * 4); ss += v[j][0] * v[j][0] + v[j][1] * v[j][1] + v[j][2] * v[j][2] + v[j][3] * v[j][3]; }
#pragma unroll
    for (int o = 32; o > 0; o >>= 1) ss += __shfl_xor(ss, o);
    const float rs = rsqrtf(ss * (1.f / 1024.f) + EPS);
    f32x4 gq[4], shq[4], scq[4];
#pragma unroll
    for (int j = 0; j < 4; ++j) { const int c = j * 256 + lane * 4; gq[j] = *(const f32x4*)(gw + c); shq[j] = *(const f32x4*)(mv + c); scq[j] = *(const f32x4*)(mv + 1024 + c); }
#pragma unroll
    for (int j = 0; j < 4; ++j) {
      const int c = j * 256 + lane * 4;
      float o[4];
#pragma unroll
      for (int e = 0; e < 4; ++e) o[e] = v[j][e] * rs * gq[j][e] * (1.f + scq[j][e]) + shq[j][e];
      st4(H + (size_t)m * 1024 + c, o[0], o[1], o[2], o[3]);
    }
  }
}

static __device__ __forceinline__ void phase_inproj(const P& p, int l, char* lds) {
  const int tid = otid(), lane = tid & 63, wid = tid >> 6, r32 = lane & 31, hi = lane >> 5, wm = wid >> 1, wn = wid & 1, lr = tid >> 3;
  const u16* H = (const u16*)(p.ws + OFF_H); const u16* W = wl(p, l) + W_IN;
  u16* proj = (u16*)(p.ws + OFF_PROJ);
  const float* cosS = (const float*)(p.ws + OFF_ROPE + ROPE_COSS); const float* sinS = (const float*)(p.ws + OFF_ROPE + ROPE_SINS);
  const int ns = tile_steps(264, 12, 16, 2);
  u32x4 ra0[4], rb0[2], ra1[4], rb1[2];
  LdRows al, bl; int mt, nt;
  auto mk = [&](int mt_, int nt_, LdRows& a_, LdRows& b_) {
#pragma unroll
    for (int j = 0; j < 4; ++j) a_.p[j] = H + (size_t)(mt_ * 256 + lr + 64 * j) * 1024;
#pragma unroll
    for (int j = 0; j < 2; ++j) b_.p[j] = W + (size_t)(nt_ * 128 + lr + 64 * j) * 1024;
    b_.p[2] = b_.p[3] = b_.p[0];
  };
  int s = tile_next(0, ns, 264, 12, 16, 2, mt, nt);
  if (s >= 0) { mk(mt, nt, al, bl); gemm_issue<4, 2>(tid, al, bl, 16, ra0, rb0, ra1, rb1); }
  while (s >= 0) {
    f32x16 acc[2][2]; zero_acc(acc);
    __syncthreads();
    gemm_run<4, 2, 2, 2>(tid, lds + LDS_SCR, al, bl, 16, acc, ra0, rb0, ra1, rb1);
    int mt2 = 0, nt2 = 0; const int s2 = tile_next(s + 1, ns, 264, 12, 16, 2, mt2, nt2);
    if (s2 >= 0) { mk(mt2, nt2, al, bl); gemm_issue<4, 2>(tid, al, bl, 16, ra0, rb0, ra1, rb1); }
    const int n0w = nt * 128 + wn * 64, mw = mt * 256 + wm * 64;
    if (n0w < 896) {
#pragma unroll
      for (int tm = 0; tm < 2; ++tm) {
        const int m = mw + 32 * tm + r32;
        u16* dst = proj + (size_t)m * PROJ_LD + n0w;
#pragma unroll
        for (int tn = 0; tn < 2; ++tn) {
#pragma unroll
          for (int rg = 0; rg < 4; ++rg) st4(dst + 32 * tn + 8 * rg + 4 * hi, acc[tm][tn][4 * rg], acc[tm][tn][4 * rg + 1], acc[tm][tn][4 * rg + 2], acc[tm][tn][4 * rg + 3]);
        }
      }
    } else if (n0w < 1408) {
      const bool isq = n0w < 1280; const int head = isq ? (n0w - 896) >> 6 : (n0w - 1280) >> 6;
      const float* g = (isq ? p.sq_norm : p.sk_norm) + l * 64;
      u16* dbase = (u16*)(p.ws + (isq ? OFF_QS : OFF_KS));
      const float osc = isq ? 0.125f * LOG2E : 1.f;
#pragma unroll
      for (int tm = 0; tm < 2; ++tm) {
        const int m = mw + 32 * tm + r32;
        float ss = 0.f;
#pragma unroll
        for (int r = 0; r < 16; ++r) ss += acc[tm][0][r] * acc[tm][0][r] + acc[tm][1][r] * acc[tm][1][r];
        ss = xsum32(ss);
        const float rs = rsqrtf(ss * (1.f / 64.f) + EPS);
        u16* dst = dbase + head_row(m, head, isq ? 6 : 2) * 64;
        const bool lat = m < MLAT; const int t = m & 8191;
        f32x4 g1q[4], g2q[4], csq[4], snq[4];
#pragma unroll
        for (int rg = 0; rg < 4; ++rg) {
          const int d = 8 * rg + 4 * hi;
          g1q[rg] = *(const f32x4*)(g + d); g2q[rg] = *(const f32x4*)(g + 32 + d);
          csq[rg] = f32x4{1.f, 1.f, 1.f, 1.f}; snq[rg] = f32x4{0.f, 0.f, 0.f, 0.f};
          if (lat) { csq[rg] = *(const f32x4*)(cosS + t * 32 + d); snq[rg] = *(const f32x4*)(sinS + t * 32 + d); }
        }
#pragma unroll
        for (int rg = 0; rg < 4; ++rg) {
          const int d = 8 * rg + 4 * hi;
          const f32x4 g1 = g1q[rg], g2 = g2q[rg], cs = csq[rg], sn = snq[rg];
          float y1[4], y2[4];
#pragma unroll
          for (int e = 0; e < 4; ++e) {
            const float x1 = acc[tm][0][4 * rg + e] * rs * g1[e], x2 = acc[tm][1][4 * rg + e] * rs * g2[e];
            y1[e] = (x1 * cs[e] - x2 * sn[e]) * osc; y2[e] = (x1 * sn[e] + x2 * cs[e]) * osc;
          }
          st4(dst + d, y1[0], y1[1], y1[2], y1[3]); st4(dst + 32 + d, y2[0], y2[1], y2[2], y2[3]);
        }
      }
    } else if (n0w < 1536) {
      const int head = (n0w - 1408) >> 6;
      u16* dbase = (u16*)(p.ws + OFF_VS);
#pragma unroll
      for (int tm = 0; tm < 2; ++tm) {
        const int m = mw + 32 * tm + r32;
        u16* dst = dbase + head_row(m, head, 2) * 64;
#pragma unroll
        for (int tn = 0; tn < 2; ++tn)
#pragma unroll
          for (int rg = 0; rg < 4; ++rg) st4(dst + 32 * tn + 8 * rg + 4 * hi, acc[tm][tn][4 * rg], acc[tm][tn][4 * rg + 1], acc[tm][tn][4 * rg + 2], acc[tm][tn][4 * rg + 3]);
      }
    }
    s = s2; mt = mt2; nt = nt2;
  }
  for (int it = blockIdx.x; it < 264; it += gridDim.x) {
    LdRows a2, b2;
#pragma unroll
    for (int j = 0; j < 4; ++j) a2.p[j] = H + (size_t)(it * 256 + lr + 64 * j) * 1024;
    b2.p[0] = W + (size_t)(1536 + (lr < 32 ? lr : 31)) * 1024; b2.p[1] = b2.p[2] = b2.p[3] = b2.p[0];
    f32x16 acc2[1][2]; zero_acc(acc2);
    __syncthreads();
    gemm_main<8, 1, 1, 2>(tid, lds + LDS_SCR, a2, b2, 16, acc2);
    u16* dst = proj + (size_t)(it * 256 + wid * 32 + r32) * PROJ_LD + 896;
#pragma unroll
    for (int rg = 0; rg < 4; ++rg) st4(dst + 8 * rg + 4 * hi, acc2[0][0][4 * rg], acc2[0][0][4 * rg + 1], acc2[0][0][4 * rg + 2], acc2[0][0][4 * rg + 3]);
  }
}

template <int NCOLS>
DI void lora_rstd(int tid, const u16* proj, int m0, int col0, float* scr) {
  constexpr int NCH = NCOLS / 64;
  const int sub = tid & 7, rs = tid >> 3;
  u32x4 w[4][NCH];
#pragma unroll
  for (int j = 0; j < 4; ++j) {
    const u16* src = proj + (size_t)(m0 + rs + 64 * j) * PROJ_LD + col0 + sub * 8;
#pragma unroll
    for (int c = 0; c < NCH; ++c) w[j][c] = *(const u32x4*)(src + c * 64);
  }
#pragma unroll
  for (int j = 0; j < 4; ++j) {
    float ss = 0.f;
#pragma unroll
    for (int c = 0; c < NCH; ++c)
#pragma unroll
      for (int e = 0; e < 4; ++e) { const float a = bflo(w[j][c][e]), b = bfhi(w[j][c][e]); ss += a * a + b * b; }
    ss += __shfl_xor(ss, 1); ss += __shfl_xor(ss, 2); ss += __shfl_xor(ss, 4);
    if (sub == 0) scr[rs + 64 * j] = rsqrtf(ss * (1.f / (float)NCOLS) + EPS);
  }
}

static __device__ __forceinline__ void phase_mla_prep(const P& p, int l, char* lds) {
  const int tid = otid(), lane = tid & 63, wid = tid >> 6, r32 = lane & 31, hi = lane >> 5, lr = tid >> 3;
  const u16* proj = (const u16*)(p.ws + OFF_PROJ);
  float* scr = (float*)lds;
  const float* cosA = (const float*)(p.ws + OFF_ROPE + ROPE_COSA); const float* sinA = (const float*)(p.ws + OFF_ROPE + ROPE_SINA);
  {
    const u16* W = wl(p, l) + W_UQ; const float* g = p.q_norm + l * 96; u16* Qm = (u16*)(p.ws + OFF_QM);
    const int wm = wid >> 1, wn = wid & 1;
    const float osc = 0.10206207261596577f * LOG2E;
    for (int s = 0, ns = tile_steps(264, 3, 32, 1); s < ns; ++s) {
      int mt, nt; if (!tile_get(s, 264, 3, 32, 1, mt, nt)) continue;
      const int m0 = mt * 256;
      __syncthreads();
      lora_rstd<384>(tid, proj, m0, 0, scr);
      LdRows al, bl;
#pragma unroll
      for (int j = 0; j < 4; ++j) al.p[j] = proj + (size_t)(m0 + lr + 64 * j) * PROJ_LD;
#pragma unroll
      for (int j = 0; j < 3; ++j) bl.p[j] = W + (size_t)(nt * 192 + lr + 64 * j) * 384;
      bl.p[3] = bl.p[0];
      f32x16 acc[2][3]; zero_acc(acc);
      gemm_main<4, 2, 2, 3>(tid, lds + LDS_SCR, al, bl, 6, acc);
      const int head = nt * 2 + wn;
#pragma unroll
      for (int tm = 0; tm < 2; ++tm) {
        const int rl = wm * 64 + 32 * tm + r32, m = m0 + rl;
        const float rlo = scr[rl];
        float ss = 0.f;
#pragma unroll
        for (int tn = 0; tn < 3; ++tn)
#pragma unroll
          for (int r = 0; r < 16; ++r) ss += acc[tm][tn][r] * acc[tm][tn][r];
        ss = xsum32(ss);
        const float f = rlo * rsqrtf(rlo * rlo * ss * (1.f / 96.f) + EPS);
        u16* dst = Qm + head_row(m, head, 6) * 96;
        const bool lat = m < MLAT; const int t = m & 8191;
        f32x4 gq[2][4], r1q[2], r2q[2], csq[2], snq[2];
#pragma unroll
        for (int tn = 0; tn < 2; ++tn)
#pragma unroll
          for (int rg = 0; rg < 4; ++rg) gq[tn][rg] = *(const f32x4*)(g + 32 * tn + 8 * rg + 4 * hi);
#pragma unroll
        for (int rg = 0; rg < 2; ++rg) {
          const int j = 8 * rg + 4 * hi; r1q[rg] = *(const f32x4*)(g + 64 + j); r2q[rg] = *(const f32x4*)(g + 80 + j);
          csq[rg] = f32x4{1.f, 1.f, 1.f, 1.f}; snq[rg] = f32x4{0.f, 0.f, 0.f, 0.f};
          if (lat) { csq[rg] = *(const f32x4*)(cosA + t * 16 + j); snq[rg] = *(const f32x4*)(sinA + t * 16 + j); }
        }
#pragma unroll
        for (int tn = 0; tn < 2; ++tn)
#pragma unroll
          for (int rg = 0; rg < 4; ++rg) {
            const int d = 32 * tn + 8 * rg + 4 * hi; const f32x4 gv = gq[tn][rg];
            st4(dst + d, acc[tm][tn][4 * rg] * f * gv[0] * osc, acc[tm][tn][4 * rg + 1] * f * gv[1] * osc, acc[tm][tn][4 * rg + 2] * f * gv[2] * osc, acc[tm][tn][4 * rg + 3] * f * gv[3] * osc);
          }
#pragma unroll
        for (int rg = 0; rg < 2; ++rg) {
          const int j = 8 * rg + 4 * hi; const f32x4 g1 = r1q[rg], g2 = r2q[rg], cs = csq[rg], sn = snq[rg];
          float y1[4], y2[4];
#pragma unroll
          for (int e = 0; e < 4; ++e) {
            const float x1 = acc[tm][2][4 * rg + e] * f * g1[e], x2 = acc[tm][2][8 + 4 * rg + e] * f * g2[e];
            y1[e] = (x1 * cs[e] - x2 * sn[e]) * osc; y2[e] = (x1 * sn[e] + x2 * cs[e]) * osc;
          }
          st4(dst + 64 + j, y1[0], y1[1], y1[2], y1[3]); st4(dst + 80 + j, y2[0], y2[1], y2[2], y2[3]);
        }
      }
    }
  }
  {
    const u16* W = wl(p, l) + W_UKV; const float* g = p.k_norm + l * 96; u16* Km = (u16*)(p.ws + OFF_KM); u16* Vm = (u16*)(p.ws + OFF_VM);
    for (int s = 0, ns = tile_steps(264, 6, 16, 2); s < ns; ++s) {
      int mt, head; if (!tile_get(s, 264, 6, 16, 2, mt, head)) continue;
      const int m0 = mt * 256;
      __syncthreads();
      lora_rstd<256>(tid, proj, m0, 384, scr);
      LdRows al, bl;
#pragma unroll
      for (int j = 0; j < 4; ++j) al.p[j] = proj + (size_t)(m0 + lr + 64 * j) * PROJ_LD + 384;
#pragma unroll
      for (int j = 0; j < 2; ++j) bl.p[j] = W + (size_t)(head * 128 + lr + 64 * j) * 256;
      bl.p[2] = bl.p[3] = bl.p[0];
      f32x16 acc[1][4]; zero_acc(acc);
      gemm_main<8, 1, 1, 4>(tid, lds + LDS_SCR, al, bl, 4, acc);
      const int rl = wid * 32 + r32, m = m0 + rl;
      const float rlo = scr[rl];
      float ssr = 0.f; u32x4 wx1, wx2;
      {
        const u16* kp = proj + (size_t)m * PROJ_LD + 896;
        const u32x4 w0 = *(const u32x4*)(kp), w1 = *(const u32x4*)(kp + 8), w2 = *(const u32x4*)(kp + 16), w3 = *(const u32x4*)(kp + 24);
#pragma unroll
        for (int e = 0; e < 4; ++e) {
          ssr += bflo(w0[e]) * bflo(w0[e]) + bfhi(w0[e]) * bfhi(w0[e]) + bflo(w1[e]) * bflo(w1[e]) + bfhi(w1[e]) * bfhi(w1[e]);
          ssr += bflo(w2[e]) * bflo(w2[e]) + bfhi(w2[e]) * bfhi(w2[e]) + bflo(w3[e]) * bflo(w3[e]) + bfhi(w3[e]) * bfhi(w3[e]);
        }
        wx1 = hi ? w1 : w0; wx2 = hi ? w3 : w2;
      }
      float ss = 0.f;
#pragma unroll
      for (int tn = 0; tn < 2; ++tn)
#pragma unroll
        for (int r = 0; r < 16; ++r) ss += acc[0][tn][r] * acc[0][tn][r];
      ss = xsum32(ss);
      const float rk = rsqrtf((rlo * rlo * ss + ssr) * (1.f / 96.f) + EPS);
      const size_t hr = head_row(m, head, 6);
      u16* kd = Km + hr * 96; u16* vd = Vm + hr * 64;
      const bool lat = m < MLAT; const int t = m & 8191;
      f32x4 gq[2][4]; float gr1[8], gr2[8], csr[8], snr[8];
#pragma unroll
      for (int tn = 0; tn < 2; ++tn)
#pragma unroll
        for (int rg = 0; rg < 4; ++rg) gq[tn][rg] = *(const f32x4*)(g + 32 * tn + 8 * rg + 4 * hi);
#pragma unroll
      for (int e = 0; e < 8; ++e) {
        const int j = 8 * hi + e; gr1[e] = g[64 + j]; gr2[e] = g[80 + j]; csr[e] = 1.f; snr[e] = 0.f;
        if (lat) { csr[e] = cosA[t * 16 + j]; snr[e] = sinA[t * 16 + j]; }
      }
#pragma unroll
      for (int tn = 0; tn < 2; ++tn)
#pragma unroll
        for (int rg = 0; rg < 4; ++rg) {
          const int d = 32 * tn + 8 * rg + 4 * hi; const f32x4 gv = gq[tn][rg]; const float f = rlo * rk;
          st4(kd + d, acc[0][tn][4 * rg] * f * gv[0], acc[0][tn][4 * rg + 1] * f * gv[1], acc[0][tn][4 * rg + 2] * f * gv[2], acc[0][tn][4 * rg + 3] * f * gv[3]);
          st4(vd + d, acc[0][2 + tn][4 * rg] * rlo, acc[0][2 + tn][4 * rg + 1] * rlo, acc[0][2 + tn][4 * rg + 2] * rlo, acc[0][2 + tn][4 * rg + 3] * rlo);
        }
      {
        float y1[8], y2[8];
#pragma unroll
        for (int e = 0; e < 8; ++e) {
          const int j = 8 * hi + e;
          const float k1 = (e & 1) ? bfhi(wx1[e >> 1]) : bflo(wx1[e >> 1]), k2 = (e & 1) ? bfhi(wx2[e >> 1]) : bflo(wx2[e >> 1]);
          const float x1 = k1 * rk * gr1[e], x2 = k2 * rk * gr2[e];
          const float cs = csr[e], sn = snr[e];
          y1[e] = x1 * cs - x2 * sn; y2[e] = x1 * sn + x2 * cs;
        }
        u32x4 w1 = {pk2(y1[0], y1[1]), pk2(y1[2], y1[3]), pk2(y1[4], y1[5]), pk2(y1[6], y1[7])};
        u32x4 w2 = {pk2(y2[0], y2[1]), pk2(y2[2], y2[3]), pk2(y2[4], y2[5]), pk2(y2[6], y2[7])};
        *(u32x4*)(kd + 64 + 8 * hi) = w1; *(u32x4*)(kd + 80 + 8 * hi) = w2;
      }
    }
  }
}

static __device__ __forceinline__ void phase_s5_states(const P& p, int l, char* lds) {
  const int tid = otid(), lane = tid & 63, wid = tid >> 6, r32 = lane & 31, hi = lane >> 5, wm = wid >> 1, wn = wid & 1, lr = tid >> 3;
  const u16* proj = (const u16*)(p.ws + OFF_PROJ); float* Sst = (float*)(p.ws + OFF_SST);
  for (int it = blockIdx.x; it < 160; it += gridDim.x) {
    const int g = it / 10, r = it % 10, mt = r >> 1, nt = r & 1;
    LdS5A al; LdRows bl;
#pragma unroll
    for (int j = 0; j < 4; ++j) { const int row = mt * 256 + lr + 64 * j; al.pu[j] = proj + (size_t)s5_tokbase(row < 1056 ? row : 0) * PROJ_LD + 640 + g * 16; al.ph[j] = al.pu[j]; }
    const u16* B = s5t(p, l) + S5_BST + (size_t)g * 256 * 1024;
#pragma unroll
    for (int j = 0; j < 2; ++j) bl.p[j] = B + (size_t)(nt * 128 + lr + 64 * j) * 1024;
    bl.p[2] = bl.p[3] = bl.p[0];
    f32x16 acc[2][2]; zero_acc(acc);
    __syncthreads();
    gemm_main<4, 2, 2, 2>(tid, lds + LDS_SCR, al, bl, 16, acc);
#pragma unroll
    for (int tm = 0; tm < 2; ++tm) {
      const int row = mt * 256 + wm * 64 + 32 * tm + r32;
      if (row < 1056) {
        float* dst = Sst + ((size_t)row * 16 + g) * 256 + nt * 128 + wn * 64;
#pragma unroll
        for (int tn = 0; tn < 2; ++tn)
#pragma unroll
          for (int rg = 0; rg < 4; ++rg) { f32x4 v = {acc[tm][tn][4 * rg], acc[tm][tn][4 * rg + 1], acc[tm][tn][4 * rg + 2], acc[tm][tn][4 * rg + 3]}; *(f32x4*)(dst + 32 * tn + 8 * rg + 4 * hi) = v; }
      }
    }
  }
}

static __device__ __forceinline__ void s5_scan_item(const P& p, int l, int blk) {
  const int gt = blk * NTHREADS + otid();
  const int pp = gt & 63, dir = (gt >> 6) & 1, g = (gt >> 7) & 15, b = gt >> 11;
  const dc a64d = ((const dc*)(p.ws + OFF_S5PW))[(size_t)((((l * 2 + dir) * 16 + g) * 64) + pp) * 65 + 64];
  const float ar = (float)a64d.re, ai = (float)a64d.im;
  const float* Sst = (const float*)(p.ws + OFF_SST); unsigned* Hin = (unsigned*)(p.ws + OFF_HIN);
  const int col = g * 256 + dir * 128 + 2 * pp;
  float hr = 0.f, hi_ = 0.f;
#pragma unroll 1
  for (int s0 = 0; s0 < 132; s0 += 4) {
    int rows[4]; f32x2 sv[4];
#pragma unroll
    for (int e = 0; e < 4; ++e) {
      const int st = s0 + e; int row;
      if (st < 4) { const int c = dir ? 3 - st : st; row = 1024 + b * 4 + c; } else { const int s2 = st - 4; const int c = dir ? 127 - s2 : s2; row = b * 128 + c; }
      rows[e] = row; sv[e] = *(const f32x2*)(Sst + (size_t)row * 4096 + col);
    }
#pragma unroll
    for (int e = 0; e < 4; ++e) {
      Hin[((size_t)rows[e] * 4096 + col) >> 1] = pk2(hr, hi_);
      const float nr = ar * hr - ai * hi_ + sv[e][0], ni = ar * hi_ + ai * hr + sv[e][1];
      hr = nr; hi_ = ni;
    }
  }
}

static __device__ __forceinline__ void phase_s5_out(const P& p, int l, char* lds) {
  const int tid = otid(), lane = tid & 63, wid = tid >> 6, r32 = lane & 31, hi = lane >> 5, wm = wid >> 1, wn = wid & 1, lr = tid >> 3;
  const u16* proj = (const u16*)(p.ws + OFF_PROJ); const u16* Hin = (const u16*)(p.ws + OFF_HIN); u16* zb = (u16*)(p.ws + OFF_ZB);
  const int per_g = l == NLAYER - 1 ? 32 : 40;
  for (int it = blockIdx.x; it < 16 * per_g; it += gridDim.x) {
    const int g = it / per_g, r = it % per_g, mt = r >> 3, nt = r & 7;
    LdS5A al; LdS5B bl;
#pragma unroll
    for (int j = 0; j < 4; ++j) {
      const int row = mt * 256 + lr + 64 * j;
      al.pu[j] = proj + (size_t)s5_tokbase(row < 1056 ? row : 0) * PROJ_LD + 640 + g * 16;
      al.ph[j] = Hin + ((size_t)(row < 1056 ? row : 0) * 16 + g) * 256;
    }
    const u16* Kc = s5t(p, l) + S5_KC + (size_t)g * 127 * 256; const u16* Mrd = s5t(p, l) + S5_MRD + (size_t)g * 1024 * 256;
#pragma unroll
    for (int j = 0; j < 2; ++j) { const int n = nt * 128 + lr + 64 * j; bl.pk[j] = Kc + ((n >> 4) + 63) * 256 + (n & 15) * 16; bl.pm[j] = Mrd + (size_t)n * 256; }
    f32x16 acc[2][2]; zero_acc(acc);
    __syncthreads();
    gemm_main<4, 2, 2, 2>(tid, lds + LDS_SCR, al, bl, 20, acc);
#pragma unroll
    for (int tm = 0; tm < 2; ++tm) {
      const int row = mt * 256 + wm * 64 + 32 * tm + r32;
      if (row < 1056) {
        const int tb = s5_tokbase(row);
#pragma unroll
        for (int tn = 0; tn < 2; ++tn)
#pragma unroll
          for (int rg = 0; rg < 4; ++rg) {
            const int n = nt * 128 + wn * 64 + 32 * tn + 8 * rg + 4 * hi;
            u16* dst = zb + (size_t)(tb + (n >> 4)) * 256 + g * 16 + (n & 15);
            st4(dst, gelu_tanh(acc[tm][tn][4 * rg]), gelu_tanh(acc[tm][tn][4 * rg + 1]), gelu_tanh(acc[tm][tn][4 * rg + 2]), gelu_tanh(acc[tm][tn][4 * rg + 3]));
          }
      }
    }
  }
}

static __device__ __forceinline__ void phase_glu(const P& p, int l, char* lds) {
  const int tid = otid(), lane = tid & 63, wid = tid >> 6, r32 = lane & 31, hi = lane >> 5, wm = wid >> 1, wn = wid & 1, lr = tid >> 3;
  const u16* zb = (const u16*)(p.ws + OFF_ZB); const u16* W = wl(p, l) + W_GLU; u16* mix = (u16*)(p.ws + OFF_MIX); const float* bg = p.b_glu + l * 256;
  const int MT = l == NLAYER - 1 ? 256 : 264;
  for (int s = 0, ns = tile_steps(MT, 2, 16, 2); s < ns; ++s) {
    int mt, nt; if (!tile_get(s, MT, 2, 16, 2, mt, nt)) continue;
    LdRows al, bl;
#pragma unroll
    for (int j = 0; j < 4; ++j) al.p[j] = zb + (size_t)(mt * 256 + lr + 64 * j) * 256;
#pragma unroll
    for (int j = 0; j < 2; ++j) bl.p[j] = W + (size_t)(nt * 128 + lr + 64 * j) * 256;
    bl.p[2] = bl.p[3] = bl.p[0];
    f32x16 acc[2][2]; zero_acc(acc);
    __syncthreads();
    gemm_main<4, 2, 2, 2>(tid, lds + LDS_SCR, al, bl, 4, acc);
    u32x2 zq[2][2][4]; f32x4 bq[2][4];
#pragma unroll
    for (int tn = 0; tn < 2; ++tn)
#pragma unroll
      for (int rg = 0; rg < 4; ++rg) {
        const int n = nt * 128 + wn * 64 + 32 * tn + 8 * rg + 4 * hi; bq[tn][rg] = *(const f32x4*)(bg + n);
#pragma unroll
        for (int tm = 0; tm < 2; ++tm) zq[tm][tn][rg] = *(const u32x2*)(zb + (size_t)(mt * 256 + wm * 64 + 32 * tm + r32) * 256 + n);
      }
#pragma unroll
    for (int tm = 0; tm < 2; ++tm) {
      const int m = mt * 256 + wm * 64 + 32 * tm + r32;
#pragma unroll
      for (int tn = 0; tn < 2; ++tn)
#pragma unroll
        for (int rg = 0; rg < 4; ++rg) {
          const int n = nt * 128 + wn * 64 + 32 * tn + 8 * rg + 4 * hi;
          const u32x2 zw = zq[tm][tn][rg]; const f32x4 bv = bq[tn][rg];
          const float z0 = bflo(zw[0]), z1 = bfhi(zw[0]), z2 = bflo(zw[1]), z3 = bfhi(zw[1]);
          st4(mix + (size_t)m * 1024 + 384 + n, z0 * sigmoid_f(acc[tm][tn][4 * rg] + bv[0]), z1 * sigmoid_f(acc[tm][tn][4 * rg + 1] + bv[1]), z2 * sigmoid_f(acc[tm][tn][4 * rg + 2] + bv[2]),
              z3 * sigmoid_f(acc[tm][tn][4 * rg + 3] + bv[3]));
        }
    }
  }
}

template <int DQK>
DI void attn_unit(int tid, char* lds, const u16* Qp, const u16* K1, const u16* V1, int nt1, int kpos0, const u16* K2, const u16* V2, int nt2, int qpos0, bool mask, float m_init, float l_init, u16* Op) {
  constexpr int KP = DQK * 2 + 16, KB = 64 * KP, VB = 8192, SB = KB + VB, NCH = DQK / 8, NKC = 64 * NCH, ND = DQK / 16;
  const int lane = tid & 63, wid = tid >> 6, r32 = lane & 31, hi = lane >> 5;
  bf16x8 qr[ND];
  {
    const u16* qrow = Qp + (size_t)(wid * 32 + r32) * DQK + hi * 8;
#pragma unroll
    for (int d0 = 0; d0 < ND; ++d0) qr[d0] = *(const bf16x8*)(qrow + d0 * 16);
  }
  const int kk0 = tid / NCH, kc0 = tid % NCH;
  const int id1 = tid + NTHREADS; const bool has1 = id1 < NKC; const int kk1 = id1 / NCH, kc1 = id1 % NCH;
  const int idl = has1 ? id1 : tid;
  const int vkey = tid >> 3, vc = tid & 7;
  const int vst = ((vkey >> 3) * 2 + (vc >> 2)) * 512 + (vkey & 7) * 64 + (vc & 3) * 16;
  const int vrb = ((lane & 3) << 3) | (((lane >> 2) & 3) << 6) | (((lane >> 4) & 1) << 5) | (((lane >> 5) & 1) << 8);
  const int kw0 = kk0 * KP + kc0 * 16, kw1 = kk1 * KP + kc1 * 16, kro = r32 * KP + hi * 16;
  f32x16 o0, o1;
#pragma unroll
  for (int r = 0; r < 16; ++r) { o0[r] = 0.f; o1[r] = 0.f; }
  constexpr float THR = 8.f;
  float mrun = m_init, lrun = hi == 0 ? l_init : 0.f;
  f32x16 negm;
#pragma unroll
  for (int r = 0; r < 16; ++r) negm[r] = -mrun;
  const int NT = nt1 + nt2;
  const int qpos = qpos0 + wid * 32 + r32;
  u32x4 sk0, sk1, sv;
  auto gl = [&](int i) {
    const u16* kp; const u16* vp;
    if (i < nt1) { kp = K1 + (size_t)i * 64 * DQK; vp = V1 + (size_t)i * 4096; } else { kp = K2 + (size_t)(i - nt1) * 64 * DQK; vp = V2 + (size_t)(i - nt1) * 4096; }
    sk0 = *(const u32x4*)(kp + (size_t)tid * 8); sk1 = *(const u32x4*)(kp + (size_t)idl * 8); sv = *(const u32x4*)(vp + (size_t)tid * 8);
  };
  auto sw = [&](int st) {
    char* b = lds + st * SB;
    *(u32x4*)(b + kw0) = sk0; if (has1) *(u32x4*)(b + kw1) = sk1; *(u32x4*)(b + KB + vst) = sv;
  };
  auto qk = [&](int st, f32x16& p0, f32x16& p1) {
    const char* Kb = lds + st * SB + kro;
#pragma unroll
    for (int d0 = 0; d0 < ND; ++d0) {
      const bf16x8 a0 = *(const bf16x8*)(Kb + d0 * 32);
      const bf16x8 a1 = *(const bf16x8*)(Kb + 32 * KP + d0 * 32);
      if (d0 == 0) { p0 = mfma(a0, qr[0], negm); p1 = mfma(a1, qr[0], negm); } else { p0 = mfma(a0, qr[d0], p0); p1 = mfma(a1, qr[d0], p1); }
    }
  };
  const int qw0 = qpos0 + wid * 32;
  auto live = [&](int i) { if (!mask || i >= nt1) return true; const int kb = kpos0 + i * 64; return kb + 63 >= qw0 - 128 && kb <= qw0 + 31 + 128; };
  auto step = [&](f32x16& c0, f32x16& c1, f32x16& n0, f32x16& n1, int i, int s_cur, int s_nxt, int s_wr) {
    const bool has_nxt = i + 1 < NT, has_wr = i + 2 < NT;
    if (has_wr) gl(i + 2);
    if (has_nxt && live(i + 1)) qk(s_nxt, n0, n1);
    if (live(i)) {
    if (mask && i < nt1) {
      const int kb = kpos0 + i * 64 - qpos;
#pragma unroll
      for (int r = 0; r < 16; ++r) {
        const int d0_ = kb + crow(r, hi), d1_ = d0_ + 32;
        if (d0_ > 128 || d0_ < -128) c0[r] = -1e30f;
        if (d1_ > 128 || d1_ < -128) c1[r] = -1e30f;
      }
    }
    float mt = c0[0];
#pragma unroll
    for (int r = 1; r < 16; ++r) mt = fmaxf(mt, c0[r]);
#pragma unroll
    for (int r = 0; r < 16; ++r) mt = fmaxf(mt, c1[r]);
    mt = xmax32(mt);
    if (__any(mt > THR)) {
      const float delta = fmaxf(mt, 0.f), alpha = ex2(-delta);
      mrun += delta; lrun *= alpha;
#pragma unroll
      for (int r = 0; r < 16; ++r) { o0[r] *= alpha; o1[r] *= alpha; c0[r] -= delta; c1[r] -= delta; n0[r] -= delta; n1[r] -= delta; negm[r] = -mrun; }
    }
    float ls = 0.f;
#pragma unroll
    for (int r = 0; r < 16; ++r) { c0[r] = ex2(c0[r]); c1[r] = ex2(c1[r]); ls += c0[r] + c1[r]; }
    lrun += ls;
    bf16x8 pb[4];
    { u32x4 w = {pk2(c0[0], c0[1]), pk2(c0[2], c0[3]), pk2(c0[4], c0[5]), pk2(c0[6], c0[7])}; pb[0] = __builtin_bit_cast(bf16x8, w); }
    { u32x4 w = {pk2(c0[8], c0[9]), pk2(c0[10], c0[11]), pk2(c0[12], c0[13]), pk2(c0[14], c0[15])}; pb[1] = __builtin_bit_cast(bf16x8, w); }
    { u32x4 w = {pk2(c1[0], c1[1]), pk2(c1[2], c1[3]), pk2(c1[4], c1[5]), pk2(c1[6], c1[7])}; pb[2] = __builtin_bit_cast(bf16x8, w); }
    { u32x4 w = {pk2(c1[8], c1[9]), pk2(c1[10], c1[11]), pk2(c1[12], c1[13]), pk2(c1[14], c1[15])}; pb[3] = __builtin_bit_cast(bf16x8, w); }
    LAS char* Vb = (LAS char*)(lds + s_cur * SB + KB + vrb);
#pragma unroll
    for (int ks = 0; ks < 4; ++ks) {
      const s16x4 l0 = __builtin_amdgcn_ds_read_tr16_b64_v4i16((LAS s16x4*)(Vb + ((2 * ks) * 2 + 0) * 512));
      const s16x4 h0 = __builtin_amdgcn_ds_read_tr16_b64_v4i16((LAS s16x4*)(Vb + ((2 * ks + 1) * 2 + 0) * 512));
      const s16x4 l1 = __builtin_amdgcn_ds_read_tr16_b64_v4i16((LAS s16x4*)(Vb + ((2 * ks) * 2 + 1) * 512));
      const s16x4 h1 = __builtin_amdgcn_ds_read_tr16_b64_v4i16((LAS s16x4*)(Vb + ((2 * ks + 1) * 2 + 1) * 512));
      const bf16x8 va0 = {l0[0], l0[1], l0[2], l0[3], h0[0], h0[1], h0[2], h0[3]};
      const bf16x8 va1 = {l1[0], l1[1], l1[2], l1[3], h1[0], h1[1], h1[2], h1[3]};
      o0 = mfma(va0, pb[ks], o0); o1 = mfma(va1, pb[ks], o1);
    }
    }
    if (has_wr) sw(s_wr);
    __syncthreads();
  };
  gl(0); sw(0);
  if (NT > 1) { gl(1); sw(1); }
  __syncthreads();
  f32x16 pA0, pA1, pB0, pB1;
#pragma unroll
  for (int r = 0; r < 16; ++r) { pB0[r] = 0.f; pB1[r] = 0.f; }
  if (live(0)) qk(0, pA0, pA1);
  int s_cur = 0, s_nxt = 1, s_wr = 2;
#pragma unroll 1
  for (int i = 0; i < NT; i += 2) {
    step(pA0, pA1, pB0, pB1, i, s_cur, s_nxt, s_wr);
    if (i + 1 >= NT) break;
    step(pB0, pB1, pA0, pA1, i + 1, s_nxt, s_wr, s_cur);
    const int t_ = s_cur; s_cur = s_wr; s_wr = s_nxt; s_nxt = t_;
  }
  const float inv = rcpf_(xsum32(lrun));
  u16* orow = Op + (size_t)(wid * 32 + r32) * 1024;
#pragma unroll
  for (int rg = 0; rg < 4; ++rg) {
    st4(orow + 8 * rg + 4 * hi, o0[4 * rg] * inv, o0[4 * rg + 1] * inv, o0[4 * rg + 2] * inv, o0[4 * rg + 3] * inv);
    st4(orow + 32 + 8 * rg + 4 * hi, o1[4 * rg] * inv, o1[4 * rg + 1] * inv, o1[4 * rg + 2] * inv, o1[4 * rg + 3] * inv);
  }
}

static __device__ __forceinline__ void phase_attn(const P& p, int l, char* lds) {
  if (blockIdx.x < 32) s5_scan_item(p, l, blockIdx.x);
  const int tid = otid();
  const u16* Qm = (const u16*)(p.ws + OFF_QM); const u16* Km = (const u16*)(p.ws + OFF_KM); const u16* Vm = (const u16*)(p.ws + OFF_VM);
  const u16* Qs = (const u16*)(p.ws + OFF_QS); const u16* Ks = (const u16*)(p.ws + OFF_KS); const u16* Vs = (const u16*)(p.ws + OFF_VS);
  u16* mix = (u16*)(p.ws + OFF_MIX);
  constexpr size_t CTX6 = (size_t)NBATCH * 6 * TLAT, CTX2 = (size_t)NBATCH * 2 * TLAT;
  const int nunits = l == NLAYER - 1 ? 3072 : 3168;
  for (int it = blockIdx.x; it < nunits; it += gridDim.x) {
    __syncthreads();
    if (it < 3072) {
      const int u = it < 1536 ? it : it - 1536;
      const int rr = u >> 8, bb = u & 255, bh = rr * 8 + (bb & 7), qb = bb >> 3, b = bh / 6, h = bh % 6, q0 = qb * 256;
      if (it < 1536) {
        const size_t r0 = (size_t)bh * TLAT, c0 = CTX6 + (size_t)bh * TCTX;
        attn_unit<96>(tid, lds, Qm + (r0 + q0) * 96, Km + r0 * 96, Vm + r0 * 64, 128, 0, Km + c0 * 96, Vm + c0 * 64, 4, q0, false, 0.f, 0.f, mix + (size_t)(b * TLAT + q0) * 1024 + h * 64);
      } else {
        const int kvh = h / 3, lo = q0 - 128 < 0 ? 0 : q0 - 128, hi_ = q0 + 384 > TLAT ? TLAT : q0 + 384;
        const size_t r0 = (size_t)(b * 2 + kvh) * TLAT, c0 = CTX2 + (size_t)(b * 2 + kvh) * TCTX;
        attn_unit<64>(tid, lds, Qs + ((size_t)bh * TLAT + q0) * 64, Ks + (r0 + lo) * 64, Vs + (r0 + lo) * 64, (hi_ - lo) >> 6, lo, Ks + c0 * 64, Vs + c0 * 64, 4, q0, true, p.sink[l * 6 + h] * LOG2E, 1.f,
                      mix + (size_t)(b * TLAT + q0) * 1024 + 640 + h * 64);
      }
    } else {
      const int u = it - 3072, ty = u / 48, bh = u % 48, b = bh / 6, h = bh % 6;
      if (ty == 0) {
        const size_t c0 = CTX6 + (size_t)bh * TCTX;
        attn_unit<96>(tid, lds, Qm + c0 * 96, Km + c0 * 96, Vm + c0 * 64, 4, 0, Km, Vm, 0, 0, false, 0.f, 0.f, mix + (size_t)(MLAT + b * TCTX) * 1024 + h * 64);
      } else {
        const int kvh = h / 3; const size_t c0 = CTX2 + (size_t)(b * 2 + kvh) * TCTX;
        attn_unit<64>(tid, lds, Qs + (CTX6 + (size_t)bh * TCTX) * 64, Ks + c0 * 64, Vs + c0 * 64, 4, 0, Ks, Vs, 0, 0, false, p.sink[l * 6 + h] * LOG2E, 1.f, mix + (size_t)(MLAT + b * TCTX) * 1024 + 640 + h * 64);
      }
    }
  }
}

static __device__ __forceinline__ void phase_resid_gemm(const P& p, int l, const u16* A, const u16* W, int ldk, int gate_off, char* lds) {
  const int tid = otid(), lane = tid & 63, wid = tid >> 6, r32 = lane & 31, hi = lane >> 5, wm = wid >> 1, wn = wid & 1, lr = tid >> 3;
  const int MT = l == NLAYER - 1 ? 256 : 264;
  const int ns = tile_steps(MT, 8, 4, 8), nk = ldk >> 6;
  u32x4 ra0[4], rb0[2], ra1[4], rb1[2];
  LdRows al, bl; int mt, nt;
  auto mk = [&](int mt_, int nt_, LdRows& a_, LdRows& b_) {
#pragma unroll
    for (int j = 0; j < 4; ++j) a_.p[j] = A + (size_t)(mt_ * 256 + lr + 64 * j) * ldk;
#pragma unroll
    for (int j = 0; j < 2; ++j) b_.p[j] = W + (size_t)(nt_ * 128 + lr + 64 * j) * ldk;
    b_.p[2] = b_.p[3] = b_.p[0];
  };
  int s = tile_next(0, ns, MT, 8, 4, 8, mt, nt);
  if (s >= 0) { mk(mt, nt, al, bl); gemm_issue<4, 2>(tid, al, bl, nk, ra0, rb0, ra1, rb1); }
  while (s >= 0) {
    f32x16 acc[2][2]; zero_acc(acc);
    __syncthreads();
    gemm_run<4, 2, 2, 2, true>(tid, lds + LDS_SCR, al, bl, nk, acc, ra0, rb0, ra1, rb1);
    int mt2 = 0, nt2 = 0; const int s2 = tile_next(s + 1, ns, MT, 8, 4, 8, mt2, nt2);
    if (s2 >= 0) { mk(mt2, nt2, al, bl); gemm_issue<4, 2>(tid, al, bl, nk, ra0, rb0, ra1, rb1); }
    float* xb = xrow(p, mt * 256); const float* gv = modv(p, l, modidx(mt * 256)) + gate_off;
#pragma unroll
    for (int tn = 0; tn < 2; ++tn) {
      const int n = nt * 128 + wn * 64 + 32 * tn + r32; const float g = gv[n];
      float* xp = xb + (size_t)(wm * 64 + 4 * hi) * DM + n;
      float xv[2][16];
#pragma unroll
      for (int tm = 0; tm < 2; ++tm)
#pragma unroll
        for (int r = 0; r < 16; ++r) xv[tm][r] = xp[(size_t)(32 * tm + (r & 3) + 8 * (r >> 2)) * DM];
#pragma unroll
      for (int tm = 0; tm < 2; ++tm)
#pragma unroll
        for (int r = 0; r < 16; ++r) xp[(size_t)(32 * tm + (r & 3) + 8 * (r >> 2)) * DM] = xv[tm][r] + g * acc[tm][tn][r];
    }
    s = s2; mt = mt2; nt = nt2;
  }
}

static __device__ __forceinline__ void phase_ffn_up(const P& p, int l, char* lds) {
  const int tid = otid(), lane = tid & 63, wid = tid >> 6, r32 = lane & 31, hi = lane >> 5, wm = wid >> 1, wn = wid & 1, lr = tid >> 3;
  const u16* H = (const u16*)(p.ws + OFF_H); const u16* W = wl(p, l) + W_UP; u16* act = (u16*)(p.ws + OFF_ACT);
  const float* cw = p.conv_w + (size_t)l * 3 * 5632; const float* cb = p.conv_b + (size_t)l * 5632;
  char* tile = lds + LDS_SCR;
  const int MEND = l == NLAYER - 1 ? MLAT : MTOT;
  const int RT = (MEND + 253) / 254;
  const int ns = tile_steps(RT, 44, 8, 4);
  u32x4 ra0[4], rb0[2], ra1[4], rb1[2];
  LdRows al, bl; int rt, nt;
  auto mk = [&](int rt_, int nt_, LdRows& a_, LdRows& b_) {
    const int ts_ = 254 * rt_ - 1;
#pragma unroll
    for (int j = 0; j < 4; ++j) { const int tt = ts_ + lr + 64 * j; a_.p[j] = (tt >= 0 && tt < MTOT) ? H + (size_t)tt * 1024 : (const u16*)(p.ws + OFF_ZERO); }
#pragma unroll
    for (int j = 0; j < 2; ++j) b_.p[j] = W + (size_t)(nt_ * 128 + lr + 64 * j) * 1024;
    b_.p[2] = b_.p[3] = b_.p[0];
  };
  int s = tile_next(0, ns, RT, 44, 8, 4, rt, nt);
  if (s >= 0) { mk(rt, nt, al, bl); gemm_issue<4, 2>(tid, al, bl, 16, ra0, rb0, ra1, rb1); }
  while (s >= 0) {
    const int tstart = 254 * rt - 1;
    f32x16 acc[2][2]; zero_acc(acc);
    __syncthreads();
    gemm_run<4, 2, 2, 2>(tid, lds + LDS_SCR, al, bl, 16, acc, ra0, rb0, ra1, rb1);
    int rt2 = 0, nt2 = 0; const int s2 = tile_next(s + 1, ns, RT, 44, 8, 4, rt2, nt2);
    if (s2 >= 0) { mk(rt2, nt2, al, bl); gemm_issue<4, 2>(tid, al, bl, 16, ra0, rb0, ra1, rb1); }
#pragma unroll
    for (int tm = 0; tm < 2; ++tm) {
      char* trow = tile + (wm * 64 + 32 * tm + r32) * 528;
#pragma unroll
      for (int tn = 0; tn < 2; ++tn)
#pragma unroll
        for (int rg = 0; rg < 4; ++rg) { f32x4 v = {acc[tm][tn][4 * rg], acc[tm][tn][4 * rg + 1], acc[tm][tn][4 * rg + 2], acc[tm][tn][4 * rg + 3]}; *(f32x4*)(trow + (wn * 64 + 32 * tn + 8 * rg + 4 * hi) * 4) = v; }
    }
    __syncthreads();
    {
      const int cgp = tid & 7, wn2 = cgp >> 2, j0 = (cgp & 3) * 8;
      const int ca0 = nt * 64 + wn2 * 32 + j0;
      const int lca = (wn2 * 64 + j0) * 4, lcg = lca + 128;
      float wa0[8], wa1[8], wa2[8], ba[8], wg0[8], wg1[8], wg2[8], bg[8];
#pragma unroll
      for (int e = 0; e < 8; ++e) {
        wa0[e] = cw[ca0 + e]; wa1[e] = cw[5632 + ca0 + e]; wa2[e] = cw[2 * 5632 + ca0 + e]; ba[e] = cb[ca0 + e];
        wg0[e] = cw[DFF + ca0 + e]; wg1[e] = cw[5632 + DFF + ca0 + e]; wg2[e] = cw[2 * 5632 + DFF + ca0 + e]; bg[e] = cb[DFF + ca0 + e];
      }
#pragma unroll
      for (int jj = 0; jj < 4; ++jj) {
        const int r = (tid >> 3) + 64 * jj, tt = tstart + r;
        if (r >= 1 && r <= 254 && tt < MEND) {
          const int pos = tt < MLAT ? (tt & (TLAT - 1)) : ((tt - MLAT) & (TCTX - 1)), slen = tt < MLAT ? TLAT : TCTX;
          const float fm = pos == 0 ? 0.f : 1.f, fp = pos == slen - 1 ? 0.f : 1.f;
          const char* rp = tile + r * 528;
          float o[8];
#pragma unroll
          for (int hf = 0; hf < 2; ++hf) {
            const f32x4 am = *(const f32x4*)(rp - 528 + lca + hf * 16), a0 = *(const f32x4*)(rp + lca + hf * 16), ap = *(const f32x4*)(rp + 528 + lca + hf * 16);
            const f32x4 gm = *(const f32x4*)(rp - 528 + lcg + hf * 16), g0 = *(const f32x4*)(rp + lcg + hf * 16), gp = *(const f32x4*)(rp + 528 + lcg + hf * 16);
#pragma unroll
            for (int e = 0; e < 4; ++e) {
              const int q = hf * 4 + e;
              const float ua = wa0[q] * (fm * am[e]) + wa1[q] * a0[e] + wa2[q] * (fp * ap[e]) + ba[q];
              const float ug = wg0[q] * (fm * gm[e]) + wg1[q] * g0[e] + wg2[q] * (fp * gp[e]) + bg[q];
              o[q] = silu_f(ug) * ua;
            }
          }
          u32x4 w = {pk2(o[0], o[1]), pk2(o[2], o[3]), pk2(o[4], o[5]), pk2(o[6], o[7])};
          *(u32x4*)(act + (size_t)tt * DFF + ca0) = w;
        }
      }
    }
    s = s2; rt = rt2; nt = nt2;
  }
}

#define XB_TMO      128
#define XB_XCNT(j)  (256  + 64 * (j))
#define XB_XSUB(j)  (1280 + 64 * (j))
#define XB_XGEN(j)  (2304 + 64 * (j))
#define XB_TOP      3328
#define XB_TOPGEN   3392
#define XCD_BAR_WORDS 3456
#define XB_SPIN_CAP (1u << 24)
DI unsigned xb_ld(unsigned* p) { return __hip_atomic_load(p, __ATOMIC_RELAXED, __HIP_MEMORY_SCOPE_AGENT); }
DI unsigned xb_add(unsigned* p, unsigned v) { return __hip_atomic_fetch_add(p, v, __ATOMIC_RELAXED, __HIP_MEMORY_SCOPE_AGENT); }
DI unsigned xb_xcc_id() { return (unsigned)__builtin_amdgcn_s_getreg((3 << 11) | 20) & 0xFu; }
#define XB_SPIN(cond, bar) do { unsigned _sp = 0; while (cond) { __builtin_amdgcn_s_sleep(1); \
    if ((++_sp & 255u) == 0u) { if (xb_ld(&(bar)[XB_TMO])) break; if (_sp > XB_SPIN_CAP) { atomicAdd(&(bar)[XB_TMO], 1u); break; } } } } while (0)
struct XcdBarrier { unsigned* bar; unsigned x; volatile LAS unsigned* st; };
DI XcdBarrier xcd_barrier_post(unsigned* bar, volatile LAS unsigned* st) {
  XcdBarrier b; b.bar = bar; b.x = xb_xcc_id(); b.st = st;
  if (threadIdx.x == 0) (void)xb_add(&bar[XB_XCNT(b.x)], 1u);
  return b;
}
DI void xcd_barrier_complete(unsigned* bar, unsigned x, unsigned& nloc, unsigned& nx) {
  const unsigned G = gridDim.x * gridDim.y * gridDim.z;
  unsigned sum, cnt, mine, sp = 0u;
  for (;;) {
    sum = 0u; cnt = 0u; mine = 0u;
#pragma unroll
    for (unsigned j = 0; j < 16; ++j) { const unsigned c = xb_ld(&bar[XB_XCNT(j)]); sum += c; cnt += (c > 0u) ? 1u : 0u; mine = (j == x) ? c : mine; }
    if (sum == G) break;
    __builtin_amdgcn_s_sleep(1);
    if ((++sp & 255u) == 0u) { if (xb_ld(&bar[XB_TMO])) break; if (sp > XB_SPIN_CAP) { atomicAdd(&bar[XB_TMO], 1u); break; } }
  }
  nloc = mine > 0u ? mine : 1u; nx = cnt > 0u ? cnt : 1u;
}
DI void xcd_barrier(const XcdBarrier& b) {
  asm volatile("s_waitcnt vmcnt(0)" ::: "memory");
  __syncthreads();
  if (threadIdx.x == 0) {
    unsigned* bar = b.bar;
    __builtin_amdgcn_s_waitcnt(0);
    unsigned nloc = b.st[0], nx = b.st[1];
    if (nloc == 0u) { xcd_barrier_complete(bar, b.x, nloc, nx); b.st[0] = nloc; b.st[1] = nx; }
    const unsigned old = xb_add(&bar[XB_XSUB(b.x)], 1u);
    const unsigned gen = old / nloc;
    if (old + 1u == (gen + 1u) * nloc) {
      __builtin_amdgcn_fence(__ATOMIC_RELEASE, "agent");
      asm volatile("s_waitcnt vmcnt(0)" ::: "memory");
      const unsigned og = xb_add(&bar[XB_TOP], 1u);
      const unsigned tg = og / nx;
      if (og + 1u == (tg + 1u) * nx) xb_add(&bar[XB_TOPGEN], 1u);
      else XB_SPIN(xb_ld(&bar[XB_TOPGEN]) == tg, bar);
      __builtin_amdgcn_fence(__ATOMIC_ACQUIRE, "agent");
      xb_add(&bar[XB_XGEN(b.x)], 1u);
      asm volatile("s_waitcnt vmcnt(0)" ::: "memory");
    } else {
      XB_SPIN(xb_ld(&bar[XB_XGEN(b.x)]) == gen, bar);
      __builtin_amdgcn_fence(__ATOMIC_ACQUIRE, "agent");
      asm volatile("s_waitcnt vmcnt(0)" ::: "memory");
    }
  }
  __syncthreads();
}

__global__ void __launch_bounds__(NTHREADS) fwd_kernel(P p) {
  extern __shared__ __attribute__((aligned(16))) char lds_raw[];
  char* lds = lds_raw + LDS_FRONT;
  cg::grid_group grid = cg::this_grid();
  if (threadIdx.x == 0) *(u32x4*)lds_raw = u32x4{0u, 0u, 0u, 0u};
  __syncthreads();
  const XcdBarrier xb = xcd_barrier_post((unsigned*)(p.ws + OFF_BAR), (volatile LAS unsigned*)lds_raw);
  phase_pre(p);
  grid.sync();
  phase0(p, lds);
  xcd_barrier(xb);
  for (int l = 0; l < NLAYER; ++l) {
    phase_norm(p, l, 0);
    xcd_barrier(xb);
    phase_inproj(p, l, lds);
    xcd_barrier(xb);
    phase_mla_prep(p, l, lds);
    phase_s5_states(p, l, lds);
    xcd_barrier(xb);
    phase_attn(p, l, lds);
    xcd_barrier(xb);
    phase_s5_out(p, l, lds);
    xcd_barrier(xb);
    phase_glu(p, l, lds);
    xcd_barrier(xb);
    phase_resid_gemm(p, l, (const u16*)(p.ws + OFF_MIX), wl(p, l) + W_OUT, 1024, 2048, lds);
    xcd_barrier(xb);
    phase_norm(p, l, 1);
    xcd_barrier(xb);
    phase_ffn_up(p, l, lds);
    xcd_barrier(xb);
    phase_resid_gemm(p, l, (const u16*)(p.ws + OFF_ACT), wl(p, l) + W_DN, DFF, 5120, lds);
    xcd_barrier(xb);
  }
}

extern "C" void kernel_launch(void* const* d_in, const int* in_sizes, int n_in, void* d_out, int out_size, void* d_ws, size_t ws_size, hipStream_t stream) {
  static int grid_blocks = 0;
  if (!grid_blocks) {
    if (ws_size < WS_NEED) { fprintf(stderr, "kernel_launch: workspace too small: %zu < %zu\n", ws_size, (size_t)WS_NEED); return; }
    if (hipFuncSetAttribute((const void*)fwd_kernel, hipFuncAttributeMaxDynamicSharedMemorySize, LDS_TOTAL) != hipSuccess) { fprintf(stderr, "kernel_launch: LDS attribute failed\n"); return; }
    int dev = 0, cus = 0, per_cu = 0;
    hipGetDevice(&dev);
    hipDeviceGetAttribute(&cus, hipDeviceAttributeMultiprocessorCount, dev);
    hipOccupancyMaxActiveBlocksPerMultiprocessor(&per_cu, fwd_kernel, NTHREADS, LDS_TOTAL);
    if (per_cu < 1) { fprintf(stderr, "kernel_launch: occupancy 0\n"); return; }
    grid_blocks = cus;
  }
  P p{};
  const float** fp = (const float**)&p;
  for (int i = 0; i < 33; ++i) fp[i] = (const float*)d_in[i];
  p.out = (float*)d_out; p.ws = (char*)d_ws;
  (void)hipMemsetAsync((char*)d_ws + OFF_BAR, 0, XCD_BAR_WORDS * 4, stream);
  void* args[] = {&p};
  hipError_t e = hipLaunchCooperativeKernel((void*)fwd_kernel, dim3(grid_blocks), dim3(NTHREADS), args, LDS_TOTAL, stream);
  if (e != hipSuccess) fprintf(stderr, "cooperative launch failed: %s (grid %d)\n", hipGetErrorString(e), grid_blocks);
}
```

```cpp
#include <hip/hip_runtime.h>
#include <hip/hip_cooperative_groups.h>
#include <cstdio>
#include <cstdint>
namespace cg = cooperative_groups;

typedef unsigned short u16;
typedef short bf16x8 __attribute__((ext_vector_type(8)));
typedef short s16x4 __attribute__((ext_vector_type(4)));
typedef float f32x16 __attribute__((ext_vector_type(16)));
typedef float f32x4 __attribute__((ext_vector_type(4)));
typedef float f32x2 __attribute__((ext_vector_type(2)));
typedef unsigned u32x4 __attribute__((ext_vector_type(4)));
typedef unsigned u32x2 __attribute__((ext_vector_type(2)));
typedef __bf16 bf16x2_t __attribute__((ext_vector_type(2)));
#define DI __device__ __forceinline__
#define LAS __attribute__((address_space(3)))

constexpr int DM = 1024, NBATCH = 8, TLAT = 8192, NLAYER = 4, TCTX = 256;
constexpr int MLAT = NBATCH * TLAT, MCTX = NBATCH * TCTX, MTOT = MLAT + MCTX;
constexpr int PROJ_LD = 928, DFF = 2816;
constexpr float EPS = 1e-6f, LOG2E = 1.4426950408889634f;
constexpr int NTHREADS = 512;
constexpr int PITCH = 144;
constexpr int LDS_SCR = 2048;
constexpr int LDS_FRONT = 256;
constexpr int LDS_TOTAL = LDS_FRONT + LDS_SCR + 256 * 528;

constexpr size_t al256(size_t x) { return (x + 255) / 256 * 256; }
constexpr size_t OFF_CTXX = 0;
constexpr size_t OFF_MOD = OFF_CTXX + (size_t)MCTX * DM * 4;
constexpr size_t OFF_ROPE = OFF_MOD + al256((size_t)NLAYER * 9 * 6144 * 4);
constexpr size_t ROPE_COSA = 0, ROPE_SINA = (size_t)TLAT * 16 * 4, ROPE_COSS = 2 * ROPE_SINA, ROPE_SINS = ROPE_COSS + (size_t)TLAT * 32 * 4;
constexpr size_t OFF_S5PW = OFF_ROPE + 2 * (size_t)TLAT * 16 * 4 + 2 * (size_t)TLAT * 32 * 4;
constexpr size_t OFF_S5Q = OFF_S5PW + (size_t)NLAYER * 2 * 16 * 64 * 65 * 16;
constexpr size_t OFF_W = OFF_S5Q + (size_t)NLAYER * 2 * 16 * 64 * 16;
constexpr size_t W_IN = 0, W_OUT = W_IN + (size_t)1664 * 1024, W_UP = W_OUT + (size_t)1024 * 1024, W_DN = W_UP + (size_t)5632 * 1024,
                 W_UQ = W_DN + (size_t)1024 * 2816, W_UKV = W_UQ + (size_t)576 * 384, W_GLU = W_UKV + (size_t)768 * 256, W_LAYER = W_GLU + (size_t)256 * 256;
constexpr size_t OFF_S5T = OFF_W + (size_t)NLAYER * W_LAYER * 2;
constexpr size_t S5_KC = 0, S5_BST = S5_KC + (size_t)16 * 127 * 256, S5_MRD = S5_BST + (size_t)16 * 256 * 1024, S5_LAYER = S5_MRD + (size_t)16 * 1024 * 256;
constexpr size_t OFF_H = OFF_S5T + (size_t)NLAYER * S5_LAYER * 2;
constexpr size_t OFF_MIX = OFF_H + (size_t)MTOT * 1024 * 2;
constexpr size_t OFF_SST = OFF_MIX + (size_t)MTOT * 1024 * 2;
constexpr size_t OFF_HIN = OFF_SST + (size_t)1056 * 16 * 256 * 4;
constexpr size_t OFF_ZB = OFF_HIN + (size_t)1056 * 16 * 256 * 2;
constexpr size_t OFF_BIG = OFF_ZB + (size_t)MTOT * 256 * 2;
constexpr size_t OFF_PROJ = OFF_BIG;
constexpr size_t OFF_QM = OFF_PROJ + (size_t)MTOT * PROJ_LD * 2;
constexpr size_t OFF_KM = OFF_QM + (size_t)MTOT * 576 * 2;
constexpr size_t OFF_VM = OFF_KM + (size_t)MTOT * 576 * 2;
constexpr size_t OFF_QS = OFF_VM + (size_t)MTOT * 384 * 2;
constexpr size_t OFF_KS = OFF_QS + (size_t)MTOT * 384 * 2;
constexpr size_t OFF_VS = OFF_KS + (size_t)MTOT * 128 * 2;
constexpr size_t OFF_END1 = OFF_VS + (size_t)MTOT * 128 * 2;
constexpr size_t OFF_ACT = OFF_BIG;
constexpr size_t OFF_END2 = OFF_ACT + (size_t)MTOT * DFF * 2;
constexpr size_t OFF_ZERO = OFF_END1 > OFF_END2 ? OFF_END1 : OFF_END2;
constexpr size_t OFF_BAR = OFF_ZERO + 8192;
constexpr size_t WS_NEED = OFF_BAR + 16384;

struct P {
  const float *x, *c, *ctx, *c_ctx, *w_mod, *b_mod, *norm1, *w_in, *q_lora_g, *w_uq, *kv_lora_g, *w_ukv, *q_norm, *k_norm, *a_re, *a_im, *log_dt, *b_re, *b_im, *c_re,
      *c_im, *s5_d, *w_glu, *b_glu, *sq_norm, *sk_norm, *sink, *w_out, *norm2, *w_up, *conv_w, *conv_b, *w_down;
  float* out;
  char* ws;
};

DI unsigned pk2(float a, float b) { f32x2 v = {a, b}; bf16x2_t r = __builtin_convertvector(v, bf16x2_t); return __builtin_bit_cast(unsigned, r); }
DI float bflo(unsigned w) { return __uint_as_float(w << 16); }
DI float bfhi(unsigned w) { return __uint_as_float(w & 0xffff0000u); }
DI int otid() { int t = threadIdx.x; asm volatile("" : "+v"(t)); return t; }
DI int crow(int r, int hi) { return (r & 3) + 8 * (r >> 2) + 4 * hi; }
DI f32x16 mfma(bf16x8 a, bf16x8 b, f32x16 c) { return __builtin_amdgcn_mfma_f32_32x32x16_bf16(a, b, c, 0, 0, 0); }
DI float ex2(float x) { return __builtin_amdgcn_exp2f(x); }
DI float rcpf_(float x) { return __builtin_amdgcn_rcpf(x); }
DI float xsum32(float v) { auto rr = __builtin_amdgcn_permlane32_swap(__float_as_uint(v), __float_as_uint(v), false, false); return __uint_as_float(rr[0]) + __uint_as_float(rr[1]); }
DI float xmax32(float v) { auto rr = __builtin_amdgcn_permlane32_swap(__float_as_uint(v), __float_as_uint(v), false, false); return fmaxf(__uint_as_float(rr[0]), __uint_as_float(rr[1])); }
DI void st4(u16* p, float a, float b, float c, float d) { u32x2 w = {pk2(a, b), pk2(c, d)}; *(u32x2*)p = w; }
DI float silu_f(float g) { return g * rcpf_(1.f + ex2(-g * LOG2E)); }
DI float sigmoid_f(float g) { return rcpf_(1.f + ex2(-g * LOG2E)); }
DI float gelu_tanh(float x) { const float u = 0.7978845608028654f * (x + 0.044715f * x * x * x); const float th = 1.f - 2.f * rcpf_(1.f + ex2(2.f * LOG2E * u)); return 0.5f * x * (1.f + th); }
DI const float* xin(const P& p, int m) { return m < MLAT ? p.x + (size_t)m * DM : p.ctx + (size_t)(m - MLAT) * DM; }
DI float* xrow(const P& p, int m) { return m < MLAT ? p.out + (size_t)m * DM : (float*)(p.ws + OFF_CTXX) + (size_t)(m - MLAT) * DM; }
DI int modidx(int m) { return m < MLAT ? (m >> 13) : 8; }
DI const float* modv(const P& p, int l, int mi) { return (const float*)(p.ws + OFF_MOD) + ((size_t)l * 9 + mi) * 6144; }
DI size_t head_row(int m, int h, int H) {
  if (m < MLAT) return ((size_t)((m >> 13) * H + h) << 13) + (m & 8191);
  const int r = m - MLAT; return (size_t)NBATCH * H * TLAT + (size_t)((r >> 8) * H + h) * TCTX + (r & 255);
}
DI u16* wl(const P& p, int l) { return (u16*)(p.ws + OFF_W) + (size_t)l * W_LAYER; }
DI u16* s5t(const P& p, int l) { return (u16*)(p.ws + OFF_S5T) + (size_t)l * S5_LAYER; }
DI int s5_tokbase(int row) { return row < 1024 ? (row >> 7) * TLAT + (row & 127) * 64 : MLAT + ((row - 1024) >> 2) * TCTX + ((row - 1024) & 3) * 64; }

DI int tile_steps(int MT, int NT, int RM, int RN) {
  if (gridDim.x == 256) { const int SM = (MT + RM - 1) / RM, SN = (NT + RN - 1) / RN; return (SM * SN + 7) >> 3; }
  return (MT * NT + gridDim.x - 1) / gridDim.x;
}
DI bool tile_get(int s, int MT, int NT, int RM, int RN, int& mt, int& nt) {
  if (gridDim.x == 256) {
    const int xcd = blockIdx.x & 7, slot = blockIdx.x >> 3; const int SM = (MT + RM - 1) / RM, SN = (NT + RN - 1) / RN;
    const int st = s * 8 + xcd; if (st >= SM * SN) return false;
    mt = (st / SN) * RM + slot % RM; nt = (st % SN) * RN + slot / RM;
    return mt < MT && nt < NT;
  }
  const int it = s * gridDim.x + blockIdx.x; if (it >= MT * NT) return false;
  mt = it / NT; nt = it % NT; return true;
}

struct LdRows {
  const u16* p[4];
  DI u32x4 load(int j, int kc) const { return *(const u32x4*)(p[j] + (size_t)kc * 8); }
};
struct LdS5A {
  const u16* pu[4]; const u16* ph[4];
  DI u32x4 load(int j, int kc) const {
    const u16* q = kc < 128 ? pu[j] + (size_t)(kc >> 1) * PROJ_LD + (kc & 1) * 8 : ph[j] + (kc - 128) * 8;
    return *(const u32x4*)q;
  }
};
struct LdS5B {
  const u16* pk[2]; const u16* pm[2];
  DI u32x4 load(int j, int kc) const {
    const u16* q = kc < 128 ? pk[j] - (kc >> 1) * 256 + (kc & 1) * 8 : pm[j] + (kc - 128) * 8;
    return *(const u32x4*)q;
  }
};

template <int NA, int NB, class AL, class BL>
DI void gemm_issue(int tid, const AL& al, const BL& bl, int nk, u32x4 (&ra0)[NA], u32x4 (&rb0)[NB], u32x4 (&ra1)[NA], u32x4 (&rb1)[NB]) {
  const int lc = tid & 7, k1 = nk > 1 ? 1 : 0;
#pragma unroll
  for (int j = 0; j < NA; ++j) ra0[j] = al.load(j, lc);
#pragma unroll
  for (int j = 0; j < NB; ++j) rb0[j] = bl.load(j, lc);
#pragma unroll
  for (int j = 0; j < NA; ++j) ra1[j] = al.load(j, k1 * 8 + lc);
#pragma unroll
  for (int j = 0; j < NB; ++j) rb1[j] = bl.load(j, k1 * 8 + lc);
}
template <int WM, int WN, int TM, int TN, bool SW = false, class AL, class BL>
DI void gemm_run(int tid, char* lds, const AL& al, const BL& bl, int nk, f32x16 (&acc)[TM][TN], u32x4 (&ra0)[WM * TM / 2], u32x4 (&rb0)[WN * TN / 2], u32x4 (&ra1)[WM * TM / 2], u32x4 (&rb1)[WN * TN / 2]) {
  constexpr int BM = WM * TM * 32, BN = WN * TN * 32, NA = BM / 64, NB = BN / 64;
  constexpr int AB = BM * PITCH, STAGE = (BM + BN) * PITCH;
  const int lane = tid & 63, wid = tid >> 6, r32 = lane & 31, hi = lane >> 5;
  const int wm = wid / WN, wn = wid % WN, lr = tid >> 3, lc = tid & 7;
  char* const wa = lds + lr * PITCH + lc * 16;
  const int aoff = (wm * TM * 32 + r32) * PITCH + hi * 16;
  const int boff = AB + (wn * TN * 32 + r32) * PITCH + hi * 16;
#define GLOAD(RA, RB, KT) do { const int kc_ = (KT) * 8 + lc; _Pragma("unroll") for (int j = 0; j < NA; ++j) RA[j] = al.load(j, kc_); _Pragma("unroll") for (int j = 0; j < NB; ++j) RB[j] = bl.load(j, kc_); } while (0)
#define LWRITE(RA, RB, BUF) do { char* w_ = wa + (BUF) * STAGE; _Pragma("unroll") for (int j = 0; j < NA; ++j) *(u32x4*)(w_ + j * 64 * PITCH) = RA[j]; _Pragma("unroll") for (int j = 0; j < NB; ++j) *(u32x4*)(w_ + AB + j * 64 * PITCH) = RB[j]; } while (0)
#define COMPUTE(BUF, RA, RB, WBUF) do { const char* sb = lds + (BUF) * STAGE; char* w_ = wa + (WBUF) * STAGE; _Pragma("unroll") for (int ks = 0; ks < 4; ++ks) { bf16x8 wf[TN], xf[TM]; \
    _Pragma("unroll") for (int tn = 0; tn < TN; ++tn) wf[tn] = *(const bf16x8*)(sb + boff + tn * 32 * PITCH + ks * 32); \
    _Pragma("unroll") for (int tm = 0; tm < TM; ++tm) xf[tm] = *(const bf16x8*)(sb + aoff + tm * 32 * PITCH + ks * 32); \
    _Pragma("unroll") for (int tm = 0; tm < TM; ++tm) _Pragma("unroll") for (int tn = 0; tn < TN; ++tn) acc[tm][tn] = SW ? mfma(xf[tm], wf[tn], acc[tm][tn]) : mfma(wf[tn], xf[tm], acc[tm][tn]); \
    _Pragma("unroll") for (int j = 0; j < NA; ++j) if (1 + j % 3 == ks) *(u32x4*)(w_ + j * 64 * PITCH) = RA[j]; \
    _Pragma("unroll") for (int j = 0; j < NB; ++j) if (1 + (NA + j) % 3 == ks) *(u32x4*)(w_ + AB + j * 64 * PITCH) = RB[j]; } } while (0)
  const int kl = nk - 1;
  LWRITE(ra0, rb0, 0);
  __syncthreads();
#pragma unroll 1
  for (int kt = 0; kt < nk; kt += 2) {
    GLOAD(ra0, rb0, (kt + 2 < kl ? kt + 2 : kl));
    COMPUTE(0, ra1, rb1, 1);
    __syncthreads();
    if (kt + 1 >= nk) break;
    GLOAD(ra1, rb1, (kt + 3 < kl ? kt + 3 : kl));
    COMPUTE(1, ra0, rb0, 0);
    __syncthreads();
  }
#undef GLOAD
#undef LWRITE
#undef COMPUTE
}
template <int WM, int WN, int TM, int TN, bool SW = false, class AL, class BL>
DI void gemm_main(int tid, char* lds, const AL& al, const BL& bl, int nk, f32x16 (&acc)[TM][TN]) {
  constexpr int NA = WM * TM / 2, NB = WN * TN / 2;
  u32x4 ra0[NA], rb0[NB], ra1[NA], rb1[NB];
  gemm_issue<NA, NB>(tid, al, bl, nk, ra0, rb0, ra1, rb1);
  gemm_run<WM, WN, TM, TN, SW>(tid, lds, al, bl, nk, acc, ra0, rb0, ra1, rb1);
}
DI int tile_next(int s, int ns, int MT, int NT, int RM, int RN, int& mt, int& nt) {
  for (; s < ns; ++s) if (tile_get(s, MT, NT, RM, RN, mt, nt)) return s;
  return -1;
}
template <int TM, int TN> DI void zero_acc(f32x16 (&acc)[TM][TN]) {
#pragma unroll
  for (int a = 0; a < TM; ++a)
#pragma unroll
    for (int b = 0; b < TN; ++b)
#pragma unroll
      for (int r = 0; r < 16; ++r) acc[a][b][r] = 0.f;
}

struct dc { double re, im; };
DI dc cmul(dc a, dc b) { return {a.re * b.re - a.im * b.im, a.re * b.im + a.im * b.re}; }

static __device__ __forceinline__ void phase_pre(const P& p) {
  const int gt = blockIdx.x * NTHREADS + threadIdx.x;
  if (gt < 512) ((u32x4*)(p.ws + OFF_ZERO))[gt] = u32x4{0, 0, 0, 0};
  if (gt < NLAYER * 2 * 16 * 64) {
    const int ldg = gt >> 6;
    const double lre = p.a_re[gt], lim = p.a_im[gt];
    const double dt = exp((double)p.log_dt[ldg]);
    double s, c; sincos(lim * dt, &s, &c);
    const double e = exp(lre * dt);
    const dc a = {e * c, e * s};
    const double den = lre * lre + lim * lim;
    const dc am1 = {a.re - 1.0, a.im};
    const dc q = {(am1.re * lre + am1.im * lim) / den, (am1.im * lre - am1.re * lim) / den};
    dc* pw = (dc*)(p.ws + OFF_S5PW) + (size_t)gt * 65;
    dc r = {1.0, 0.0};
    for (int k = 0; k <= 64; ++k) { pw[k] = r; r = cmul(r, a); }
    ((dc*)(p.ws + OFF_S5Q))[gt] = q;
  }
}

DI int nmap_in(int n) { return n < 640 ? n : (n < 1536 ? n + 32 : n - 896); }
DI int nmap_up(int n) { const int q = n >> 6, r = n & 63; return r < 32 ? 32 * q + r : DFF + 32 * q + (r - 32); }

static __device__ __forceinline__ void transpose_tile(const float* src, int ldsrc, int K, int Nd, int nmap, const float* kscale, u16* dst, int kt, int ntile, char* lds) {
  float* tile = (float*)lds;
  const int tid = threadIdx.x;
  __syncthreads();
  {
    const int n = tid & 63, kk = tid >> 6;
    const int nd = ntile * 64 + n;
    const int ns = nmap == 1 ? nmap_in(nd) : (nmap == 2 ? nmap_up(nd) : nd);
#pragma unroll
    for (int j = 0; j < 8; ++j) {
      const int k = kk + 8 * j, kg = kt * 64 + k;
      float v = 0.f;
      if (nd < Nd) { v = src[(size_t)kg * ldsrc + ns]; if (kscale) v *= kscale[kg]; }
      tile[k * 65 + n] = v;
    }
  }
  __syncthreads();
  {
    const int n = tid >> 3, kc = tid & 7, nd = ntile * 64 + n;
    if (nd < Nd) {
      const float* t = tile + (kc * 8) * 65 + n;
      u32x4 w = {pk2(t[0], t[65]), pk2(t[130], t[195]), pk2(t[260], t[325]), pk2(t[390], t[455])};
      *(u32x4*)(dst + (size_t)nd * K + kt * 64 + kc * 8) = w;
    }
  }
}

static __device__ __forceinline__ void mod_item(const P& p, int it, char* lds) {
  const int l = it / 96, n0 = (it % 96) * 64, tid = threadIdx.x;
  float* sv = (float*)lds;
  float* red = sv + 9 * 1024;
  __syncthreads();
  for (int i = tid; i < 9 * 1024; i += NTHREADS) { const int j = i >> 10, k = i & 1023; const float v = j < 8 ? p.c[j * 1024 + k] : p.c_ctx[k]; sv[i] = v / (1.f + expf(-v)); }
  __syncthreads();
  const int c = tid & 63, kg = tid >> 6;
  float acc[9];
#pragma unroll
  for (int j = 0; j < 9; ++j) acc[j] = 0.f;
  const float* w = p.w_mod + ((size_t)l * 1024 + kg * 128) * 6144 + n0 + c;
  for (int kk = 0; kk < 128; ++kk) {
    const float wv = w[(size_t)kk * 6144];
#pragma unroll
    for (int j = 0; j < 9; ++j) acc[j] += sv[j * 1024 + kg * 128 + kk] * wv;
  }
#pragma unroll
  for (int j = 0; j < 9; ++j) red[(kg * 9 + j) * 64 + c] = acc[j];
  __syncthreads();
  for (int q = tid; q < 576; q += NTHREADS) {
    const int j = q >> 6, cc = q & 63; float s = 0.f;
#pragma unroll
    for (int g = 0; g < 8; ++g) s += red[(g * 9 + j) * 64 + cc];
    ((float*)(p.ws + OFF_MOD))[((size_t)l * 9 + j) * 6144 + n0 + cc] = s + p.b_mod[l * 6144 + n0 + cc];
  }
}

static __device__ __forceinline__ void phase0(const P& p, char* lds) {
  constexpr int NMOD = 384, TPL = 2886;
  for (int it = blockIdx.x; it < NMOD + NLAYER * TPL; it += gridDim.x) {
    if (it < NMOD) { mod_item(p, it, lds); continue; }
    const int u = it - NMOD, l = u / TPL, r = u % TPL;
    u16* W = wl(p, l);
    if (r < 400) transpose_tile(p.w_in + (size_t)l * 1024 * 1568, 1568, 1024, 1568, 1, nullptr, W + W_IN, r / 25, r % 25, lds);
    else if (r < 656) { const int q = r - 400; transpose_tile(p.w_out + (size_t)l * 1024 * 1024, 1024, 1024, 1024, 0, nullptr, W + W_OUT, q / 16, q % 16, lds); }
    else if (r < 2064) { const int q = r - 656; transpose_tile(p.w_up + (size_t)l * 1024 * 5632, 5632, 1024, 5632, 2, nullptr, W + W_UP, q / 88, q % 88, lds); }
    else if (r < 2768) { const int q = r - 2064; transpose_tile(p.w_down + (size_t)l * 2816 * 1024, 1024, 2816, 1024, 0, nullptr, W + W_DN, q / 16, q % 16, lds); }
    else if (r < 2822) { const int q = r - 2768; transpose_tile(p.w_uq + (size_t)l * 384 * 576, 576, 384, 576, 0, p.q_lora_g + l * 384, W + W_UQ, q / 9, q % 9, lds); }
    else if (r < 2870) { const int q = r - 2822; transpose_tile(p.w_ukv + (size_t)l * 256 * 768, 768, 256, 768, 0, p.kv_lora_g + l * 256, W + W_UKV, q / 12, q % 12, lds); }
    else { const int q = r - 2870; transpose_tile(p.w_glu + (size_t)l * 256 * 256, 256, 256, 256, 0, nullptr, W + W_GLU, q / 4, q % 4, lds); }
  }
  const size_t gt = (size_t)blockIdx.x * NTHREADS + threadIdx.x, gn = (size_t)gridDim.x * NTHREADS;
  for (size_t i = gt; i < (size_t)TLAT * 48; i += gn) {
    const int t = (int)(i / 48), j = (int)(i % 48);
    const int row = t >> 6, col = t & 63;
    int pos; double ex; float* cd; float* sd;
    if (j < 16) { const int f = j & 7; pos = j < 8 ? row : col; ex = -(double)f / 8.0; cd = (float*)(p.ws + OFF_ROPE + ROPE_COSA) + t * 16 + j; sd = (float*)(p.ws + OFF_ROPE + ROPE_SINA) + t * 16 + j; }
    else { const int jj = j - 16, f = jj & 15; pos = jj < 16 ? row : col; ex = -(double)f / 16.0; cd = (float*)(p.ws + OFF_ROPE + ROPE_COSS) + t * 32 + jj; sd = (float*)(p.ws + OFF_ROPE + ROPE_SINS) + t * 32 + jj; }
    const float inv = (float)exp(ex * 9.210340371976184);
    const float ang = (float)pos * inv;
    double s, c; sincos((double)ang, &s, &c);
    *cd = (float)c; *sd = (float)s;
  }
  const dc* PW = (const dc*)(p.ws + OFF_S5PW); const dc* QQ = (const dc*)(p.ws + OFF_S5Q);
  for (size_t i = gt; i < (size_t)NLAYER * 16 * 127 * 16; i += gn) {
    const int ii = (int)(i & 15); const int rest = (int)(i >> 4); const int dd = rest % 127, lg = rest / 127, g = lg & 15, l = lg >> 4;
    const int d = dd - 63;
    double acc[16];
#pragma unroll
    for (int o = 0; o < 16; ++o) acc[o] = 0.0;
    for (int dir = 0; dir < 2; ++dir) {
      if ((dir == 0 && d < 0) || (dir == 1 && d > 0)) continue;
      const int base = ((l * 2 + dir) * 16 + g) * 64; const int ad = d < 0 ? -d : d;
      const float* cr = p.c_re + (size_t)((l * 2 + dir) * 16 + g) * 16 * 64; const float* ci_ = p.c_im + (size_t)((l * 2 + dir) * 16 + g) * 16 * 64;
      for (int pp = 0; pp < 64; ++pp) {
        const dc a = PW[(size_t)(base + pp) * 65 + ad], q = QQ[base + pp];
        const size_t bi = (size_t)(base + pp) * 16 + ii; const dc B = {(double)p.b_re[bi], (double)p.b_im[bi]};
        const dc t1 = cmul(cmul(a, q), B);
#pragma unroll
        for (int o = 0; o < 16; ++o) acc[o] += (double)cr[o * 64 + pp] * t1.re - (double)ci_[o * 64 + pp] * t1.im;
      }
    }
    if (d == 0) acc[ii] += (double)p.s5_d[l * 256 + g * 16 + ii];
    u16* dst = s5t(p, l) + S5_KC + (size_t)(g * 127 + dd) * 256 + ii;
#pragma unroll
    for (int o = 0; o < 16; ++o) dst[o * 16] = (u16)(pk2((float)acc[o], 0.f) & 0xffff);
  }
  for (size_t i = gt; i < (size_t)NLAYER * 16 * 256 * 1024; i += gn) {
    const int k = (int)(i & 1023), n = (int)((i >> 10) & 255), g = (int)((i >> 18) & 15), l = (int)(i >> 22);
    const int dir = n >> 7, pp = (n >> 1) & 63, reim = n & 1, s = k >> 4, ii = k & 15;
    const int base = ((l * 2 + dir) * 16 + g) * 64 + pp; const int e = dir == 0 ? 63 - s : s;
    const size_t bi = (size_t)base * 16 + ii; const dc B = {(double)p.b_re[bi], (double)p.b_im[bi]};
    const dc v = cmul(cmul(PW[(size_t)base * 65 + e], QQ[base]), B);
    (s5t(p, l) + S5_BST)[((size_t)g * 256 + n) * 1024 + k] = (u16)(pk2((float)(reim ? v.im : v.re), 0.f) & 0xffff);
  }
  for (size_t i = gt; i < (size_t)NLAYER * 16 * 1024 * 256; i += gn) {
    const int k = (int)(i & 255), n = (int)((i >> 8) & 1023), g = (int)((i >> 18) & 15), l = (int)(i >> 22);
    const int dir = k >> 7, pp = (k >> 1) & 63, reim = k & 1, t = n >> 4, o = n & 15;
    const int base = ((l * 2 + dir) * 16 + g) * 64 + pp; const int e = dir == 0 ? t + 1 : 64 - t;
    const size_t ci = ((size_t)(((l * 2 + dir) * 16 + g) * 16 + o)) * 64 + pp; const dc C = {(double)p.c_re[ci], (double)p.c_im[ci]};
    const dc v = cmul(C, PW[(size_t)base * 65 + e]);
    (s5t(p, l) + S5_MRD)[((size_t)g * 1024 + n) * 256 + k] = (u16)(pk2((float)(reim ? -v.im : v.re), 0.f) & 0xffff);
  }
}

static __device__ __forceinline__ void phase_norm(const P& p, int l, int which) {
  const int tid = otid(), lane = tid & 63, wid = tid >> 6;
  const float* gw = (which ? p.norm2 : p.norm1) + l * 1024;
  u16* H = (u16*)(p.ws + OFF_H);
  const int mend = (which == 1 && l == NLAYER - 1) ? MLAT : MTOT;
  const bool first = l == 0 && which == 0;
  f32x4 gq[4];
#pragma unroll
  for (int j = 0; j < 4; ++j) gq[j] = *(const f32x4*)(gw + j * 256 + lane * 4);
  for (int m0 = blockIdx.x * 8 + wid; m0 < mend; m0 += gridDim.x * 16) {
    const int m1 = m0 + gridDim.x * 8; const bool has1 = m1 < mend; const int m1c = has1 ? m1 : m0;
    const float* xr0 = first ? xin(p, m0) : xrow(p, m0); const float* xr1 = first ? xin(p, m1c) : xrow(p, m1c);
    const float* mv0 = modv(p, l, modidx(m0)) + which * 3072; const float* mv1 = modv(p, l, modidx(m1c)) + which * 3072;
    f32x4 v0[4], v1[4], sh0[4], sc0[4], sh1[4], sc1[4];
#pragma unroll
    for (int j = 0; j < 4; ++j) { v0[j] = *(const f32x4*)(xr0 + j * 256 + lane * 4); v1[j] = *(const f32x4*)(xr1 + j * 256 + lane * 4); }
#pragma unroll
    for (int j = 0; j < 4; ++j) { const int c = j * 256 + lane * 4; sh0[j] = *(const f32x4*)(mv0 + c); sc0[j] = *(const f32x4*)(mv0 + 1024 + c); sh1[j] = *(const f32x4*)(mv1 + c); sc1[j] = *(const f32x4*)(mv1 + 1024 + c); }
    float s0 = 0.f, s1 = 0.f;
#pragma unroll
    for (int j = 0; j < 4; ++j)
#pragma unroll
      for (int e = 0; e < 4; ++e) { s0 += v0[j][e] * v0[j][e]; s1 += v1[j][e] * v1[j][e]; }
#pragma unroll
    for (int o = 32; o > 0; o >>= 1) { s0 += __shfl_xor(s0, o); s1 += __shfl_xor(s1, o); }
    const float r0 = rsqrtf(s0 * (1.f / 1024.f) + EPS), r1 = rsqrtf(s1 * (1.f / 1024.f) + EPS);
#pragma unroll
    for (int j = 0; j < 4; ++j) {
      const int c = j * 256 + lane * 4;
      float o[4];
#pragma unroll
      for (int e = 0; e < 4; ++e) o[e] = v0[j][e] * r0 * gq[j][e] * (1.f + sc0[j][e]) + sh0[j][e];
      st4(H + (size_t)m0 * 1024 + c, o[0], o[1], o[2], o[3]);
    }
    if (has1) {
#pragma unroll
      for (int j = 0; j < 4; ++j) {
        const int c = j * 256 + lane * 4;
        float o[4];
#pragma unroll
        for (int e = 0; e < 4; ++e) o[e] = v1[j][e] * r1 * gq[j][e] * (1.f + sc1[j][e]) + sh1[j][e];
        st4(H + (size_t)m1 * 1024 + c, o[0], o[1], o[2], o[3]);
      }
    }
  }
}

static __device__ __forceinline__ void phase_inproj(const P& p, int l, char* lds) {
  const int tid = otid(), lane = tid & 63, wid = tid >> 6, r32 = lane & 31, hi = lane >> 5, wm = wid >> 1, wn = wid & 1, lr = tid >> 3;
  const u16* H = (const u16*)(p.ws + OFF_H); const u16* W = wl(p, l) + W_IN;
  u16* proj = (u16*)(p.ws + OFF_PROJ);
  const float* cosS = (const float*)(p.ws + OFF_ROPE + ROPE_COSS); const float* sinS = (const float*)(p.ws + OFF_ROPE + ROPE_SINS);
  const int ns = tile_steps(264, 12, 16, 2);
  u32x4 ra0[4], rb0[2], ra1[4], rb1[2];
  LdRows al, bl; int mt, nt;
  auto mk = [&](int mt_, int nt_, LdRows& a_, LdRows& b_) {
#pragma unroll
    for (int j = 0; j < 4; ++j) a_.p[j] = H + (size_t)(mt_ * 256 + lr + 64 * j) * 1024;
#pragma unroll
    for (int j = 0; j < 2; ++j) b_.p[j] = W + (size_t)(nt_ * 128 + lr + 64 * j) * 1024;
    b_.p[2] = b_.p[3] = b_.p[0];
  };
  int s = tile_next(0, ns, 264, 12, 16, 2, mt, nt);
  if (s >= 0) { mk(mt, nt, al, bl); gemm_issue<4, 2>(tid, al, bl, 16, ra0, rb0, ra1, rb1); }
  while (s >= 0) {
    f32x16 acc[2][2]; zero_acc(acc);
    __syncthreads();
    gemm_run<4, 2, 2, 2>(tid, lds + LDS_SCR, al, bl, 16, acc, ra0, rb0, ra1, rb1);
    int mt2 = 0, nt2 = 0; const int s2 = tile_next(s + 1, ns, 264, 12, 16, 2, mt2, nt2);
    if (s2 >= 0) { mk(mt2, nt2, al, bl); gemm_issue<4, 2>(tid, al, bl, 16, ra0, rb0, ra1, rb1); }
    const int n0w = nt * 128 + wn * 64, mw = mt * 256 + wm * 64;
    if (n0w < 896) {
#pragma unroll
      for (int tm = 0; tm < 2; ++tm) {
        const int m = mw + 32 * tm + r32;
        u16* dst = proj + (size_t)m * PROJ_LD + n0w;
#pragma unroll
        for (int tn = 0; tn < 2; ++tn) {
#pragma unroll
          for (int rg = 0; rg < 4; ++rg) st4(dst + 32 * tn + 8 * rg + 4 * hi, acc[tm][tn][4 * rg], acc[tm][tn][4 * rg + 1], acc[tm][tn][4 * rg + 2], acc[tm][tn][4 * rg + 3]);
        }
      }
    } else if (n0w < 1408) {
      const bool isq = n0w < 1280; const int head = isq ? (n0w - 896) >> 6 : (n0w - 1280) >> 6;
      const float* g = (isq ? p.sq_norm : p.sk_norm) + l * 64;
      u16* dbase = (u16*)(p.ws + (isq ? OFF_QS : OFF_KS));
      const float osc = isq ? 0.125f * LOG2E : 1.f;
#pragma unroll
      for (int tm = 0; tm < 2; ++tm) {
        const int m = mw + 32 * tm + r32;
        float ss = 0.f;
#pragma unroll
        for (int r = 0; r < 16; ++r) ss += acc[tm][0][r] * acc[tm][0][r] + acc[tm][1][r] * acc[tm][1][r];
        ss = xsum32(ss);
        const float rs = rsqrtf(ss * (1.f / 64.f) + EPS);
        u16* dst = dbase + head_row(m, head, isq ? 6 : 2) * 64;
        const bool lat = m < MLAT; const int t = m & 8191;
        f32x4 g1q[4], g2q[4], csq[4], snq[4];
#pragma unroll
        for (int rg = 0; rg < 4; ++rg) {
          const int d = 8 * rg + 4 * hi;
          g1q[rg] = *(const f32x4*)(g + d); g2q[rg] = *(const f32x4*)(g + 32 + d);
          csq[rg] = f32x4{1.f, 1.f, 1.f, 1.f}; snq[rg] = f32x4{0.f, 0.f, 0.f, 0.f};
          if (lat) { csq[rg] = *(const f32x4*)(cosS + t * 32 + d); snq[rg] = *(const f32x4*)(sinS + t * 32 + d); }
        }
#pragma unroll
        for (int rg = 0; rg < 4; ++rg) {
          const int d = 8 * rg + 4 * hi;
          const f32x4 g1 = g1q[rg], g2 = g2q[rg], cs = csq[rg], sn = snq[rg];
          float y1[4], y2[4];
#pragma unroll
          for (int e = 0; e < 4; ++e) {
            const float x1 = acc[tm][0][4 * rg + e] * rs * g1[e], x2 = acc[tm][1][4 * rg + e] * rs * g2[e];
            y1[e] = (x1 * cs[e] - x2 * sn[e]) * osc; y2[e] = (x1 * sn[e] + x2 * cs[e]) * osc;
          }
          st4(dst + d, y1[0], y1[1], y1[2], y1[3]); st4(dst + 32 + d, y2[0], y2[1], y2[2], y2[3]);
        }
      }
    } else if (n0w < 1536) {
      const int head = (n0w - 1408) >> 6;
      u16* dbase = (u16*)(p.ws + OFF_VS);
#pragma unroll
      for (int tm = 0; tm < 2; ++tm) {
        const int m = mw + 32 * tm + r32;
        u16* dst = dbase + head_row(m, head, 2) * 64;
#pragma unroll
        for (int tn = 0; tn < 2; ++tn)
#pragma unroll
          for (int rg = 0; rg < 4; ++rg) st4(dst + 32 * tn + 8 * rg + 4 * hi, acc[tm][tn][4 * rg], acc[tm][tn][4 * rg + 1], acc[tm][tn][4 * rg + 2], acc[tm][tn][4 * rg + 3]);
      }
    }
    s = s2; mt = mt2; nt = nt2;
  }
  for (int it = blockIdx.x; it < 264; it += gridDim.x) {
    LdRows a2, b2;
#pragma unroll
    for (int j = 0; j < 4; ++j) a2.p[j] = H + (size_t)(it * 256 + lr + 64 * j) * 1024;
    b2.p[0] = W + (size_t)(1536 + (lr < 32 ? lr : 31)) * 1024; b2.p[1] = b2.p[2] = b2.p[3] = b2.p[0];
    f32x16 acc2[1][2]; zero_acc(acc2);
    __syncthreads();
    gemm_main<8, 1, 1, 2>(tid, lds + LDS_SCR, a2, b2, 16, acc2);
    u16* dst = proj + (size_t)(it * 256 + wid * 32 + r32) * PROJ_LD + 896;
#pragma unroll
    for (int rg = 0; rg < 4; ++rg) st4(dst + 8 * rg + 4 * hi, acc2[0][0][4 * rg], acc2[0][0][4 * rg + 1], acc2[0][0][4 * rg + 2], acc2[0][0][4 * rg + 3]);
  }
}

template <int NCOLS>
DI void lora_rstd(int tid, const u16* proj, int m0, int col0, float* scr) {
  constexpr int NCH = NCOLS / 64;
  const int sub = tid & 7, rs = tid >> 3;
  u32x4 w[4][NCH];
#pragma unroll
  for (int j = 0; j < 4; ++j) {
    const u16* src = proj + (size_t)(m0 + rs + 64 * j) * PROJ_LD + col0 + sub * 8;
#pragma unroll
    for (int c = 0; c < NCH; ++c) w[j][c] = *(const u32x4*)(src + c * 64);
  }
#pragma unroll
  for (int j = 0; j < 4; ++j) {
    float ss = 0.f;
#pragma unroll
    for (int c = 0; c < NCH; ++c)
#pragma unroll
      for (int e = 0; e < 4; ++e) { const float a = bflo(w[j][c][e]), b = bfhi(w[j][c][e]); ss += a * a + b * b; }
    ss += __shfl_xor(ss, 1); ss += __shfl_xor(ss, 2); ss += __shfl_xor(ss, 4);
    if (sub == 0) scr[rs + 64 * j] = rsqrtf(ss * (1.f / (float)NCOLS) + EPS);
  }
}

static __device__ __forceinline__ void phase_mla_prep(const P& p, int l, char* lds) {
  const int tid = otid(), lane = tid & 63, wid = tid >> 6, r32 = lane & 31, hi = lane >> 5, lr = tid >> 3;
  const u16* proj = (const u16*)(p.ws + OFF_PROJ);
  float* scr = (float*)lds;
  const float* cosA = (const float*)(p.ws + OFF_ROPE + ROPE_COSA); const float* sinA = (const float*)(p.ws + OFF_ROPE + ROPE_SINA);
  {
    const u16* W = wl(p, l) + W_UQ; const float* g = p.q_norm + l * 96; u16* Qm = (u16*)(p.ws + OFF_QM);
    const int wm = wid >> 1, wn = wid & 1;
    const float osc = 0.10206207261596577f * LOG2E;
    for (int s = 0, ns = tile_steps(264, 3, 32, 1); s < ns; ++s) {
      int mt, nt; if (!tile_get(s, 264, 3, 32, 1, mt, nt)) continue;
      const int m0 = mt * 256;
      __syncthreads();
      lora_rstd<384>(tid, proj, m0, 0, scr);
      LdRows al, bl;
#pragma unroll
      for (int j = 0; j < 4; ++j) al.p[j] = proj + (size_t)(m0 + lr + 64 * j) * PROJ_LD;
#pragma unroll
      for (int j = 0; j < 3; ++j) bl.p[j] = W + (size_t)(nt * 192 + lr + 64 * j) * 384;
      bl.p[3] = bl.p[0];
      f32x16 acc[2][3]; zero_acc(acc);
      gemm_main<4, 2, 2, 3>(tid, lds + LDS_SCR, al, bl, 6, acc);
      const int head = nt * 2 + wn;
#pragma unroll
      for (int tm = 0; tm < 2; ++tm) {
        const int rl = wm * 64 + 32 * tm + r32, m = m0 + rl;
        const float rlo = scr[rl];
        float ss = 0.f;
#pragma unroll
        for (int tn = 0; tn < 3; ++tn)
#pragma unroll
          for (int r = 0; r < 16; ++r) ss += acc[tm][tn][r] * acc[tm][tn][r];
        ss = xsum32(ss);
        const float f = rlo * rsqrtf(rlo * rlo * ss * (1.f / 96.f) + EPS);
        u16* dst = Qm + head_row(m, head, 6) * 96;
        const bool lat = m < MLAT; const int t = m & 8191;
        f32x4 gq[2][4], r1q[2], r2q[2], csq[2], snq[2];
#pragma unroll
        for (int tn = 0; tn < 2; ++tn)
#pragma unroll
          for (int rg = 0; rg < 4; ++rg) gq[tn][rg] = *(const f32x4*)(g + 32 * tn + 8 * rg + 4 * hi);
#pragma unroll
        for (int rg = 0; rg < 2; ++rg) {
          const int j = 8 * rg + 4 * hi; r1q[rg] = *(const f32x4*)(g + 64 + j); r2q[rg] = *(const f32x4*)(g + 80 + j);
          csq[rg] = f32x4{1.f, 1.f, 1.f, 1.f}; snq[rg] = f32x4{0.f, 0.f, 0.f, 0.f};
          if (lat) { csq[rg] = *(const f32x4*)(cosA + t * 16 + j); snq[rg] = *(const f32x4*)(sinA + t * 16 + j); }
        }
#pragma unroll
        for (int tn = 0; tn < 2; ++tn)
#pragma unroll
          for (int rg = 0; rg < 4; ++rg) {
            const int d = 32 * tn + 8 * rg + 4 * hi; const f32x4 gv = gq[tn][rg];
            st4(dst + d, acc[tm][tn][4 * rg] * f * gv[0] * osc, acc[tm][tn][4 * rg + 1] * f * gv[1] * osc, acc[tm][tn][4 * rg + 2] * f * gv[2] * osc, acc[tm][tn][4 * rg + 3] * f * gv[3] * osc);
          }
#pragma unroll
        for (int rg = 0; rg < 2; ++rg) {
          const int j = 8 * rg + 4 * hi; const f32x4 g1 = r1q[rg], g2 = r2q[rg], cs = csq[rg], sn = snq[rg];
          float y1[4], y2[4];
#pragma unroll
          for (int e = 0; e < 4; ++e) {
            const float x1 = acc[tm][2][4 * rg + e] * f * g1[e], x2 = acc[tm][2][8 + 4 * rg + e] * f * g2[e];
            y1[e] = (x1 * cs[e] - x2 * sn[e]) * osc; y2[e] = (x1 * sn[e] + x2 * cs[e]) * osc;
          }
          st4(dst + 64 + j, y1[0], y1[1], y1[2], y1[3]); st4(dst + 80 + j, y2[0], y2[1], y2[2], y2[3]);
        }
      }
    }
  }
  {
    const u16* W = wl(p, l) + W_UKV; const float* g = p.k_norm + l * 96; u16* Km = (u16*)(p.ws + OFF_KM); u16* Vm = (u16*)(p.ws + OFF_VM);
    for (int s = 0, ns = tile_steps(264, 6, 16, 2); s < ns; ++s) {
      int mt, head; if (!tile_get(s, 264, 6, 16, 2, mt, head)) continue;
      const int m0 = mt * 256;
      __syncthreads();
      lora_rstd<256>(tid, proj, m0, 384, scr);
      LdRows al, bl;
#pragma unroll
      for (int j = 0; j < 4; ++j) al.p[j] = proj + (size_t)(m0 + lr + 64 * j) * PROJ_LD + 384;
#pragma unroll
      for (int j = 0; j < 2; ++j) bl.p[j] = W + (size_t)(head * 128 + lr + 64 * j) * 256;
      bl.p[2] = bl.p[3] = bl.p[0];
      f32x16 acc[1][4]; zero_acc(acc);
      gemm_main<8, 1, 1, 4>(tid, lds + LDS_SCR, al, bl, 4, acc);
      const int rl = wid * 32 + r32, m = m0 + rl;
      const float rlo = scr[rl];
      float ssr = 0.f; u32x4 wx1, wx2;
      {
        const u16* kp = proj + (size_t)m * PROJ_LD + 896;
        const u32x4 w0 = *(const u32x4*)(kp), w1 = *(const u32x4*)(kp + 8), w2 = *(const u32x4*)(kp + 16), w3 = *(const u32x4*)(kp + 24);
#pragma unroll
        for (int e = 0; e < 4; ++e) {
          ssr += bflo(w0[e]) * bflo(w0[e]) + bfhi(w0[e]) * bfhi(w0[e]) + bflo(w1[e]) * bflo(w1[e]) + bfhi(w1[e]) * bfhi(w1[e]);
          ssr += bflo(w2[e]) * bflo(w2[e]) + bfhi(w2[e]) * bfhi(w2[e]) + bflo(w3[e]) * bflo(w3[e]) + bfhi(w3[e]) * bfhi(w3[e]);
        }
        wx1 = hi ? w1 : w0; wx2 = hi ? w3 : w2;
      }
      float ss = 0.f;
#pragma unroll
      for (int tn = 0; tn < 2; ++tn)
#pragma unroll
        for (int r = 0; r < 16; ++r) ss += acc[0][tn][r] * acc[0][tn][r];
      ss = xsum32(ss);
      const float rk = rsqrtf((rlo * rlo * ss + ssr) * (1.f / 96.f) + EPS);
      const size_t hr = head_row(m, head, 6);
      u16* kd = Km + hr * 96; u16* vd = Vm + hr * 64;
      const bool lat = m < MLAT; const int t = m & 8191;
      f32x4 gq[2][4]; float gr1[8], gr2[8], csr[8], snr[8];
#pragma unroll
      for (int tn = 0; tn < 2; ++tn)
#pragma unroll
        for (int rg = 0; rg < 4; ++rg) gq[tn][rg] = *(const f32x4*)(g + 32 * tn + 8 * rg + 4 * hi);
#pragma unroll
      for (int e = 0; e < 8; ++e) {
        const int j = 8 * hi + e; gr1[e] = g[64 + j]; gr2[e] = g[80 + j]; csr[e] = 1.f; snr[e] = 0.f;
        if (lat) { csr[e] = cosA[t * 16 + j]; snr[e] = sinA[t * 16 + j]; }
      }
#pragma unroll
      for (int tn = 0; tn < 2; ++tn)
#pragma unroll
        for (int rg = 0; rg < 4; ++rg) {
          const int d = 32 * tn + 8 * rg + 4 * hi; const f32x4 gv = gq[tn][rg]; const float f = rlo * rk;
          st4(kd + d, acc[0][tn][4 * rg] * f * gv[0], acc[0][tn][4 * rg + 1] * f * gv[1], acc[0][tn][4 * rg + 2] * f * gv[2], acc[0][tn][4 * rg + 3] * f * gv[3]);
          st4(vd + d, acc[0][2 + tn][4 * rg] * rlo, acc[0][2 + tn][4 * rg + 1] * rlo, acc[0][2 + tn][4 * rg + 2] * rlo, acc[0][2 + tn][4 * rg + 3] * rlo);
        }
      {
        float y1[8], y2[8];
#pragma unroll
        for (int e = 0; e < 8; ++e) {
          const int j = 8 * hi + e;
          const float k1 = (e & 1) ? bfhi(wx1[e >> 1]) : bflo(wx1[e >> 1]), k2 = (e & 1) ? bfhi(wx2[e >> 1]) : bflo(wx2[e >> 1]);
          const float x1 = k1 * rk * gr1[e], x2 = k2 * rk * gr2[e];
          const float cs = csr[e], sn = snr[e];
          y1[e] = x1 * cs - x2 * sn; y2[e] = x1 * sn + x2 * cs;
        }
        u32x4 w1 = {pk2(y1[0], y1[1]), pk2(y1[2], y1[3]), pk2(y1[4], y1[5]), pk2(y1[6], y1[7])};
        u32x4 w2 = {pk2(y2[0], y2[1]), pk2(y2[2], y2[3]), pk2(y2[4], y2[5]), pk2(y2[6], y2[7])};
        *(u32x4*)(kd + 64 + 8 * hi) = w1; *(u32x4*)(kd + 80 + 8 * hi) = w2;
      }
    }
  }
}

static __device__ __forceinline__ void phase_s5_states(const P& p, int l, char* lds) {
  const int tid = otid(), lane = tid & 63, wid = tid >> 6, r32 = lane & 31, hi = lane >> 5, wm = wid >> 1, wn = wid & 1, lr = tid >> 3;
  const u16* proj = (const u16*)(p.ws + OFF_PROJ); float* Sst = (float*)(p.ws + OFF_SST);
  for (int it = blockIdx.x; it < 160; it += gridDim.x) {
    const int g = it / 10, r = it % 10, mt = r >> 1, nt = r & 1;
    LdS5A al; LdRows bl;
#pragma unroll
    for (int j = 0; j < 4; ++j) { const int row = mt * 256 + lr + 64 * j; al.pu[j] = proj + (size_t)s5_tokbase(row < 1056 ? row : 0) * PROJ_LD + 640 + g * 16; al.ph[j] = al.pu[j]; }
    const u16* B = s5t(p, l) + S5_BST + (size_t)g * 256 * 1024;
#pragma unroll
    for (int j = 0; j < 2; ++j) bl.p[j] = B + (size_t)(nt * 128 + lr + 64 * j) * 1024;
    bl.p[2] = bl.p[3] = bl.p[0];
    f32x16 acc[2][2]; zero_acc(acc);
    __syncthreads();
    gemm_main<4, 2, 2, 2>(tid, lds + LDS_SCR, al, bl, 16, acc);
#pragma unroll
    for (int tm = 0; tm < 2; ++tm) {
      const int row = mt * 256 + wm * 64 + 32 * tm + r32;
      if (row < 1056) {
        float* dst = Sst + ((size_t)row * 16 + g) * 256 + nt * 128 + wn * 64;
#pragma unroll
        for (int tn = 0; tn < 2; ++tn)
#pragma unroll
          for (int rg = 0; rg < 4; ++rg) { f32x4 v = {acc[tm][tn][4 * rg], acc[tm][tn][4 * rg + 1], acc[tm][tn][4 * rg + 2], acc[tm][tn][4 * rg + 3]}; *(f32x4*)(dst + 32 * tn + 8 * rg + 4 * hi) = v; }
      }
    }
  }
}

static __device__ __forceinline__ void s5_scan_item(const P& p, int l, int blk) {
  const int gt = blk * NTHREADS + otid();
  const int pp = gt & 63, dir = (gt >> 6) & 1, g = (gt >> 7) & 15, b = gt >> 11;
  const dc a64d = ((const dc*)(p.ws + OFF_S5PW))[(size_t)((((l * 2 + dir) * 16 + g) * 64) + pp) * 65 + 64];
  const float ar = (float)a64d.re, ai = (float)a64d.im;
  const float* Sst = (const float*)(p.ws + OFF_SST); unsigned* Hin = (unsigned*)(p.ws + OFF_HIN);
  const int col = g * 256 + dir * 128 + 2 * pp;
  float hr = 0.f, hi_ = 0.f;
#pragma unroll 1
  for (int s0 = 0; s0 < 132; s0 += 4) {
    int rows[4]; f32x2 sv[4];
#pragma unroll
    for (int e = 0; e < 4; ++e) {
      const int st = s0 + e; int row;
      if (st < 4) { const int c = dir ? 3 - st : st; row = 1024 + b * 4 + c; } else { const int s2 = st - 4; const int c = dir ? 127 - s2 : s2; row = b * 128 + c; }
      rows[e] = row; sv[e] = *(const f32x2*)(Sst + (size_t)row * 4096 + col);
    }
#pragma unroll
    for (int e = 0; e < 4; ++e) {
      Hin[((size_t)rows[e] * 4096 + col) >> 1] = pk2(hr, hi_);
      const float nr = ar * hr - ai * hi_ + sv[e][0], ni = ar * hi_ + ai * hr + sv[e][1];
      hr = nr; hi_ = ni;
    }
  }
}

static __device__ __forceinline__ void phase_s5_out(const P& p, int l, char* lds) {
  const int tid = otid(), lane = tid & 63, wid = tid >> 6, r32 = lane & 31, hi = lane >> 5, wm = wid >> 1, wn = wid & 1, lr = tid >> 3;
  const u16* proj = (const u16*)(p.ws + OFF_PROJ); const u16* Hin = (const u16*)(p.ws + OFF_HIN); u16* zb = (u16*)(p.ws + OFF_ZB);
  const int per_g = l == NLAYER - 1 ? 32 : 40;
  for (int it = blockIdx.x; it < 16 * per_g; it += gridDim.x) {
    const int g = it / per_g, r = it % per_g, mt = r >> 3, nt = r & 7;
    LdS5A al; LdS5B bl;
#pragma unroll
    for (int j = 0; j < 4; ++j) {
      const int row = mt * 256 + lr + 64 * j;
      al.pu[j] = proj + (size_t)s5_tokbase(row < 1056 ? row : 0) * PROJ_LD + 640 + g * 16;
      al.ph[j] = Hin + ((size_t)(row < 1056 ? row : 0) * 16 + g) * 256;
    }
    const u16* Kc = s5t(p, l) + S5_KC + (size_t)g * 127 * 256; const u16* Mrd = s5t(p, l) + S5_MRD + (size_t)g * 1024 * 256;
#pragma unroll
    for (int j = 0; j < 2; ++j) { const int n = nt * 128 + lr + 64 * j; bl.pk[j] = Kc + ((n >> 4) + 63) * 256 + (n & 15) * 16; bl.pm[j] = Mrd + (size_t)n * 256; }
    f32x16 acc[2][2]; zero_acc(acc);
    __syncthreads();
    gemm_main<4, 2, 2, 2>(tid, lds + LDS_SCR, al, bl, 20, acc);
#pragma unroll
    for (int tm = 0; tm < 2; ++tm) {
      const int row = mt * 256 + wm * 64 + 32 * tm + r32;
      if (row < 1056) {
        const int tb = s5_tokbase(row);
#pragma unroll
        for (int tn = 0; tn < 2; ++tn)
#pragma unroll
          for (int rg = 0; rg < 4; ++rg) {
            const int n = nt * 128 + wn * 64 + 32 * tn + 8 * rg + 4 * hi;
            u16* dst = zb + (size_t)(tb + (n >> 4)) * 256 + g * 16 + (n & 15);
            st4(dst, gelu_tanh(acc[tm][tn][4 * rg]), gelu_tanh(acc[tm][tn][4 * rg + 1]), gelu_tanh(acc[tm][tn][4 * rg + 2]), gelu_tanh(acc[tm][tn][4 * rg + 3]));
          }
      }
    }
  }
}

static __device__ __forceinline__ void phase_glu(const P& p, int l, char* lds) {
  const int tid = otid(), lane = tid & 63, wid = tid >> 6, r32 = lane & 31, hi = lane >> 5, wm = wid >> 1, wn = wid & 1, lr = tid >> 3;
  const u16* zb = (const u16*)(p.ws + OFF_ZB); const u16* W = wl(p, l) + W_GLU; u16* mix = (u16*)(p.ws + OFF_MIX); const float* bg = p.b_glu + l * 256;
  const int MT = l == NLAYER - 1 ? 256 : 264;
  for (int s = 0, ns = tile_steps(MT, 2, 16, 2); s < ns; ++s) {
    int mt, nt; if (!tile_get(s, MT, 2, 16, 2, mt, nt)) continue;
    LdRows al, bl;
#pragma unroll
    for (int j = 0; j < 4; ++j) al.p[j] = zb + (size_t)(mt * 256 + lr + 64 * j) * 256;
#pragma unroll
    for (int j = 0; j < 2; ++j) bl.p[j] = W + (size_t)(nt * 128 + lr + 64 * j) * 256;
    bl.p[2] = bl.p[3] = bl.p[0];
    f32x16 acc[2][2]; zero_acc(acc);
    __syncthreads();
    gemm_main<4, 2, 2, 2>(tid, lds + LDS_SCR, al, bl, 4, acc);
    u32x2 zq[2][2][4]; f32x4 bq[2][4];
#pragma unroll
    for (int tn = 0; tn < 2; ++tn)
#pragma unroll
      for (int rg = 0; rg < 4; ++rg) {
        const int n = nt * 128 + wn * 64 + 32 * tn + 8 * rg + 4 * hi; bq[tn][rg] = *(const f32x4*)(bg + n);
#pragma unroll
        for (int tm = 0; tm < 2; ++tm) zq[tm][tn][rg] = *(const u32x2*)(zb + (size_t)(mt * 256 + wm * 64 + 32 * tm + r32) * 256 + n);
      }
#pragma unroll
    for (int tm = 0; tm < 2; ++tm) {
      const int m = mt * 256 + wm * 64 + 32 * tm + r32;
#pragma unroll
      for (int tn = 0; tn < 2; ++tn)
#pragma unroll
        for (int rg = 0; rg < 4; ++rg) {
          const int n = nt * 128 + wn * 64 + 32 * tn + 8 * rg + 4 * hi;
          const u32x2 zw = zq[tm][tn][rg]; const f32x4 bv = bq[tn][rg];
          const float z0 = bflo(zw[0]), z1 = bfhi(zw[0]), z2 = bflo(zw[1]), z3 = bfhi(zw[1]);
          st4(mix + (size_t)m * 1024 + 384 + n, z0 * sigmoid_f(acc[tm][tn][4 * rg] + bv[0]), z1 * sigmoid_f(acc[tm][tn][4 * rg + 1] + bv[1]), z2 * sigmoid_f(acc[tm][tn][4 * rg + 2] + bv[2]),
              z3 * sigmoid_f(acc[tm][tn][4 * rg + 3] + bv[3]));
        }
    }
  }
}

template <int DQK>
DI void attn_unit(int tid, char* lds, const u16* Qp, const u16* K1, const u16* V1, int nt1, int kpos0, const u16* K2, const u16* V2, int nt2, int qpos0, bool mask, float m_init, float l_init, u16* Op) {
  constexpr int KP = DQK * 2 + 16, KB = 64 * KP, VB = 8192, SB = KB + VB, NCH = DQK / 8, NKC = 64 * NCH, ND = DQK / 16;
  const int lane = tid & 63, wid = tid >> 6, r32 = lane & 31, hi = lane >> 5;
  bf16x8 qr[ND];
  {
    const u16* qrow = Qp + (size_t)(wid * 32 + r32) * DQK + hi * 8;
#pragma unroll
    for (int d0 = 0; d0 < ND; ++d0) qr[d0] = *(const bf16x8*)(qrow + d0 * 16);
  }
  const int kk0 = tid / NCH, kc0 = tid % NCH;
  const int id1 = tid + NTHREADS; const bool has1 = id1 < NKC; const int kk1 = id1 / NCH, kc1 = id1 % NCH;
  const int idl = has1 ? id1 : tid;
  const int vkey = tid >> 3, vc = tid & 7;
  const int vst = ((vkey >> 3) * 2 + (vc >> 2)) * 512 + (vkey & 7) * 64 + (vc & 3) * 16;
  const int vrb = ((lane & 3) << 3) | (((lane >> 2) & 3) << 6) | (((lane >> 4) & 1) << 5) | (((lane >> 5) & 1) << 8);
  const int kw0 = kk0 * KP + kc0 * 16, kw1 = kk1 * KP + kc1 * 16, kro = r32 * KP + hi * 16;
  f32x16 o0, o1;
#pragma unroll
  for (int r = 0; r < 16; ++r) { o0[r] = 0.f; o1[r] = 0.f; }
  constexpr float THR = 8.f;
  float mrun = m_init, lrun = hi == 0 ? l_init : 0.f;
  f32x16 negm;
#pragma unroll
  for (int r = 0; r < 16; ++r) negm[r] = -mrun;
  const int NT = nt1 + nt2;
  const int qpos = qpos0 + wid * 32 + r32;
  u32x4 sk0, sk1, sv;
  auto gl = [&](int i) {
    const u16* kp; const u16* vp;
    if (i < nt1) { kp = K1 + (size_t)i * 64 * DQK; vp = V1 + (size_t)i * 4096; } else { kp = K2 + (size_t)(i - nt1) * 64 * DQK; vp = V2 + (size_t)(i - nt1) * 4096; }
    sk0 = *(const u32x4*)(kp + (size_t)tid * 8); sk1 = *(const u32x4*)(kp + (size_t)idl * 8); sv = *(const u32x4*)(vp + (size_t)tid * 8);
  };
  auto sw = [&](int st) {
    char* b = lds + st * SB;
    *(u32x4*)(b + kw0) = sk0; if (has1) *(u32x4*)(b + kw1) = sk1; *(u32x4*)(b + KB + vst) = sv;
  };
  auto qk = [&](int st, f32x16& p0, f32x16& p1) {
    const char* Kb = lds + st * SB + kro;
#pragma unroll
    for (int d0 = 0; d0 < ND; ++d0) {
      const bf16x8 a0 = *(const bf16x8*)(Kb + d0 * 32);
      const bf16x8 a1 = *(const bf16x8*)(Kb + 32 * KP + d0 * 32);
      if (d0 == 0) { p0 = mfma(a0, qr[0], negm); p1 = mfma(a1, qr[0], negm); } else { p0 = mfma(a0, qr[d0], p0); p1 = mfma(a1, qr[d0], p1); }
    }
  };
  const int qw0 = qpos0 + wid * 32;
  auto live = [&](int i) { if (!mask || i >= nt1) return true; const int kb = kpos0 + i * 64; return kb + 63 >= qw0 - 128 && kb <= qw0 + 31 + 128; };
  auto step = [&](f32x16& c0, f32x16& c1, f32x16& n0, f32x16& n1, int i, int s_cur, int s_nxt, int s_wr) {
    const bool has_nxt = i + 1 < NT, has_wr = i + 2 < NT;
    if (has_wr) gl(i + 2);
    if (has_nxt && live(i + 1)) qk(s_nxt, n0, n1);
    if (live(i)) {
    if (mask && i < nt1) {
      const int kb = kpos0 + i * 64 - qpos;
#pragma unroll
      for (int r = 0; r < 16; ++r) {
        const int d0_ = kb + crow(r, hi), d1_ = d0_ + 32;
        if (d0_ > 128 || d0_ < -128) c0[r] = -1e30f;
        if (d1_ > 128 || d1_ < -128) c1[r] = -1e30f;
      }
    }
    float mt = c0[0];
#pragma unroll
    for (int r = 1; r < 16; ++r) mt = fmaxf(mt, c0[r]);
#pragma unroll
    for (int r = 0; r < 16; ++r) mt = fmaxf(mt, c1[r]);
    mt = xmax32(mt);
    if (__any(mt > THR)) {
      const float delta = fmaxf(mt, 0.f), alpha = ex2(-delta);
      mrun += delta; lrun *= alpha;
#pragma unroll
      for (int r = 0; r < 16; ++r) { o0[r] *= alpha; o1[r] *= alpha; c0[r] -= delta; c1[r] -= delta; n0[r] -= delta; n1[r] -= delta; negm[r] = -mrun; }
    }
    float ls = 0.f;
#pragma unroll
    for (int r = 0; r < 16; ++r) { c0[r] = ex2(c0[r]); c1[r] = ex2(c1[r]); ls += c0[r] + c1[r]; }
    lrun += ls;
    bf16x8 pb[4];
    { u32x4 w = {pk2(c0[0], c0[1]), pk2(c0[2], c0[3]), pk2(c0[4], c0[5]), pk2(c0[6], c0[7])}; pb[0] = __builtin_bit_cast(bf16x8, w); }
    { u32x4 w = {pk2(c0[8], c0[9]), pk2(c0[10], c0[11]), pk2(c0[12], c0[13]), pk2(c0[14], c0[15])}; pb[1] = __builtin_bit_cast(bf16x8, w); }
    { u32x4 w = {pk2(c1[0], c1[1]), pk2(c1[2], c1[3]), pk2(c1[4], c1[5]), pk2(c1[6], c1[7])}; pb[2] = __builtin_bit_cast(bf16x8, w); }
    { u32x4 w = {pk2(c1[8], c1[9]), pk2(c1[10], c1[11]), pk2(c1[12], c1[13]), pk2(c1[14], c1[15])}; pb[3] = __builtin_bit_cast(bf16x8, w); }
    LAS char* Vb = (LAS char*)(lds + s_cur * SB + KB + vrb);
#pragma unroll
    for (int ks = 0; ks < 4; ++ks) {
      const s16x4 l0 = __builtin_amdgcn_ds_read_tr16_b64_v4i16((LAS s16x4*)(Vb + ((2 * ks) * 2 + 0) * 512));
      const s16x4 h0 = __builtin_amdgcn_ds_read_tr16_b64_v4i16((LAS s16x4*)(Vb + ((2 * ks + 1) * 2 + 0) * 512));
      const s16x4 l1 = __builtin_amdgcn_ds_read_tr16_b64_v4i16((LAS s16x4*)(Vb + ((2 * ks) * 2 + 1) * 512));
      const s16x4 h1 = __builtin_amdgcn_ds_read_tr16_b64_v4i16((LAS s16x4*)(Vb + ((2 * ks + 1) * 2 + 1) * 512));
      const bf16x8 va0 = {l0[0], l0[1], l0[2], l0[3], h0[0], h0[1], h0[2], h0[3]};
      const bf16x8 va1 = {l1[0], l1[1], l1[2], l1[3], h1[0], h1[1], h1[2], h1[3]};
      o0 = mfma(va0, pb[ks], o0); o1 = mfma(va1, pb[ks], o1);
    }
    }
    if (has_wr) sw(s_wr);
    __syncthreads();
  };
  gl(0); sw(0);
  if (NT > 1) { gl(1); sw(1); }
  __syncthreads();
  f32x16 pA0, pA1, pB0, pB1;
#pragma unroll
  for (int r = 0; r < 16; ++r) { pB0[r] = 0.f; pB1[r] = 0.f; }
  if (live(0)) qk(0, pA0, pA1);
  int s_cur = 0, s_nxt = 1, s_wr = 2;
#pragma unroll 1
  for (int i = 0; i < NT; i += 2) {
    step(pA0, pA1, pB0, pB1, i, s_cur, s_nxt, s_wr);
    if (i + 1 >= NT) break;
    step(pB0, pB1, pA0, pA1, i + 1, s_nxt, s_wr, s_cur);
    const int t_ = s_cur; s_cur = s_wr; s_wr = s_nxt; s_nxt = t_;
  }
  const float inv = rcpf_(xsum32(lrun));
  u16* orow = Op + (size_t)(wid * 32 + r32) * 1024;
#pragma unroll
  for (int rg = 0; rg < 4; ++rg) {
    st4(orow + 8 * rg + 4 * hi, o0[4 * rg] * inv, o0[4 * rg + 1] * inv, o0[4 * rg + 2] * inv, o0[4 * rg + 3] * inv);
    st4(orow + 32 + 8 * rg + 4 * hi, o1[4 * rg] * inv, o1[4 * rg + 1] * inv, o1[4 * rg + 2] * inv, o1[4 * rg + 3] * inv);
  }
}

static __device__ __forceinline__ void phase_attn(const P& p, int l, char* lds) {
  if (blockIdx.x < 32) s5_scan_item(p, l, blockIdx.x);
  const int tid = otid();
  const u16* Qm = (const u16*)(p.ws + OFF_QM); const u16* Km = (const u16*)(p.ws + OFF_KM); const u16* Vm = (const u16*)(p.ws + OFF_VM);
  const u16* Qs = (const u16*)(p.ws + OFF_QS); const u16* Ks = (const u16*)(p.ws + OFF_KS); const u16* Vs = (const u16*)(p.ws + OFF_VS);
  u16* mix = (u16*)(p.ws + OFF_MIX);
  constexpr size_t CTX6 = (size_t)NBATCH * 6 * TLAT, CTX2 = (size_t)NBATCH * 2 * TLAT;
  const int nunits = l == NLAYER - 1 ? 3072 : 3168;
  for (int it = blockIdx.x; it < nunits; it += gridDim.x) {
    __syncthreads();
    if (it < 3072) {
      const int u = it < 1536 ? it : it - 1536;
      const int rr = u >> 8, bb = u & 255, bh = rr * 8 + (bb & 7), qb = bb >> 3, b = bh / 6, h = bh % 6, q0 = qb * 256;
      if (it < 1536) {
        const size_t r0 = (size_t)bh * TLAT, c0 = CTX6 + (size_t)bh * TCTX;
        attn_unit<96>(tid, lds, Qm + (r0 + q0) * 96, Km + r0 * 96, Vm + r0 * 64, 128, 0, Km + c0 * 96, Vm + c0 * 64, 4, q0, false, 0.f, 0.f, mix + (size_t)(b * TLAT + q0) * 1024 + h * 64);
      } else {
        const int kvh = h / 3, lo = q0 - 128 < 0 ? 0 : q0 - 128, hi_ = q0 + 384 > TLAT ? TLAT : q0 + 384;
        const size_t r0 = (size_t)(b * 2 + kvh) * TLAT, c0 = CTX2 + (size_t)(b * 2 + kvh) * TCTX;
        attn_unit<64>(tid, lds, Qs + ((size_t)bh * TLAT + q0) * 64, Ks + (r0 + lo) * 64, Vs + (r0 + lo) * 64, (hi_ - lo) >> 6, lo, Ks + c0 * 64, Vs + c0 * 64, 4, q0, true, p.sink[l * 6 + h] * LOG2E, 1.f,
                      mix + (size_t)(b * TLAT + q0) * 1024 + 640 + h * 64);
      }
    } else {
      const int u = it - 3072, ty = u / 48, bh = u % 48, b = bh / 6, h = bh % 6;
      if (ty == 0) {
        const size_t c0 = CTX6 + (size_t)bh * TCTX;
        attn_unit<96>(tid, lds, Qm + c0 * 96, Km + c0 * 96, Vm + c0 * 64, 4, 0, Km, Vm, 0, 0, false, 0.f, 0.f, mix + (size_t)(MLAT + b * TCTX) * 1024 + h * 64);
      } else {
        const int kvh = h / 3; const size_t c0 = CTX2 + (size_t)(b * 2 + kvh) * TCTX;
        attn_unit<64>(tid, lds, Qs + (CTX6 + (size_t)bh * TCTX) * 64, Ks + c0 * 64, Vs + c0 * 64, 4, 0, Ks, Vs, 0, 0, false, p.sink[l * 6 + h] * LOG2E, 1.f, mix + (size_t)(MLAT + b * TCTX) * 1024 + 640 + h * 64);
      }
    }
  }
}

static __device__ __forceinline__ void phase_resid_gemm(const P& p, int l, const u16* A, const u16* W, int ldk, int gate_off, char* lds, bool from_input = false) {
  const int tid = otid(), lane = tid & 63, wid = tid >> 6, r32 = lane & 31, hi = lane >> 5, wm = wid >> 1, wn = wid & 1, lr = tid >> 3;
  const int MT = l == NLAYER - 1 ? 256 : 264;
  const int ns = tile_steps(MT, 8, 4, 8), nk = ldk >> 6;
  u32x4 ra0[4], rb0[2], ra1[4], rb1[2];
  LdRows al, bl; int mt, nt;
  auto mk = [&](int mt_, int nt_, LdRows& a_, LdRows& b_) {
#pragma unroll
    for (int j = 0; j < 4; ++j) a_.p[j] = A + (size_t)(mt_ * 256 + lr + 64 * j) * ldk;
#pragma unroll
    for (int j = 0; j < 2; ++j) b_.p[j] = W + (size_t)(nt_ * 128 + lr + 64 * j) * ldk;
    b_.p[2] = b_.p[3] = b_.p[0];
  };
  int s = tile_next(0, ns, MT, 8, 4, 8, mt, nt);
  if (s >= 0) { mk(mt, nt, al, bl); gemm_issue<4, 2>(tid, al, bl, nk, ra0, rb0, ra1, rb1); }
  while (s >= 0) {
    f32x16 acc[2][2]; zero_acc(acc);
    __syncthreads();
    gemm_run<4, 2, 2, 2, true>(tid, lds + LDS_SCR, al, bl, nk, acc, ra0, rb0, ra1, rb1);
    int mt2 = 0, nt2 = 0; const int s2 = tile_next(s + 1, ns, MT, 8, 4, 8, mt2, nt2);
    if (s2 >= 0) { mk(mt2, nt2, al, bl); gemm_issue<4, 2>(tid, al, bl, nk, ra0, rb0, ra1, rb1); }
    float* xb = xrow(p, mt * 256); const float* gv = modv(p, l, modidx(mt * 256)) + gate_off;
#pragma unroll
    for (int tn = 0; tn < 2; ++tn) {
      const int n = nt * 128 + wn * 64 + 32 * tn + r32; const float g = gv[n];
      float* xp = xb + (size_t)(wm * 64 + 4 * hi) * DM + n;
      const float* xs = (from_input ? xin(p, mt * 256) : (const float*)xb) + (size_t)(wm * 64 + 4 * hi) * DM + n;
      float xv[2][16];
#pragma unroll
      for (int tm = 0; tm < 2; ++tm)
#pragma unroll
        for (int r = 0; r < 16; ++r) xv[tm][r] = xs[(size_t)(32 * tm + (r & 3) + 8 * (r >> 2)) * DM];
#pragma unroll
      for (int tm = 0; tm < 2; ++tm)
#pragma unroll
        for (int r = 0; r < 16; ++r) xp[(size_t)(32 * tm + (r & 3) + 8 * (r >> 2)) * DM] = xv[tm][r] + g * acc[tm][tn][r];
    }
    s = s2; mt = mt2; nt = nt2;
  }
}

static __device__ __forceinline__ void phase_ffn_up(const P& p, int l, char* lds) {
  const int tid = otid(), lane = tid & 63, wid = tid >> 6, r32 = lane & 31, hi = lane >> 5, wm = wid >> 1, wn = wid & 1, lr = tid >> 3;
  const u16* H = (const u16*)(p.ws + OFF_H); const u16* W = wl(p, l) + W_UP; u16* act = (u16*)(p.ws + OFF_ACT);
  const float* cw = p.conv_w + (size_t)l * 3 * 5632; const float* cb = p.conv_b + (size_t)l * 5632;
  char* tile = lds + LDS_SCR;
  const int MEND = l == NLAYER - 1 ? MLAT : MTOT;
  const int RT = (MEND + 253) / 254;
  const int ns = tile_steps(RT, 44, 8, 4);
  u32x4 ra0[4], rb0[2], ra1[4], rb1[2];
  LdRows al, bl; int rt, nt;
  auto mk = [&](int rt_, int nt_, LdRows& a_, LdRows& b_) {
    const int ts_ = 254 * rt_ - 1;
#pragma unroll
    for (int j = 0; j < 4; ++j) { const int tt = ts_ + lr + 64 * j; a_.p[j] = (tt >= 0 && tt < MTOT) ? H + (size_t)tt * 1024 : (const u16*)(p.ws + OFF_ZERO); }
#pragma unroll
    for (int j = 0; j < 2; ++j) b_.p[j] = W + (size_t)(nt_ * 128 + lr + 64 * j) * 1024;
    b_.p[2] = b_.p[3] = b_.p[0];
  };
  int s = tile_next(0, ns, RT, 44, 8, 4, rt, nt);
  if (s >= 0) { mk(rt, nt, al, bl); gemm_issue<4, 2>(tid, al, bl, 16, ra0, rb0, ra1, rb1); }
  while (s >= 0) {
    const int tstart = 254 * rt - 1;
    f32x16 acc[2][2]; zero_acc(acc);
    __syncthreads();
    gemm_run<4, 2, 2, 2>(tid, lds + LDS_SCR, al, bl, 16, acc, ra0, rb0, ra1, rb1);
    int rt2 = 0, nt2 = 0; const int s2 = tile_next(s + 1, ns, RT, 44, 8, 4, rt2, nt2);
    if (s2 >= 0) { mk(rt2, nt2, al, bl); gemm_issue<4, 2>(tid, al, bl, 16, ra0, rb0, ra1, rb1); }
#pragma unroll
    for (int tm = 0; tm < 2; ++tm) {
      char* trow = tile + (wm * 64 + 32 * tm + r32) * 528;
#pragma unroll
      for (int tn = 0; tn < 2; ++tn)
#pragma unroll
        for (int rg = 0; rg < 4; ++rg) { f32x4 v = {acc[tm][tn][4 * rg], acc[tm][tn][4 * rg + 1], acc[tm][tn][4 * rg + 2], acc[tm][tn][4 * rg + 3]}; *(f32x4*)(trow + (wn * 64 + 32 * tn + 8 * rg + 4 * hi) * 4) = v; }
    }
    __syncthreads();
    {
      const int cgp = tid & 7, wn2 = cgp >> 2, j0 = (cgp & 3) * 8;
      const int ca0 = nt * 64 + wn2 * 32 + j0;
      const int lca = (wn2 * 64 + j0) * 4, lcg = lca + 128;
      float wa0[8], wa1[8], wa2[8], ba[8], wg0[8], wg1[8], wg2[8], bg[8];
#pragma unroll
      for (int e = 0; e < 8; ++e) {
        wa0[e] = cw[ca0 + e]; wa1[e] = cw[5632 + ca0 + e]; wa2[e] = cw[2 * 5632 + ca0 + e]; ba[e] = cb[ca0 + e];
        wg0[e] = cw[DFF + ca0 + e]; wg1[e] = cw[5632 + DFF + ca0 + e]; wg2[e] = cw[2 * 5632 + DFF + ca0 + e]; bg[e] = cb[DFF + ca0 + e];
      }
#pragma unroll
      for (int jj = 0; jj < 4; ++jj) {
        const int r = (tid >> 3) + 64 * jj, tt = tstart + r;
        if (r >= 1 && r <= 254 && tt < MEND) {
          const int pos = tt < MLAT ? (tt & (TLAT - 1)) : ((tt - MLAT) & (TCTX - 1)), slen = tt < MLAT ? TLAT : TCTX;
          const float fm = pos == 0 ? 0.f : 1.f, fp = pos == slen - 1 ? 0.f : 1.f;
          const char* rp = tile + r * 528;
          float o[8];
#pragma unroll
          for (int hf = 0; hf < 2; ++hf) {
            const f32x4 am = *(const f32x4*)(rp - 528 + lca + hf * 16), a0 = *(const f32x4*)(rp + lca + hf * 16), ap = *(const f32x4*)(rp + 528 + lca + hf * 16);
            const f32x4 gm = *(const f32x4*)(rp - 528 + lcg + hf * 16), g0 = *(const f32x4*)(rp + lcg + hf * 16), gp = *(const f32x4*)(rp + 528 + lcg + hf * 16);
#pragma unroll
            for (int e = 0; e < 4; ++e) {
              const int q = hf * 4 + e;
              const float ua = wa0[q] * (fm * am[e]) + wa1[q] * a0[e] + wa2[q] * (fp * ap[e]) + ba[q];
              const float ug = wg0[q] * (fm * gm[e]) + wg1[q] * g0[e] + wg2[q] * (fp * gp[e]) + bg[q];
              o[q] = silu_f(ug) * ua;
            }
          }
          u32x4 w = {pk2(o[0], o[1]), pk2(o[2], o[3]), pk2(o[4], o[5]), pk2(o[6], o[7])};
          *(u32x4*)(act + (size_t)tt * DFF + ca0) = w;
        }
      }
    }
    s = s2; rt = rt2; nt = nt2;
  }
}

#define XB_TMO      128
#define XB_XCNT(j)  (256  + 64 * (j))
#define XB_XSUB(j)  (1280 + 64 * (j))
#define XB_XGEN(j)  (2304 + 64 * (j))
#define XB_TOP      3328
#define XB_TOPGEN   3392
#define XCD_BAR_WORDS 3456
#define XB_SPIN_CAP (1u << 24)
DI unsigned xb_ld(unsigned* p) { return __hip_atomic_load(p, __ATOMIC_RELAXED, __HIP_MEMORY_SCOPE_AGENT); }
DI unsigned xb_add(unsigned* p, unsigned v) { return __hip_atomic_fetch_add(p, v, __ATOMIC_RELAXED, __HIP_MEMORY_SCOPE_AGENT); }
DI unsigned xb_xcc_id() { return (unsigned)__builtin_amdgcn_s_getreg((3 << 11) | 20) & 0xFu; }
#define XB_SPIN(cond, bar) do { unsigned _sp = 0; while (cond) { __builtin_amdgcn_s_sleep(1); \
    if ((++_sp & 255u) == 0u) { if (xb_ld(&(bar)[XB_TMO])) break; if (_sp > XB_SPIN_CAP) { atomicAdd(&(bar)[XB_TMO], 1u); break; } } } } while (0)
struct XcdBarrier { unsigned* bar; unsigned x; volatile LAS unsigned* st; };
DI XcdBarrier xcd_barrier_post(unsigned* bar, volatile LAS unsigned* st) {
  XcdBarrier b; b.bar = bar; b.x = xb_xcc_id(); b.st = st;
  if (threadIdx.x == 0) (void)xb_add(&bar[XB_XCNT(b.x)], 1u);
  return b;
}
DI void xcd_barrier_complete(unsigned* bar, unsigned x, unsigned& nloc, unsigned& nx) {
  const unsigned G = gridDim.x * gridDim.y * gridDim.z;
  unsigned sum, cnt, mine, sp = 0u;
  for (;;) {
    sum = 0u; cnt = 0u; mine = 0u;
#pragma unroll
    for (unsigned j = 0; j < 16; ++j) { const unsigned c = xb_ld(&bar[XB_XCNT(j)]); sum += c; cnt += (c > 0u) ? 1u : 0u; mine = (j == x) ? c : mine; }
    if (sum == G) break;
    __builtin_amdgcn_s_sleep(1);
    if ((++sp & 255u) == 0u) { if (xb_ld(&bar[XB_TMO])) break; if (sp > XB_SPIN_CAP) { atomicAdd(&bar[XB_TMO], 1u); break; } }
  }
  nloc = mine > 0u ? mine : 1u; nx = cnt > 0u ? cnt : 1u;
}
DI void xcd_barrier(const XcdBarrier& b) {
  asm volatile("s_waitcnt vmcnt(0)" ::: "memory");
  __syncthreads();
  if (threadIdx.x == 0) {
    unsigned* bar = b.bar;
    __builtin_amdgcn_s_waitcnt(0);
    unsigned nloc = b.st[0], nx = b.st[1];
    if (nloc == 0u) { xcd_barrier_complete(bar, b.x, nloc, nx); b.st[0] = nloc; b.st[1] = nx; }
    const unsigned old = xb_add(&bar[XB_XSUB(b.x)], 1u);
    const unsigned gen = old / nloc;
    if (old + 1u == (gen + 1u) * nloc) {
      __builtin_amdgcn_fence(__ATOMIC_RELEASE, "agent");
      asm volatile("s_waitcnt vmcnt(0)" ::: "memory");
      const unsigned og = xb_add(&bar[XB_TOP], 1u);
      const unsigned tg = og / nx;
      if (og + 1u == (tg + 1u) * nx) xb_add(&bar[XB_TOPGEN], 1u);
      else XB_SPIN(xb_ld(&bar[XB_TOPGEN]) == tg, bar);
      __builtin_amdgcn_fence(__ATOMIC_ACQUIRE, "agent");
      xb_add(&bar[XB_XGEN(b.x)], 1u);
      asm volatile("s_waitcnt vmcnt(0)" ::: "memory");
    } else {
      XB_SPIN(xb_ld(&bar[XB_XGEN(b.x)]) == gen, bar);
      __builtin_amdgcn_fence(__ATOMIC_ACQUIRE, "agent");
      asm volatile("s_waitcnt vmcnt(0)" ::: "memory");
    }
  }
  __syncthreads();
}

__global__ void __launch_bounds__(NTHREADS) fwd_kernel(P p) {
  extern __shared__ __attribute__((aligned(16))) char lds_raw[];
  char* lds = lds_raw + LDS_FRONT;
  cg::grid_group grid = cg::this_grid();
  if (threadIdx.x == 0) *(u32x4*)lds_raw = u32x4{0u, 0u, 0u, 0u};
  __syncthreads();
  const XcdBarrier xb = xcd_barrier_post((unsigned*)(p.ws + OFF_BAR), (volatile LAS unsigned*)lds_raw);
  phase_pre(p);
  grid.sync();
  phase0(p, lds);
  xcd_barrier(xb);
  for (int l = 0; l < NLAYER; ++l) {
    phase_norm(p, l, 0);
    xcd_barrier(xb);
    phase_inproj(p, l, lds);
    xcd_barrier(xb);
    phase_mla_prep(p, l, lds);
    phase_s5_states(p, l, lds);
    xcd_barrier(xb);
    phase_attn(p, l, lds);
    xcd_barrier(xb);
    phase_s5_out(p, l, lds);
    xcd_barrier(xb);
    phase_glu(p, l, lds);
    xcd_barrier(xb);
    phase_resid_gemm(p, l, (const u16*)(p.ws + OFF_MIX), wl(p, l) + W_OUT, 1024, 2048, lds, l == 0);
    xcd_barrier(xb);
    phase_norm(p, l, 1);
    xcd_barrier(xb);
    phase_ffn_up(p, l, lds);
    xcd_barrier(xb);
    phase_resid_gemm(p, l, (const u16*)(p.ws + OFF_ACT), wl(p, l) + W_DN, DFF, 5120, lds);
    xcd_barrier(xb);
  }
}

extern "C" void kernel_launch(void* const* d_in, const int* in_sizes, int n_in, void* d_out, int out_size, void* d_ws, size_t ws_size, hipStream_t stream) {
  static int grid_blocks = 0;
  if (!grid_blocks) {
    if (ws_size < WS_NEED) { fprintf(stderr, "kernel_launch: workspace too small: %zu < %zu\n", ws_size, (size_t)WS_NEED); return; }
    if (hipFuncSetAttribute((const void*)fwd_kernel, hipFuncAttributeMaxDynamicSharedMemorySize, LDS_TOTAL) != hipSuccess) { fprintf(stderr, "kernel_launch: LDS attribute failed\n"); return; }
    int dev = 0, cus = 0, per_cu = 0;
    hipGetDevice(&dev);
    hipDeviceGetAttribute(&cus, hipDeviceAttributeMultiprocessorCount, dev);
    hipOccupancyMaxActiveBlocksPerMultiprocessor(&per_cu, fwd_kernel, NTHREADS, LDS_TOTAL);
    if (per_cu < 1) { fprintf(stderr, "kernel_launch: occupancy 0\n"); return; }
    grid_blocks = cus;
  }
  P p{};
  const float** fp = (const float**)&p;
  for (int i = 0; i < 33; ++i) fp[i] = (const float*)d_in[i];
  p.out = (float*)d_out; p.ws = (char*)d_ws;
  (void)hipMemsetAsync((char*)d_ws + OFF_BAR, 0, XCD_BAR_WORDS * 4, stream);
  void* args[] = {&p};
  hipError_t e = hipLaunchCooperativeKernel((void*)fwd_kernel, dim3(grid_blocks), dim3(NTHREADS), args, LDS_TOTAL, stream);
  if (e != hipSuccess) fprintf(stderr, "cooperative launch failed: %s (grid %d)\n", hipGetErrorString(e), grid_blocks);
}
```

```cpp
#include <hip/hip_runtime.h>
#include <hip/hip_cooperative_groups.h>
#include <cstdio>
#include <cstdint>
namespace cg = cooperative_groups;

typedef unsigned short u16;
typedef short bf16x8 __attribute__((ext_vector_type(8)));
typedef short s16x4 __attribute__((ext_vector_type(4)));
typedef float f32x16 __attribute__((ext_vector_type(16)));
typedef float f32x4 __attribute__((ext_vector_type(4)));
typedef float f32x2 __attribute__((ext_vector_type(2)));
typedef unsigned u32x4 __attribute__((ext_vector_type(4)));
typedef unsigned u32x2 __attribute__((ext_vector_type(2)));
typedef __bf16 bf16x2_t __attribute__((ext_vector_type(2)));
#define DI __device__ __forceinline__
#define LAS __attribute__((address_space(3)))

constexpr int DM = 1024, NBATCH = 8, TLAT = 8192, NLAYER = 4, TCTX = 256;
constexpr int MLAT = NBATCH * TLAT, MCTX = NBATCH * TCTX, MTOT = MLAT + MCTX;
constexpr int PROJ_LD = 928, DFF = 2816;
constexpr float EPS = 1e-6f, LOG2E = 1.4426950408889634f;
constexpr int NTHREADS = 512;
constexpr int PITCH = 144;
constexpr int LDS_SCR = 2048;
constexpr int LDS_FRONT = 256;
constexpr int LDS_TOTAL = LDS_FRONT + LDS_SCR + 256 * 528;

constexpr size_t al256(size_t x) { return (x + 255) / 256 * 256; }
constexpr size_t OFF_CTXX = 0;
constexpr size_t OFF_MOD = OFF_CTXX + (size_t)MCTX * DM * 4;
constexpr size_t OFF_ROPE = OFF_MOD + al256((size_t)NLAYER * 9 * 6144 * 4);
constexpr size_t ROPE_COSA = 0, ROPE_SINA = (size_t)TLAT * 16 * 4, ROPE_COSS = 2 * ROPE_SINA, ROPE_SINS = ROPE_COSS + (size_t)TLAT * 32 * 4;
constexpr size_t OFF_S5PW = OFF_ROPE + 2 * (size_t)TLAT * 16 * 4 + 2 * (size_t)TLAT * 32 * 4;
constexpr size_t OFF_S5Q = OFF_S5PW + (size_t)NLAYER * 2 * 16 * 64 * 65 * 16;
constexpr size_t OFF_W = OFF_S5Q + (size_t)NLAYER * 2 * 16 * 64 * 16;
constexpr size_t W_IN = 0, W_OUT = W_IN + (size_t)1664 * 1024, W_UP = W_OUT + (size_t)1024 * 1024, W_DN = W_UP + (size_t)5632 * 1024,
                 W_UQ = W_DN + (size_t)1024 * 2816, W_UKV = W_UQ + (size_t)576 * 384, W_GLU = W_UKV + (size_t)768 * 256, W_LAYER = W_GLU + (size_t)256 * 256;
constexpr size_t OFF_S5T = OFF_W + (size_t)NLAYER * W_LAYER * 2;
constexpr size_t S5_KC = 0, S5_BST = S5_KC + (size_t)16 * 127 * 256, S5_MRD = S5_BST + (size_t)16 * 256 * 1024, S5_LAYER = S5_MRD + (size_t)16 * 1024 * 256;
constexpr size_t OFF_H = OFF_S5T + (size_t)NLAYER * S5_LAYER * 2;
constexpr size_t OFF_MIX = OFF_H + (size_t)MTOT * 1024 * 2;
constexpr size_t OFF_SST = OFF_MIX + (size_t)MTOT * 1024 * 2;
constexpr size_t OFF_HIN = OFF_SST + (size_t)1056 * 16 * 256 * 4;
constexpr size_t OFF_ZB = OFF_HIN + (size_t)1056 * 16 * 256 * 2;
constexpr size_t OFF_BIG = OFF_ZB + (size_t)MTOT * 256 * 2;
constexpr size_t OFF_PROJ = OFF_BIG;
constexpr size_t OFF_QM = OFF_PROJ + (size_t)MTOT * PROJ_LD * 2;
constexpr size_t OFF_KM = OFF_QM + (size_t)MTOT * 576 * 2;
constexpr size_t OFF_VM = OFF_KM + (size_t)MTOT * 576 * 2;
constexpr size_t OFF_QS = OFF_VM + (size_t)MTOT * 384 * 2;
constexpr size_t OFF_KS = OFF_QS + (size_t)MTOT * 384 * 2;
constexpr size_t OFF_VS = OFF_KS + (size_t)MTOT * 128 * 2;
constexpr size_t OFF_END1 = OFF_VS + (size_t)MTOT * 128 * 2;
constexpr size_t OFF_ACT = OFF_BIG;
constexpr size_t OFF_END2 = OFF_ACT + (size_t)MTOT * DFF * 2;
constexpr size_t OFF_ZERO = OFF_END1 > OFF_END2 ? OFF_END1 : OFF_END2;
constexpr size_t OFF_BAR = OFF_ZERO + 8192;
constexpr size_t WS_NEED = OFF_BAR + 16384;

struct P {
  const float *x, *c, *ctx, *c_ctx, *w_mod, *b_mod, *norm1, *w_in, *q_lora_g, *w_uq, *kv_lora_g, *w_ukv, *q_norm, *k_norm, *a_re, *a_im, *log_dt, *b_re, *b_im, *c_re,
      *c_im, *s5_d, *w_glu, *b_glu, *sq_norm, *sk_norm, *sink, *w_out, *norm2, *w_up, *conv_w, *conv_b, *w_down;
  float* out;
  char* ws;
};

DI unsigned pk2(float a, float b) { f32x2 v = {a, b}; bf16x2_t r = __builtin_convertvector(v, bf16x2_t); return __builtin_bit_cast(unsigned, r); }
DI float bflo(unsigned w) { return __uint_as_float(w << 16); }
DI float bfhi(unsigned w) { return __uint_as_float(w & 0xffff0000u); }
DI int otid() { int t = threadIdx.x; asm volatile("" : "+v"(t)); return t; }
DI int crow(int r, int hi) { return (r & 3) + 8 * (r >> 2) + 4 * hi; }
DI f32x16 mfma(bf16x8 a, bf16x8 b, f32x16 c) { return __builtin_amdgcn_mfma_f32_32x32x16_bf16(a, b, c, 0, 0, 0); }
DI float ex2(float x) { return __builtin_amdgcn_exp2f(x); }
DI float rcpf_(float x) { return __builtin_amdgcn_rcpf(x); }
DI float xsum32(float v) { auto rr = __builtin_amdgcn_permlane32_swap(__float_as_uint(v), __float_as_uint(v), false, false); return __uint_as_float(rr[0]) + __uint_as_float(rr[1]); }
DI float xmax32(float v) { auto rr = __builtin_amdgcn_permlane32_swap(__float_as_uint(v), __float_as_uint(v), false, false); return fmaxf(__uint_as_float(rr[0]), __uint_as_float(rr[1])); }
DI void st4(u16* p, float a, float b, float c, float d) { u32x2 w = {pk2(a, b), pk2(c, d)}; *(u32x2*)p = w; }
DI float silu_f(float g) { return g * rcpf_(1.f + ex2(-g * LOG2E)); }
DI float sigmoid_f(float g) { return rcpf_(1.f + ex2(-g * LOG2E)); }
DI float gelu_tanh(float x) { const float u = 0.7978845608028654f * (x + 0.044715f * x * x * x); const float th = 1.f - 2.f * rcpf_(1.f + ex2(2.f * LOG2E * u)); return 0.5f * x * (1.f + th); }
DI const float* xin(const P& p, int m) { return m < MLAT ? p.x + (size_t)m * DM : p.ctx + (size_t)(m - MLAT) * DM; }
DI float* xrow(const P& p, int m) { return m < MLAT ? p.out + (size_t)m * DM : (float*)(p.ws + OFF_CTXX) + (size_t)(m - MLAT) * DM; }
DI int modidx(int m) { return m < MLAT ? (m >> 13) : 8; }
DI const float* modv(const P& p, int l, int mi) { return (const float*)(p.ws + OFF_MOD) + ((size_t)l * 9 + mi) * 6144; }
DI size_t head_row(int m, int h, int H) {
  if (m < MLAT) return ((size_t)((m >> 13) * H + h) << 13) + (m & 8191);
  const int r = m - MLAT; return (size_t)NBATCH * H * TLAT + (size_t)((r >> 8) * H + h) * TCTX + (r & 255);
}
DI u16* wl(const P& p, int l) { return (u16*)(p.ws + OFF_W) + (size_t)l * W_LAYER; }
DI u16* s5t(const P& p, int l) { return (u16*)(p.ws + OFF_S5T) + (size_t)l * S5_LAYER; }
DI int s5_tokbase(int row) { return row < 1024 ? (row >> 7) * TLAT + (row & 127) * 64 : MLAT + ((row - 1024) >> 2) * TCTX + ((row - 1024) & 3) * 64; }

DI int tile_steps(int MT, int NT, int RM, int RN) {
  if (gridDim.x == 256) { const int SM = (MT + RM - 1) / RM, SN = (NT + RN - 1) / RN; return (SM * SN + 7) >> 3; }
  return (MT * NT + gridDim.x - 1) / gridDim.x;
}
DI bool tile_get(int s, int MT, int NT, int RM, int RN, int& mt, int& nt) {
  if (gridDim.x == 256) {
    const int xcd = blockIdx.x & 7, slot = blockIdx.x >> 3; const int SM = (MT + RM - 1) / RM, SN = (NT + RN - 1) / RN;
    const int st = s * 8 + xcd; if (st >= SM * SN) return false;
    mt = (st / SN) * RM + slot % RM; nt = (st % SN) * RN + slot / RM;
    return mt < MT && nt < NT;
  }
  const int it = s * gridDim.x + blockIdx.x; if (it >= MT * NT) return false;
  mt = it / NT; nt = it % NT; return true;
}

struct LdRows {
  const u16* p[4];
  DI u32x4 load(int j, int kc) const { return *(const u32x4*)(p[j] + (size_t)kc * 8); }
};
struct LdS5A {
  const u16* pu[4]; const u16* ph[4];
  DI u32x4 load(int j, int kc) const {
    const u16* q = kc < 128 ? pu[j] + (size_t)(kc >> 1) * PROJ_LD + (kc & 1) * 8 : ph[j] + (kc - 128) * 8;
    return *(const u32x4*)q;
  }
};
struct LdS5B {
  const u16* pk[2]; const u16* pm[2];
  DI u32x4 load(int j, int kc) const {
    const u16* q = kc < 128 ? pk[j] - (kc >> 1) * 256 + (kc & 1) * 8 : pm[j] + (kc - 128) * 8;
    return *(const u32x4*)q;
  }
};

template <int NA, int NB, class AL, class BL>
DI void gemm_issue(int tid, const AL& al, const BL& bl, int nk, u32x4 (&ra0)[NA], u32x4 (&rb0)[NB], u32x4 (&ra1)[NA], u32x4 (&rb1)[NB]) {
  const int lc = tid & 7, k1 = nk > 1 ? 1 : 0;
#pragma unroll
  for (int j = 0; j < NA; ++j) ra0[j] = al.load(j, lc);
#pragma unroll
  for (int j = 0; j < NB; ++j) rb0[j] = bl.load(j, lc);
#pragma unroll
  for (int j = 0; j < NA; ++j) ra1[j] = al.load(j, k1 * 8 + lc);
#pragma unroll
  for (int j = 0; j < NB; ++j) rb1[j] = bl.load(j, k1 * 8 + lc);
}
template <int WM, int WN, int TM, int TN, bool SW = false, class AL, class BL>
DI void gemm_run(int tid, char* lds, const AL& al, const BL& bl, int nk, f32x16 (&acc)[TM][TN], u32x4 (&ra0)[WM * TM / 2], u32x4 (&rb0)[WN * TN / 2], u32x4 (&ra1)[WM * TM / 2], u32x4 (&rb1)[WN * TN / 2]) {
  constexpr int BM = WM * TM * 32, BN = WN * TN * 32, NA = BM / 64, NB = BN / 64;
  constexpr int AB = BM * PITCH, STAGE = (BM + BN) * PITCH;
  const int lane = tid & 63, wid = tid >> 6, r32 = lane & 31, hi = lane >> 5;
  const int wm = wid / WN, wn = wid % WN, lr = tid >> 3, lc = tid & 7;
  char* const wa = lds + lr * PITCH + lc * 16;
  const int aoff = (wm * TM * 32 + r32) * PITCH + hi * 16;
  const int boff = AB + (wn * TN * 32 + r32) * PITCH + hi * 16;
#define GLOAD(RA, RB, KT) do { const int kc_ = (KT) * 8 + lc; _Pragma("unroll") for (int j = 0; j < NA; ++j) RA[j] = al.load(j, kc_); _Pragma("unroll") for (int j = 0; j < NB; ++j) RB[j] = bl.load(j, kc_); } while (0)
#define LWRITE(RA, RB, BUF) do { char* w_ = wa + (BUF) * STAGE; _Pragma("unroll") for (int j = 0; j < NA; ++j) *(u32x4*)(w_ + j * 64 * PITCH) = RA[j]; _Pragma("unroll") for (int j = 0; j < NB; ++j) *(u32x4*)(w_ + AB + j * 64 * PITCH) = RB[j]; } while (0)
#define COMPUTE(BUF, RA, RB, WBUF) do { const char* sb = lds + (BUF) * STAGE; char* w_ = wa + (WBUF) * STAGE; _Pragma("unroll") for (int ks = 0; ks < 4; ++ks) { bf16x8 wf[TN], xf[TM]; \
    _Pragma("unroll") for (int tn = 0; tn < TN; ++tn) wf[tn] = *(const bf16x8*)(sb + boff + tn * 32 * PITCH + ks * 32); \
    _Pragma("unroll") for (int tm = 0; tm < TM; ++tm) xf[tm] = *(const bf16x8*)(sb + aoff + tm * 32 * PITCH + ks * 32); \
    _Pragma("unroll") for (int tm = 0; tm < TM; ++tm) _Pragma("unroll") for (int tn = 0; tn < TN; ++tn) acc[tm][tn] = SW ? mfma(xf[tm], wf[tn], acc[tm][tn]) : mfma(wf[tn], xf[tm], acc[tm][tn]); \
    _Pragma("unroll") for (int j = 0; j < NA; ++j) if (1 + j % 3 == ks) *(u32x4*)(w_ + j * 64 * PITCH) = RA[j]; \
    _Pragma("unroll") for (int j = 0; j < NB; ++j) if (1 + (NA + j) % 3 == ks) *(u32x4*)(w_ + AB + j * 64 * PITCH) = RB[j]; } } while (0)
  const int kl = nk - 1;
  LWRITE(ra0, rb0, 0);
  __syncthreads();
#pragma unroll 1
  for (int kt = 0; kt < nk; kt += 2) {
    GLOAD(ra0, rb0, (kt + 2 < kl ? kt + 2 : kl));
    COMPUTE(0, ra1, rb1, 1);
    __syncthreads();
    if (kt + 1 >= nk) break;
    GLOAD(ra1, rb1, (kt + 3 < kl ? kt + 3 : kl));
    COMPUTE(1, ra0, rb0, 0);
    __syncthreads();
  }
#undef GLOAD
#undef LWRITE
#undef COMPUTE
}
template <int WM, int WN, int TM, int TN, bool SW = false, class AL, class BL>
DI void gemm_main(int tid, char* lds, const AL& al, const BL& bl, int nk, f32x16 (&acc)[TM][TN]) {
  constexpr int NA = WM * TM / 2, NB = WN * TN / 2;
  u32x4 ra0[NA], rb0[NB], ra1[NA], rb1[NB];
  gemm_issue<NA, NB>(tid, al, bl, nk, ra0, rb0, ra1, rb1);
  gemm_run<WM, WN, TM, TN, SW>(tid, lds, al, bl, nk, acc, ra0, rb0, ra1, rb1);
}
template <bool SW, class AL, class BL>
DI void gemm_run16(int tid, char* lds, const AL& al, const BL& bl, int nk, f32x4 (&acc)[4][4], u32x4 (&ra0)[4], u32x4 (&rb0)[2], u32x4 (&ra1)[4], u32x4 (&rb1)[2]) {
  constexpr int NA = 4, NB = 2, RB_ = 128, AB = 256 * RB_, STAGE = 384 * RB_;
  const int lane = tid & 63, wid = tid >> 6, l15 = lane & 15, g = lane >> 4;
  const int wm = wid >> 1, wn = wid & 1, lr = tid >> 3, lc = tid & 7;
  char* const wa = lds + lr * RB_ + ((lc ^ ((lr >> 1) & 7)) << 4);
  const int o0 = (g ^ ((lane >> 1) & 7)) << 4, o1 = o0 ^ 64;
  const int aoff = (wm * 64 + l15) * RB_, boff = AB + (wn * 64 + l15) * RB_;
#define GLOAD(RA, RB, KT) do { const int kc_ = (KT) * 8 + lc; _Pragma("unroll") for (int j = 0; j < NA; ++j) RA[j] = al.load(j, kc_); _Pragma("unroll") for (int j = 0; j < NB; ++j) RB[j] = bl.load(j, kc_); } while (0)
#define LWRITE(RA, RB, BUF) do { char* w_ = wa + (BUF) * STAGE; _Pragma("unroll") for (int j = 0; j < NA; ++j) *(u32x4*)(w_ + j * 64 * RB_) = RA[j]; _Pragma("unroll") for (int j = 0; j < NB; ++j) *(u32x4*)(w_ + AB + j * 64 * RB_) = RB[j]; } while (0)
#define KSTEP(OFF) do { bf16x8 wf[4], xf[4]; \
    _Pragma("unroll") for (int t = 0; t < 4; ++t) { wf[t] = *(const bf16x8*)(sb + boff + t * 16 * RB_ + (OFF)); xf[t] = *(const bf16x8*)(sb + aoff + t * 16 * RB_ + (OFF)); } \
    _Pragma("unroll") for (int tm = 0; tm < 4; ++tm) _Pragma("unroll") for (int tn = 0; tn < 4; ++tn) \
      acc[tm][tn] = SW ? __builtin_amdgcn_mfma_f32_16x16x32_bf16(xf[tm], wf[tn], acc[tm][tn], 0, 0, 0) : __builtin_amdgcn_mfma_f32_16x16x32_bf16(wf[tn], xf[tm], acc[tm][tn], 0, 0, 0); } while (0)
#define COMPUTE(BUF, RA, RB, WBUF) do { const char* sb = lds + (BUF) * STAGE; char* w_ = wa + (WBUF) * STAGE; \
    KSTEP(o0); *(u32x4*)(w_) = RA[0]; *(u32x4*)(w_ + 64 * RB_) = RA[1]; *(u32x4*)(w_ + 128 * RB_) = RA[2]; \
    KSTEP(o1); *(u32x4*)(w_ + 192 * RB_) = RA[3]; *(u32x4*)(w_ + AB) = RB[0]; *(u32x4*)(w_ + AB + 64 * RB_) = RB[1]; } while (0)
  const int kl = nk - 1;
  LWRITE(ra0, rb0, 0);
  __syncthreads();
#pragma unroll 1
  for (int kt = 0; kt < nk; kt += 2) {
    GLOAD(ra0, rb0, (kt + 2 < kl ? kt + 2 : kl));
    COMPUTE(0, ra1, rb1, 1);
    __syncthreads();
    if (kt + 1 >= nk) break;
    GLOAD(ra1, rb1, (kt + 3 < kl ? kt + 3 : kl));
    COMPUTE(1, ra0, rb0, 0);
    __syncthreads();
  }
#undef GLOAD
#undef LWRITE
#undef KSTEP
#undef COMPUTE
}
DI int tile_next(int s, int ns, int MT, int NT, int RM, int RN, int& mt, int& nt) {
  for (; s < ns; ++s) if (tile_get(s, MT, NT, RM, RN, mt, nt)) return s;
  return -1;
}
template <int TM, int TN> DI void zero_acc(f32x16 (&acc)[TM][TN]) {
#pragma unroll
  for (int a = 0; a < TM; ++a)
#pragma unroll
    for (int b = 0; b < TN; ++b)
#pragma unroll
      for (int r = 0; r < 16; ++r) acc[a][b][r] = 0.f;
}

struct dc { double re, im; };
DI dc cmul(dc a, dc b) { return {a.re * b.re - a.im * b.im, a.re * b.im + a.im * b.re}; }

static __device__ __forceinline__ void phase_pre(const P& p) {
  const int gt = blockIdx.x * NTHREADS + threadIdx.x;
  if (gt < 512) ((u32x4*)(p.ws + OFF_ZERO))[gt] = u32x4{0, 0, 0, 0};
  if (gt < NLAYER * 2 * 16 * 64) {
    const int ldg = gt >> 6;
    const double lre = p.a_re[gt], lim = p.a_im[gt];
    const double dt = exp((double)p.log_dt[ldg]);
    double s, c; sincos(lim * dt, &s, &c);
    const double e = exp(lre * dt);
    const dc a = {e * c, e * s};
    const double den = lre * lre + lim * lim;
    const dc am1 = {a.re - 1.0, a.im};
    const dc q = {(am1.re * lre + am1.im * lim) / den, (am1.im * lre - am1.re * lim) / den};
    dc* pw = (dc*)(p.ws + OFF_S5PW) + (size_t)gt * 65;
    dc r = {1.0, 0.0};
    for (int k = 0; k <= 64; ++k) { pw[k] = r; r = cmul(r, a); }
    ((dc*)(p.ws + OFF_S5Q))[gt] = q;
  }
}

DI int nmap_in(int n) { return n < 640 ? n : (n < 1536 ? n + 32 : n - 896); }
DI int nmap_up(int n) { const int q = n >> 6, r = n & 63; return r < 32 ? 32 * q + r : DFF + 32 * q + (r - 32); }

static __device__ __forceinline__ void transpose_tile(const float* src, int ldsrc, int K, int Nd, int nmap, const float* kscale, u16* dst, int kt, int ntile, char* lds) {
  float* tile = (float*)lds;
  const int tid = threadIdx.x;
  __syncthreads();
  {
    const int n = tid & 63, kk = tid >> 6;
    const int nd = ntile * 64 + n;
    const int ns = nmap == 1 ? nmap_in(nd) : (nmap == 2 ? nmap_up(nd) : nd);
#pragma unroll
    for (int j = 0; j < 8; ++j) {
      const int k = kk + 8 * j, kg = kt * 64 + k;
      float v = 0.f;
      if (nd < Nd) { v = src[(size_t)kg * ldsrc + ns]; if (kscale) v *= kscale[kg]; }
      tile[k * 65 + n] = v;
    }
  }
  __syncthreads();
  {
    const int n = tid >> 3, kc = tid & 7, nd = ntile * 64 + n;
    if (nd < Nd) {
      const float* t = tile + (kc * 8) * 65 + n;
      u32x4 w = {pk2(t[0], t[65]), pk2(t[130], t[195]), pk2(t[260], t[325]), pk2(t[390], t[455])};
      *(u32x4*)(dst + (size_t)nd * K + kt * 64 + kc * 8) = w;
    }
  }
}

static __device__ __forceinline__ void mod_item(const P& p, int it, char* lds) {
  const int l = it / 96, n0 = (it % 96) * 64, tid = threadIdx.x;
  float* sv = (float*)lds;
  float* red = sv + 9 * 1024;
  __syncthreads();
  for (int i = tid; i < 9 * 1024; i += NTHREADS) { const int j = i >> 10, k = i & 1023; const float v = j < 8 ? p.c[j * 1024 + k] : p.c_ctx[k]; sv[i] = v / (1.f + expf(-v)); }
  __syncthreads();
  const int c = tid & 63, kg = tid >> 6;
  float acc[9];
#pragma unroll
  for (int j = 0; j < 9; ++j) acc[j] = 0.f;
  const float* w = p.w_mod + ((size_t)l * 1024 + kg * 128) * 6144 + n0 + c;
  for (int kk = 0; kk < 128; ++kk) {
    const float wv = w[(size_t)kk * 6144];
#pragma unroll
    for (int j = 0; j < 9; ++j) acc[j] += sv[j * 1024 + kg * 128 + kk] * wv;
  }
#pragma unroll
  for (int j = 0; j < 9; ++j) red[(kg * 9 + j) * 64 + c] = acc[j];
  __syncthreads();
  for (int q = tid; q < 576; q += NTHREADS) {
    const int j = q >> 6, cc = q & 63; float s = 0.f;
#pragma unroll
    for (int g = 0; g < 8; ++g) s += red[(g * 9 + j) * 64 + cc];
    ((float*)(p.ws + OFF_MOD))[((size_t)l * 9 + j) * 6144 + n0 + cc] = s + p.b_mod[l * 6144 + n0 + cc];
  }
}

static __device__ __forceinline__ void phase0(const P& p, char* lds) {
  constexpr int NMOD = 384, TPL = 2886;
  for (int it = blockIdx.x; it < NMOD + NLAYER * TPL; it += gridDim.x) {
    if (it < NMOD) { mod_item(p, it, lds); continue; }
    const int u = it - NMOD, l = u / TPL, r = u % TPL;
    u16* W = wl(p, l);
    if (r < 400) transpose_tile(p.w_in + (size_t)l * 1024 * 1568, 1568, 1024, 1568, 1, nullptr, W + W_IN, r / 25, r % 25, lds);
    else if (r < 656) { const int q = r - 400; transpose_tile(p.w_out + (size_t)l * 1024 * 1024, 1024, 1024, 1024, 0, nullptr, W + W_OUT, q / 16, q % 16, lds); }
    else if (r < 2064) { const int q = r - 656; transpose_tile(p.w_up + (size_t)l * 1024 * 5632, 5632, 1024, 5632, 2, nullptr, W + W_UP, q / 88, q % 88, lds); }
    else if (r < 2768) { const int q = r - 2064; transpose_tile(p.w_down + (size_t)l * 2816 * 1024, 1024, 2816, 1024, 0, nullptr, W + W_DN, q / 16, q % 16, lds); }
    else if (r < 2822) { const int q = r - 2768; transpose_tile(p.w_uq + (size_t)l * 384 * 576, 576, 384, 576, 0, p.q_lora_g + l * 384, W + W_UQ, q / 9, q % 9, lds); }
    else if (r < 2870) { const int q = r - 2822; transpose_tile(p.w_ukv + (size_t)l * 256 * 768, 768, 256, 768, 0, p.kv_lora_g + l * 256, W + W_UKV, q / 12, q % 12, lds); }
    else { const int q = r - 2870; transpose_tile(p.w_glu + (size_t)l * 256 * 256, 256, 256, 256, 0, nullptr, W + W_GLU, q / 4, q % 4, lds); }
  }
  const size_t gt = (size_t)blockIdx.x * NTHREADS + threadIdx.x, gn = (size_t)gridDim.x * NTHREADS;
  for (size_t i = gt; i < (size_t)TLAT * 48; i += gn) {
    const int t = (int)(i / 48), j = (int)(i % 48);
    const int row = t >> 6, col = t & 63;
    int pos; double ex; float* cd; float* sd;
    if (j < 16) { const int f = j & 7; pos = j < 8 ? row : col; ex = -(double)f / 8.0; cd = (float*)(p.ws + OFF_ROPE + ROPE_COSA) + t * 16 + j; sd = (float*)(p.ws + OFF_ROPE + ROPE_SINA) + t * 16 + j; }
    else { const int jj = j - 16, f = jj & 15; pos = jj < 16 ? row : col; ex = -(double)f / 16.0; cd = (float*)(p.ws + OFF_ROPE + ROPE_COSS) + t * 32 + jj; sd = (float*)(p.ws + OFF_ROPE + ROPE_SINS) + t * 32 + jj; }
    const float inv = (float)exp(ex * 9.210340371976184);
    const float ang = (float)pos * inv;
    double s, c; sincos((double)ang, &s, &c);
    *cd = (float)c; *sd = (float)s;
  }
  const dc* PW = (const dc*)(p.ws + OFF_S5PW); const dc* QQ = (const dc*)(p.ws + OFF_S5Q);
  for (size_t i = gt; i < (size_t)NLAYER * 16 * 127 * 16; i += gn) {
    const int ii = (int)(i & 15); const int rest = (int)(i >> 4); const int dd = rest % 127, lg = rest / 127, g = lg & 15, l = lg >> 4;
    const int d = dd - 63;
    double acc[16];
#pragma unroll
    for (int o = 0; o < 16; ++o) acc[o] = 0.0;
    for (int dir = 0; dir < 2; ++dir) {
      if ((dir == 0 && d < 0) || (dir == 1 && d > 0)) continue;
      const int base = ((l * 2 + dir) * 16 + g) * 64; const int ad = d < 0 ? -d : d;
      const float* cr = p.c_re + (size_t)((l * 2 + dir) * 16 + g) * 16 * 64; const float* ci_ = p.c_im + (size_t)((l * 2 + dir) * 16 + g) * 16 * 64;
      for (int pp = 0; pp < 64; ++pp) {
        const dc a = PW[(size_t)(base + pp) * 65 + ad], q = QQ[base + pp];
        const size_t bi = (size_t)(base + pp) * 16 + ii; const dc B = {(double)p.b_re[bi], (double)p.b_im[bi]};
        const dc t1 = cmul(cmul(a, q), B);
#pragma unroll
        for (int o = 0; o < 16; ++o) acc[o] += (double)cr[o * 64 + pp] * t1.re - (double)ci_[o * 64 + pp] * t1.im;
      }
    }
    if (d == 0) acc[ii] += (double)p.s5_d[l * 256 + g * 16 + ii];
    u16* dst = s5t(p, l) + S5_KC + (size_t)(g * 127 + dd) * 256 + ii;
#pragma unroll
    for (int o = 0; o < 16; ++o) dst[o * 16] = (u16)(pk2((float)acc[o], 0.f) & 0xffff);
  }
  for (size_t i = gt; i < (size_t)NLAYER * 16 * 256 * 1024; i += gn) {
    const int k = (int)(i & 1023), n = (int)((i >> 10) & 255), g = (int)((i >> 18) & 15), l = (int)(i >> 22);
    const int dir = n >> 7, pp = (n >> 1) & 63, reim = n & 1, s = k >> 4, ii = k & 15;
    const int base = ((l * 2 + dir) * 16 + g) * 64 + pp; const int e = dir == 0 ? 63 - s : s;
    const size_t bi = (size_t)base * 16 + ii; const dc B = {(double)p.b_re[bi], (double)p.b_im[bi]};
    const dc v = cmul(cmul(PW[(size_t)base * 65 + e], QQ[base]), B);
    (s5t(p, l) + S5_BST)[((size_t)g * 256 + n) * 1024 + k] = (u16)(pk2((float)(reim ? v.im : v.re), 0.f) & 0xffff);
  }
  for (size_t i = gt; i < (size_t)NLAYER * 16 * 1024 * 256; i += gn) {
    const int k = (int)(i & 255), n = (int)((i >> 8) & 1023), g = (int)((i >> 18) & 15), l = (int)(i >> 22);
    const int dir = k >> 7, pp = (k >> 1) & 63, reim = k & 1, t = n >> 4, o = n & 15;
    const int base = ((l * 2 + dir) * 16 + g) * 64 + pp; const int e = dir == 0 ? t + 1 : 64 - t;
    const size_t ci = ((size_t)(((l * 2 + dir) * 16 + g) * 16 + o)) * 64 + pp; const dc C = {(double)p.c_re[ci], (double)p.c_im[ci]};
    const dc v = cmul(C, PW[(size_t)base * 65 + e]);
    (s5t(p, l) + S5_MRD)[((size_t)g * 1024 + n) * 256 + k] = (u16)(pk2((float)(reim ? -v.im : v.re), 0.f) & 0xffff);
  }
}

static __device__ __forceinline__ void phase_norm(const P& p, int l, int which) {
  const int tid = otid(), lane = tid & 63, wid = tid >> 6;
  const float* gw = (which ? p.norm2 : p.norm1) + l * 1024;
  u16* H = (u16*)(p.ws + OFF_H);
  const int mend = (which == 1 && l == NLAYER - 1) ? MLAT : MTOT;
  const bool first = l == 0 && which == 0;
  f32x4 gq[4];
#pragma unroll
  for (int j = 0; j < 4; ++j) gq[j] = *(const f32x4*)(gw + j * 256 + lane * 4);
  for (int m0 = blockIdx.x * 8 + wid; m0 < mend; m0 += gridDim.x * 16) {
    const int m1 = m0 + gridDim.x * 8; const bool has1 = m1 < mend; const int m1c = has1 ? m1 : m0;
    const float* xr0 = first ? xin(p, m0) : xrow(p, m0); const float* xr1 = first ? xin(p, m1c) : xrow(p, m1c);
    const float* mv0 = modv(p, l, modidx(m0)) + which * 3072; const float* mv1 = modv(p, l, modidx(m1c)) + which * 3072;
    f32x4 v0[4], v1[4], sh0[4], sc0[4], sh1[4], sc1[4];
#pragma unroll
    for (int j = 0; j < 4; ++j) { v0[j] = *(const f32x4*)(xr0 + j * 256 + lane * 4); v1[j] = *(const f32x4*)(xr1 + j * 256 + lane * 4); }
#pragma unroll
    for (int j = 0; j < 4; ++j) { const int c = j * 256 + lane * 4; sh0[j] = *(const f32x4*)(mv0 + c); sc0[j] = *(const f32x4*)(mv0 + 1024 + c); sh1[j] = *(const f32x4*)(mv1 + c); sc1[j] = *(const f32x4*)(mv1 + 1024 + c); }
    float s0 = 0.f, s1 = 0.f;
#pragma unroll
    for (int j = 0; j < 4; ++j)
#pragma unroll
      for (int e = 0; e < 4; ++e) { s0 += v0[j][e] * v0[j][e]; s1 += v1[j][e] * v1[j][e]; }
#pragma unroll
    for (int o = 32; o > 0; o >>= 1) { s0 += __shfl_xor(s0, o); s1 += __shfl_xor(s1, o); }
    const float r0 = rsqrtf(s0 * (1.f / 1024.f) + EPS), r1 = rsqrtf(s1 * (1.f / 1024.f) + EPS);
#pragma unroll
    for (int j = 0; j < 4; ++j) {
      const int c = j * 256 + lane * 4;
      float o[4];
#pragma unroll
      for (int e = 0; e < 4; ++e) o[e] = v0[j][e] * r0 * gq[j][e] * (1.f + sc0[j][e]) + sh0[j][e];
      st4(H + (size_t)m0 * 1024 + c, o[0], o[1], o[2], o[3]);
    }
    if (has1) {
#pragma unroll
      for (int j = 0; j < 4; ++j) {
        const int c = j * 256 + lane * 4;
        float o[4];
#pragma unroll
        for (int e = 0; e < 4; ++e) o[e] = v1[j][e] * r1 * gq[j][e] * (1.f + sc1[j][e]) + sh1[j][e];
        st4(H + (size_t)m1 * 1024 + c, o[0], o[1], o[2], o[3]);
      }
    }
  }
}

static __device__ __forceinline__ void phase_inproj(const P& p, int l, char* lds) {
  const int tid = otid(), lane = tid & 63, wid = tid >> 6, r32 = lane & 31, hi = lane >> 5, wm = wid >> 1, wn = wid & 1, lr = tid >> 3;
  const u16* H = (const u16*)(p.ws + OFF_H); const u16* W = wl(p, l) + W_IN;
  u16* proj = (u16*)(p.ws + OFF_PROJ);
  const float* cosS = (const float*)(p.ws + OFF_ROPE + ROPE_COSS); const float* sinS = (const float*)(p.ws + OFF_ROPE + ROPE_SINS);
  const int ns = tile_steps(264, 12, 16, 2);
  u32x4 ra0[4], rb0[2], ra1[4], rb1[2];
  LdRows al, bl; int mt, nt;
  auto mk = [&](int mt_, int nt_, LdRows& a_, LdRows& b_) {
#pragma unroll
    for (int j = 0; j < 4; ++j) a_.p[j] = H + (size_t)(mt_ * 256 + lr + 64 * j) * 1024;
#pragma unroll
    for (int j = 0; j < 2; ++j) b_.p[j] = W + (size_t)(nt_ * 128 + lr + 64 * j) * 1024;
    b_.p[2] = b_.p[3] = b_.p[0];
  };
  int s = tile_next(0, ns, 264, 12, 16, 2, mt, nt);
  if (s >= 0) { mk(mt, nt, al, bl); gemm_issue<4, 2>(tid, al, bl, 16, ra0, rb0, ra1, rb1); }
  while (s >= 0) {
    f32x16 acc[2][2]; zero_acc(acc);
    __syncthreads();
    gemm_run<4, 2, 2, 2>(tid, lds + LDS_SCR, al, bl, 16, acc, ra0, rb0, ra1, rb1);
    int mt2 = 0, nt2 = 0; const int s2 = tile_next(s + 1, ns, 264, 12, 16, 2, mt2, nt2);
    if (s2 >= 0) { mk(mt2, nt2, al, bl); gemm_issue<4, 2>(tid, al, bl, 16, ra0, rb0, ra1, rb1); }
    const int n0w = nt * 128 + wn * 64, mw = mt * 256 + wm * 64;
    if (n0w < 896) {
#pragma unroll
      for (int tm = 0; tm < 2; ++tm) {
        const int m = mw + 32 * tm + r32;
        u16* dst = proj + (size_t)m * PROJ_LD + n0w;
#pragma unroll
        for (int tn = 0; tn < 2; ++tn) {
#pragma unroll
          for (int rg = 0; rg < 4; ++rg) st4(dst + 32 * tn + 8 * rg + 4 * hi, acc[tm][tn][4 * rg], acc[tm][tn][4 * rg + 1], acc[tm][tn][4 * rg + 2], acc[tm][tn][4 * rg + 3]);
        }
      }
    } else if (n0w < 1408) {
      const bool isq = n0w < 1280; const int head = isq ? (n0w - 896) >> 6 : (n0w - 1280) >> 6;
      const float* g = (isq ? p.sq_norm : p.sk_norm) + l * 64;
      u16* dbase = (u16*)(p.ws + (isq ? OFF_QS : OFF_KS));
      const float osc = isq ? 0.125f * LOG2E : 1.f;
#pragma unroll
      for (int tm = 0; tm < 2; ++tm) {
        const int m = mw + 32 * tm + r32;
        float ss = 0.f;
#pragma unroll
        for (int r = 0; r < 16; ++r) ss += acc[tm][0][r] * acc[tm][0][r] + acc[tm][1][r] * acc[tm][1][r];
        ss = xsum32(ss);
        const float rs = rsqrtf(ss * (1.f / 64.f) + EPS);
        u16* dst = dbase + head_row(m, head, isq ? 6 : 2) * 64;
        const bool lat = m < MLAT; const int t = m & 8191;
        f32x4 g1q[4], g2q[4], csq[4], snq[4];
#pragma unroll
        for (int rg = 0; rg < 4; ++rg) {
          const int d = 8 * rg + 4 * hi;
          g1q[rg] = *(const f32x4*)(g + d); g2q[rg] = *(const f32x4*)(g + 32 + d);
          csq[rg] = f32x4{1.f, 1.f, 1.f, 1.f}; snq[rg] = f32x4{0.f, 0.f, 0.f, 0.f};
          if (lat) { csq[rg] = *(const f32x4*)(cosS + t * 32 + d); snq[rg] = *(const f32x4*)(sinS + t * 32 + d); }
        }
#pragma unroll
        for (int rg = 0; rg < 4; ++rg) {
          const int d = 8 * rg + 4 * hi;
          const f32x4 g1 = g1q[rg], g2 = g2q[rg], cs = csq[rg], sn = snq[rg];
          float y1[4], y2[4];
#pragma unroll
          for (int e = 0; e < 4; ++e) {
            const float x1 = acc[tm][0][4 * rg + e] * rs * g1[e], x2 = acc[tm][1][4 * rg + e] * rs * g2[e];
            y1[e] = (x1 * cs[e] - x2 * sn[e]) * osc; y2[e] = (x1 * sn[e] + x2 * cs[e]) * osc;
          }
          st4(dst + d, y1[0], y1[1], y1[2], y1[3]); st4(dst + 32 + d, y2[0], y2[1], y2[2], y2[3]);
        }
      }
    } else if (n0w < 1536) {
      const int head = (n0w - 1408) >> 6;
      u16* dbase = (u16*)(p.ws + OFF_VS);
#pragma unroll
      for (int tm = 0; tm < 2; ++tm) {
        const int m = mw + 32 * tm + r32;
        u16* dst = dbase + head_row(m, head, 2) * 64;
#pragma unroll
        for (int tn = 0; tn < 2; ++tn)
#pragma unroll
          for (int rg = 0; rg < 4; ++rg) st4(dst + 32 * tn + 8 * rg + 4 * hi, acc[tm][tn][4 * rg], acc[tm][tn][4 * rg + 1], acc[tm][tn][4 * rg + 2], acc[tm][tn][4 * rg + 3]);
      }
    }
    s = s2; mt = mt2; nt = nt2;
  }
  for (int it = blockIdx.x; it < 264; it += gridDim.x) {
    LdRows a2, b2;
#pragma unroll
    for (int j = 0; j < 4; ++j) a2.p[j] = H + (size_t)(it * 256 + lr + 64 * j) * 1024;
    b2.p[0] = W + (size_t)(1536 + (lr < 32 ? lr : 31)) * 1024; b2.p[1] = b2.p[2] = b2.p[3] = b2.p[0];
    f32x16 acc2[1][2]; zero_acc(acc2);
    __syncthreads();
    gemm_main<8, 1, 1, 2>(tid, lds + LDS_SCR, a2, b2, 16, acc2);
    u16* dst = proj + (size_t)(it * 256 + wid * 32 + r32) * PROJ_LD + 896;
#pragma unroll
    for (int rg = 0; rg < 4; ++rg) st4(dst + 8 * rg + 4 * hi, acc2[0][0][4 * rg], acc2[0][0][4 * rg + 1], acc2[0][0][4 * rg + 2], acc2[0][0][4 * rg + 3]);
  }
}

template <int NCOLS>
DI void lora_rstd(int tid, const u16* proj, int m0, int col0, float* scr) {
  constexpr int NCH = NCOLS / 64;
  const int sub = tid & 7, rs = tid >> 3;
  u32x4 w[4][NCH];
#pragma unroll
  for (int j = 0; j < 4; ++j) {
    const u16* src = proj + (size_t)(m0 + rs + 64 * j) * PROJ_LD + col0 + sub * 8;
#pragma unroll
    for (int c = 0; c < NCH; ++c) w[j][c] = *(const u32x4*)(src + c * 64);
  }
#pragma unroll
  for (int j = 0; j < 4; ++j) {
    float ss = 0.f;
#pragma unroll
    for (int c = 0; c < NCH; ++c)
#pragma unroll
      for (int e = 0; e < 4; ++e) { const float a = bflo(w[j][c][e]), b = bfhi(w[j][c][e]); ss += a * a + b * b; }
    ss += __shfl_xor(ss, 1); ss += __shfl_xor(ss, 2); ss += __shfl_xor(ss, 4);
    if (sub == 0) scr[rs + 64 * j] = rsqrtf(ss * (1.f / (float)NCOLS) + EPS);
  }
}

static __device__ __forceinline__ void phase_mla_prep(const P& p, int l, char* lds) {
  const int tid = otid(), lane = tid & 63, wid = tid >> 6, r32 = lane & 31, hi = lane >> 5, lr = tid >> 3;
  const u16* proj = (const u16*)(p.ws + OFF_PROJ);
  float* scr = (float*)lds;
  const float* cosA = (const float*)(p.ws + OFF_ROPE + ROPE_COSA); const float* sinA = (const float*)(p.ws + OFF_ROPE + ROPE_SINA);
  {
    const u16* W = wl(p, l) + W_UQ; const float* g = p.q_norm + l * 96; u16* Qm = (u16*)(p.ws + OFF_QM);
    const int wm = wid >> 1, wn = wid & 1;
    const float osc = 0.10206207261596577f * LOG2E;
    for (int s = 0, ns = tile_steps(264, 3, 32, 1); s < ns; ++s) {
      int mt, nt; if (!tile_get(s, 264, 3, 32, 1, mt, nt)) continue;
      const int m0 = mt * 256;
      __syncthreads();
      lora_rstd<384>(tid, proj, m0, 0, scr);
      LdRows al, bl;
#pragma unroll
      for (int j = 0; j < 4; ++j) al.p[j] = proj + (size_t)(m0 + lr + 64 * j) * PROJ_LD;
#pragma unroll
      for (int j = 0; j < 3; ++j) bl.p[j] = W + (size_t)(nt * 192 + lr + 64 * j) * 384;
      bl.p[3] = bl.p[0];
      f32x16 acc[2][3]; zero_acc(acc);
      gemm_main<4, 2, 2, 3>(tid, lds + LDS_SCR, al, bl, 6, acc);
      const int head = nt * 2 + wn;
#pragma unroll
      for (int tm = 0; tm < 2; ++tm) {
        const int rl = wm * 64 + 32 * tm + r32, m = m0 + rl;
        const float rlo = scr[rl];
        float ss = 0.f;
#pragma unroll
        for (int tn = 0; tn < 3; ++tn)
#pragma unroll
          for (int r = 0; r < 16; ++r) ss += acc[tm][tn][r] * acc[tm][tn][r];
        ss = xsum32(ss);
        const float f = rlo * rsqrtf(rlo * rlo * ss * (1.f / 96.f) + EPS);
        u16* dst = Qm + head_row(m, head, 6) * 96;
        const bool lat = m < MLAT; const int t = m & 8191;
        f32x4 gq[2][4], r1q[2], r2q[2], csq[2], snq[2];
#pragma unroll
        for (int tn = 0; tn < 2; ++tn)
#pragma unroll
          for (int rg = 0; rg < 4; ++rg) gq[tn][rg] = *(const f32x4*)(g + 32 * tn + 8 * rg + 4 * hi);
#pragma unroll
        for (int rg = 0; rg < 2; ++rg) {
          const int j = 8 * rg + 4 * hi; r1q[rg] = *(const f32x4*)(g + 64 + j); r2q[rg] = *(const f32x4*)(g + 80 + j);
          csq[rg] = f32x4{1.f, 1.f, 1.f, 1.f}; snq[rg] = f32x4{0.f, 0.f, 0.f, 0.f};
          if (lat) { csq[rg] = *(const f32x4*)(cosA + t * 16 + j); snq[rg] = *(const f32x4*)(sinA + t * 16 + j); }
        }
#pragma unroll
        for (int tn = 0; tn < 2; ++tn)
#pragma unroll
          for (int rg = 0; rg < 4; ++rg) {
            const int d = 32 * tn + 8 * rg + 4 * hi; const f32x4 gv = gq[tn][rg];
            st4(dst + d, acc[tm][tn][4 * rg] * f * gv[0] * osc, acc[tm][tn][4 * rg + 1] * f * gv[1] * osc, acc[tm][tn][4 * rg + 2] * f * gv[2] * osc, acc[tm][tn][4 * rg + 3] * f * gv[3] * osc);
          }
#pragma unroll
        for (int rg = 0; rg < 2; ++rg) {
          const int j = 8 * rg + 4 * hi; const f32x4 g1 = r1q[rg], g2 = r2q[rg], cs = csq[rg], sn = snq[rg];
          float y1[4], y2[4];
#pragma unroll
          for (int e = 0; e < 4; ++e) {
            const float x1 = acc[tm][2][4 * rg + e] * f * g1[e], x2 = acc[tm][2][8 + 4 * rg + e] * f * g2[e];
            y1[e] = (x1 * cs[e] - x2 * sn[e]) * osc; y2[e] = (x1 * sn[e] + x2 * cs[e]) * osc;
          }
          st4(dst + 64 + j, y1[0], y1[1], y1[2], y1[3]); st4(dst + 80 + j, y2[0], y2[1], y2[2], y2[3]);
        }
      }
    }
  }
  {
    const u16* W = wl(p, l) + W_UKV; const float* g = p.k_norm + l * 96; u16* Km = (u16*)(p.ws + OFF_KM); u16* Vm = (u16*)(p.ws + OFF_VM);
    for (int s = 0, ns = tile_steps(264, 6, 16, 2); s < ns; ++s) {
      int mt, head; if (!tile_get(s, 264, 6, 16, 2, mt, head)) continue;
      const int m0 = mt * 256;
      __syncthreads();
      lora_rstd<256>(tid, proj, m0, 384, scr);
      LdRows al, bl;
#pragma unroll
      for (int j = 0; j < 4; ++j) al.p[j] = proj + (size_t)(m0 + lr + 64 * j) * PROJ_LD + 384;
#pragma unroll
      for (int j = 0; j < 2; ++j) bl.p[j] = W + (size_t)(head * 128 + lr + 64 * j) * 256;
      bl.p[2] = bl.p[3] = bl.p[0];
      f32x16 acc[1][4]; zero_acc(acc);
      gemm_main<8, 1, 1, 4>(tid, lds + LDS_SCR, al, bl, 4, acc);
      const int rl = wid * 32 + r32, m = m0 + rl;
      const float rlo = scr[rl];
      float ssr = 0.f; u32x4 wx1, wx2;
      {
        const u16* kp = proj + (size_t)m * PROJ_LD + 896;
        const u32x4 w0 = *(const u32x4*)(kp), w1 = *(const u32x4*)(kp + 8), w2 = *(const u32x4*)(kp + 16), w3 = *(const u32x4*)(kp + 24);
#pragma unroll
        for (int e = 0; e < 4; ++e) {
          ssr += bflo(w0[e]) * bflo(w0[e]) + bfhi(w0[e]) * bfhi(w0[e]) + bflo(w1[e]) * bflo(w1[e]) + bfhi(w1[e]) * bfhi(w1[e]);
          ssr += bflo(w2[e]) * bflo(w2[e]) + bfhi(w2[e]) * bfhi(w2[e]) + bflo(w3[e]) * bflo(w3[e]) + bfhi(w3[e]) * bfhi(w3[e]);
        }
        wx1 = hi ? w1 : w0; wx2 = hi ? w3 : w2;
      }
      float ss = 0.f;
#pragma unroll
      for (int tn = 0; tn < 2; ++tn)
#pragma unroll
        for (int r = 0; r < 16; ++r) ss += acc[0][tn][r] * acc[0][tn][r];
      ss = xsum32(ss);
      const float rk = rsqrtf((rlo * rlo * ss + ssr) * (1.f / 96.f) + EPS);
      const size_t hr = head_row(m, head, 6);
      u16* kd = Km + hr * 96; u16* vd = Vm + hr * 64;
      const bool lat = m < MLAT; const int t = m & 8191;
      f32x4 gq[2][4]; float gr1[8], gr2[8], csr[8], snr[8];
#pragma unroll
      for (int tn = 0; tn < 2; ++tn)
#pragma unroll
        for (int rg = 0; rg < 4; ++rg) gq[tn][rg] = *(const f32x4*)(g + 32 * tn + 8 * rg + 4 * hi);
#pragma unroll
      for (int e = 0; e < 8; ++e) {
        const int j = 8 * hi + e; gr1[e] = g[64 + j]; gr2[e] = g[80 + j]; csr[e] = 1.f; snr[e] = 0.f;
        if (lat) { csr[e] = cosA[t * 16 + j]; snr[e] = sinA[t * 16 + j]; }
      }
#pragma unroll
      for (int tn = 0; tn < 2; ++tn)
#pragma unroll
        for (int rg = 0; rg < 4; ++rg) {
          const int d = 32 * tn + 8 * rg + 4 * hi; const f32x4 gv = gq[tn][rg]; const float f = rlo * rk;
          st4(kd + d, acc[0][tn][4 * rg] * f * gv[0], acc[0][tn][4 * rg + 1] * f * gv[1], acc[0][tn][4 * rg + 2] * f * gv[2], acc[0][tn][4 * rg + 3] * f * gv[3]);
          st4(vd + d, acc[0][2 + tn][4 * rg] * rlo, acc[0][2 + tn][4 * rg + 1] * rlo, acc[0][2 + tn][4 * rg + 2] * rlo, acc[0][2 + tn][4 * rg + 3] * rlo);
        }
      {
        float y1[8], y2[8];
#pragma unroll
        for (int e = 0; e < 8; ++e) {
          const int j = 8 * hi + e;
          const float k1 = (e & 1) ? bfhi(wx1[e >> 1]) : bflo(wx1[e >> 1]), k2 = (e & 1) ? bfhi(wx2[e >> 1]) : bflo(wx2[e >> 1]);
          const float x1 = k1 * rk * gr1[e], x2 = k2 * rk * gr2[e];
          const float cs = csr[e], sn = snr[e];
          y1[e] = x1 * cs - x2 * sn; y2[e] = x1 * sn + x2 * cs;
        }
        u32x4 w1 = {pk2(y1[0], y1[1]), pk2(y1[2], y1[3]), pk2(y1[4], y1[5]), pk2(y1[6], y1[7])};
        u32x4 w2 = {pk2(y2[0], y2[1]), pk2(y2[2], y2[3]), pk2(y2[4], y2[5]), pk2(y2[6], y2[7])};
        *(u32x4*)(kd + 64 + 8 * hi) = w1; *(u32x4*)(kd + 80 + 8 * hi) = w2;
      }
    }
  }
}

static __device__ __forceinline__ void phase_s5_states(const P& p, int l, char* lds) {
  const int tid = otid(), lane = tid & 63, wid = tid >> 6, r32 = lane & 31, hi = lane >> 5, wm = wid >> 1, wn = wid & 1, lr = tid >> 3;
  const u16* proj = (const u16*)(p.ws + OFF_PROJ); float* Sst = (float*)(p.ws + OFF_SST);
  for (int it = blockIdx.x; it < 160; it += gridDim.x) {
    const int g = it / 10, r = it % 10, mt = r >> 1, nt = r & 1;
    LdS5A al; LdRows bl;
#pragma unroll
    for (int j = 0; j < 4; ++j) { const int row = mt * 256 + lr + 64 * j; al.pu[j] = proj + (size_t)s5_tokbase(row < 1056 ? row : 0) * PROJ_LD + 640 + g * 16; al.ph[j] = al.pu[j]; }
    const u16* B = s5t(p, l) + S5_BST + (size_t)g * 256 * 1024;
#pragma unroll
    for (int j = 0; j < 2; ++j) bl.p[j] = B + (size_t)(nt * 128 + lr + 64 * j) * 1024;
    bl.p[2] = bl.p[3] = bl.p[0];
    f32x16 acc[2][2]; zero_acc(acc);
    __syncthreads();
    gemm_main<4, 2, 2, 2>(tid, lds + LDS_SCR, al, bl, 16, acc);
#pragma unroll
    for (int tm = 0; tm < 2; ++tm) {
      const int row = mt * 256 + wm * 64 + 32 * tm + r32;
      if (row < 1056) {
        float* dst = Sst + ((size_t)row * 16 + g) * 256 + nt * 128 + wn * 64;
#pragma unroll
        for (int tn = 0; tn < 2; ++tn)
#pragma unroll
          for (int rg = 0; rg < 4; ++rg) { f32x4 v = {acc[tm][tn][4 * rg], acc[tm][tn][4 * rg + 1], acc[tm][tn][4 * rg + 2], acc[tm][tn][4 * rg + 3]}; *(f32x4*)(dst + 32 * tn + 8 * rg + 4 * hi) = v; }
      }
    }
  }
}

static __device__ __forceinline__ void s5_scan_item(const P& p, int l, int blk) {
  const int gt = blk * NTHREADS + otid();
  const int pp = gt & 63, dir = (gt >> 6) & 1, g = (gt >> 7) & 15, b = gt >> 11;
  const dc a64d = ((const dc*)(p.ws + OFF_S5PW))[(size_t)((((l * 2 + dir) * 16 + g) * 64) + pp) * 65 + 64];
  const float ar = (float)a64d.re, ai = (float)a64d.im;
  const float* Sst = (const float*)(p.ws + OFF_SST); unsigned* Hin = (unsigned*)(p.ws + OFF_HIN);
  const int col = g * 256 + dir * 128 + 2 * pp;
  float hr = 0.f, hi_ = 0.f;
#pragma unroll 1
  for (int s0 = 0; s0 < 132; s0 += 4) {
    int rows[4]; f32x2 sv[4];
#pragma unroll
    for (int e = 0; e < 4; ++e) {
      const int st = s0 + e; int row;
      if (st < 4) { const int c = dir ? 3 - st : st; row = 1024 + b * 4 + c; } else { const int s2 = st - 4; const int c = dir ? 127 - s2 : s2; row = b * 128 + c; }
      rows[e] = row; sv[e] = *(const f32x2*)(Sst + (size_t)row * 4096 + col);
    }
#pragma unroll
    for (int e = 0; e < 4; ++e) {
      Hin[((size_t)rows[e] * 4096 + col) >> 1] = pk2(hr, hi_);
      const float nr = ar * hr - ai * hi_ + sv[e][0], ni = ar * hi_ + ai * hr + sv[e][1];
      hr = nr; hi_ = ni;
    }
  }
}

static __device__ __forceinline__ void phase_s5_out(const P& p, int l, char* lds) {
  const int tid = otid(), lane = tid & 63, wid = tid >> 6, r32 = lane & 31, hi = lane >> 5, wm = wid >> 1, wn = wid & 1, lr = tid >> 3;
  const u16* proj = (const u16*)(p.ws + OFF_PROJ); const u16* Hin = (const u16*)(p.ws + OFF_HIN); u16* zb = (u16*)(p.ws + OFF_ZB);
  const int per_g = l == NLAYER - 1 ? 32 : 40;
  for (int it = blockIdx.x; it < 16 * per_g; it += gridDim.x) {
    const int g = it / per_g, r = it % per_g, mt = r >> 3, nt = r & 7;
    LdS5A al; LdS5B bl;
#pragma unroll
    for (int j = 0; j < 4; ++j) {
      const int row = mt * 256 + lr + 64 * j;
      al.pu[j] = proj + (size_t)s5_tokbase(row < 1056 ? row : 0) * PROJ_LD + 640 + g * 16;
      al.ph[j] = Hin + ((size_t)(row < 1056 ? row : 0) * 16 + g) * 256;
    }
    const u16* Kc = s5t(p, l) + S5_KC + (size_t)g * 127 * 256; const u16* Mrd = s5t(p, l) + S5_MRD + (size_t)g * 1024 * 256;
#pragma unroll
    for (int j = 0; j < 2; ++j) { const int n = nt * 128 + lr + 64 * j; bl.pk[j] = Kc + ((n >> 4) + 63) * 256 + (n & 15) * 16; bl.pm[j] = Mrd + (size_t)n * 256; }
    f32x16 acc[2][2]; zero_acc(acc);
    __syncthreads();
    gemm_main<4, 2, 2, 2>(tid, lds + LDS_SCR, al, bl, 20, acc);
#pragma unroll
    for (int tm = 0; tm < 2; ++tm) {
      const int row = mt * 256 + wm * 64 + 32 * tm + r32;
      if (row < 1056) {
        const int tb = s5_tokbase(row);
#pragma unroll
        for (int tn = 0; tn < 2; ++tn)
#pragma unroll
          for (int rg = 0; rg < 4; ++rg) {
            const int n = nt * 128 + wn * 64 + 32 * tn + 8 * rg + 4 * hi;
            u16* dst = zb + (size_t)(tb + (n >> 4)) * 256 + g * 16 + (n & 15);
            st4(dst, gelu_tanh(acc[tm][tn][4 * rg]), gelu_tanh(acc[tm][tn][4 * rg + 1]), gelu_tanh(acc[tm][tn][4 * rg + 2]), gelu_tanh(acc[tm][tn][4 * rg + 3]));
          }
      }
    }
  }
}

static __device__ __forceinline__ void phase_glu(const P& p, int l, char* lds) {
  const int tid = otid(), lane = tid & 63, wid = tid >> 6, r32 = lane & 31, hi = lane >> 5, wm = wid >> 1, wn = wid & 1, lr = tid >> 3;
  const u16* zb = (const u16*)(p.ws + OFF_ZB); const u16* W = wl(p, l) + W_GLU; u16* mix = (u16*)(p.ws + OFF_MIX); const float* bg = p.b_glu + l * 256;
  const int MT = l == NLAYER - 1 ? 256 : 264;
  for (int s = 0, ns = tile_steps(MT, 2, 16, 2); s < ns; ++s) {
    int mt, nt; if (!tile_get(s, MT, 2, 16, 2, mt, nt)) continue;
    LdRows al, bl;
#pragma unroll
    for (int j = 0; j < 4; ++j) al.p[j] = zb + (size_t)(mt * 256 + lr + 64 * j) * 256;
#pragma unroll
    for (int j = 0; j < 2; ++j) bl.p[j] = W + (size_t)(nt * 128 + lr + 64 * j) * 256;
    bl.p[2] = bl.p[3] = bl.p[0];
    f32x16 acc[2][2]; zero_acc(acc);
    __syncthreads();
    gemm_main<4, 2, 2, 2>(tid, lds + LDS_SCR, al, bl, 4, acc);
    u32x2 zq[2][2][4]; f32x4 bq[2][4];
#pragma unroll
    for (int tn = 0; tn < 2; ++tn)
#pragma unroll
      for (int rg = 0; rg < 4; ++rg) {
        const int n = nt * 128 + wn * 64 + 32 * tn + 8 * rg + 4 * hi; bq[tn][rg] = *(const f32x4*)(bg + n);
#pragma unroll
        for (int tm = 0; tm < 2; ++tm) zq[tm][tn][rg] = *(const u32x2*)(zb + (size_t)(mt * 256 + wm * 64 + 32 * tm + r32) * 256 + n);
      }
#pragma unroll
    for (int tm = 0; tm < 2; ++tm) {
      const int m = mt * 256 + wm * 64 + 32 * tm + r32;
#pragma unroll
      for (int tn = 0; tn < 2; ++tn)
#pragma unroll
        for (int rg = 0; rg < 4; ++rg) {
          const int n = nt * 128 + wn * 64 + 32 * tn + 8 * rg + 4 * hi;
          const u32x2 zw = zq[tm][tn][rg]; const f32x4 bv = bq[tn][rg];
          const float z0 = bflo(zw[0]), z1 = bfhi(zw[0]), z2 = bflo(zw[1]), z3 = bfhi(zw[1]);
          st4(mix + (size_t)m * 1024 + 384 + n, z0 * sigmoid_f(acc[tm][tn][4 * rg] + bv[0]), z1 * sigmoid_f(acc[tm][tn][4 * rg + 1] + bv[1]), z2 * sigmoid_f(acc[tm][tn][4 * rg + 2] + bv[2]),
              z3 * sigmoid_f(acc[tm][tn][4 * rg + 3] + bv[3]));
        }
    }
  }
}

template <int DQK>
DI void attn_unit(int tid, char* lds, const u16* Qp, const u16* K1, const u16* V1, int nt1, int kpos0, const u16* K2, const u16* V2, int nt2, int qpos0, bool mask, float m_init, float l_init, u16* Op) {
  constexpr int KP = DQK * 2 + 16, KB = 64 * KP, VB = 8192, SB = KB + VB, NCH = DQK / 8, NKC = 64 * NCH, ND = DQK / 16;
  const int lane = tid & 63, wid = tid >> 6, r32 = lane & 31, hi = lane >> 5;
  bf16x8 qr[ND];
  {
    const u16* qrow = Qp + (size_t)(wid * 32 + r32) * DQK + hi * 8;
#pragma unroll
    for (int d0 = 0; d0 < ND; ++d0) qr[d0] = *(const bf16x8*)(qrow + d0 * 16);
  }
  const int kk0 = tid / NCH, kc0 = tid % NCH;
  const int id1 = tid + NTHREADS; const bool has1 = id1 < NKC; const int kk1 = id1 / NCH, kc1 = id1 % NCH;
  const int idl = has1 ? id1 : tid;
  const int vkey = tid >> 3, vc = tid & 7;
  const int vst = ((vkey >> 3) * 2 + (vc >> 2)) * 512 + (vkey & 7) * 64 + (vc & 3) * 16;
  const int vrb = ((lane & 3) << 3) | (((lane >> 2) & 3) << 6) | (((lane >> 4) & 1) << 5) | (((lane >> 5) & 1) << 8);
  const int kw0 = kk0 * KP + kc0 * 16, kw1 = kk1 * KP + kc1 * 16, kro = r32 * KP + hi * 16;
  f32x16 o0, o1;
#pragma unroll
  for (int r = 0; r < 16; ++r) { o0[r] = 0.f; o1[r] = 0.f; }
  constexpr float THR = 8.f;
  float mrun = m_init, lrun = hi == 0 ? l_init : 0.f;
  f32x16 negm;
#pragma unroll
  for (int r = 0; r < 16; ++r) negm[r] = -mrun;
  const int NT = nt1 + nt2;
  const int qpos = qpos0 + wid * 32 + r32;
  u32x4 sk0, sk1, sv;
  auto gl = [&](int i) {
    const u16* kp; const u16* vp;
    if (i < nt1) { kp = K1 + (size_t)i * 64 * DQK; vp = V1 + (size_t)i * 4096; } else { kp = K2 + (size_t)(i - nt1) * 64 * DQK; vp = V2 + (size_t)(i - nt1) * 4096; }
    sk0 = *(const u32x4*)(kp + (size_t)tid * 8); sk1 = *(const u32x4*)(kp + (size_t)idl * 8); sv = *(const u32x4*)(vp + (size_t)tid * 8);
  };
  auto sw = [&](int st) {
    char* b = lds + st * SB;
    *(u32x4*)(b + kw0) = sk0; if (has1) *(u32x4*)(b + kw1) = sk1; *(u32x4*)(b + KB + vst) = sv;
  };
  auto qk = [&](int st, f32x16& p0, f32x16& p1) {
    const char* Kb = lds + st * SB + kro;
#pragma unroll
    for (int d0 = 0; d0 < ND; ++d0) {
      const bf16x8 a0 = *(const bf16x8*)(Kb + d0 * 32);
      const bf16x8 a1 = *(const bf16x8*)(Kb + 32 * KP + d0 * 32);
      if (d0 == 0) { p0 = mfma(a0, qr[0], negm); p1 = mfma(a1, qr[0], negm); } else { p0 = mfma(a0, qr[d0], p0); p1 = mfma(a1, qr[d0], p1); }
    }
  };
  const int qw0 = qpos0 + wid * 32;
  auto live = [&](int i) { if (!mask || i >= nt1) return true; const int kb = kpos0 + i * 64; return kb + 63 >= qw0 - 128 && kb <= qw0 + 31 + 128; };
  auto step = [&](f32x16& c0, f32x16& c1, f32x16& n0, f32x16& n1, int i, int s_cur, int s_nxt, int s_wr) {
    const bool has_nxt = i + 1 < NT, has_wr = i + 2 < NT;
    if (has_wr) gl(i + 2);
    if (has_nxt && live(i + 1)) qk(s_nxt, n0, n1);
    if (live(i)) {
    if (mask && i < nt1) {
      const int kb = kpos0 + i * 64 - qpos;
#pragma unroll
      for (int r = 0; r < 16; ++r) {
        const int d0_ = kb + crow(r, hi), d1_ = d0_ + 32;
        if (d0_ > 128 || d0_ < -128) c0[r] = -1e30f;
        if (d1_ > 128 || d1_ < -128) c1[r] = -1e30f;
      }
    }
    float mt = c0[0];
#pragma unroll
    for (int r = 1; r < 16; ++r) mt = fmaxf(mt, c0[r]);
#pragma unroll
    for (int r = 0; r < 16; ++r) mt = fmaxf(mt, c1[r]);
    mt = xmax32(mt);
    if (__any(mt > THR)) {
      const float delta = fmaxf(mt, 0.f), alpha = ex2(-delta);
      mrun += delta; lrun *= alpha;
#pragma unroll
      for (int r = 0; r < 16; ++r) { o0[r] *= alpha; o1[r] *= alpha; c0[r] -= delta; c1[r] -= delta; n0[r] -= delta; n1[r] -= delta; negm[r] = -mrun; }
    }
    float ls = 0.f;
#pragma unroll
    for (int r = 0; r < 16; ++r) { c0[r] = ex2(c0[r]); c1[r] = ex2(c1[r]); ls += c0[r] + c1[r]; }
    lrun += ls;
    bf16x8 pb[4];
    { u32x4 w = {pk2(c0[0], c0[1]), pk2(c0[2], c0[3]), pk2(c0[4], c0[5]), pk2(c0[6], c0[7])}; pb[0] = __builtin_bit_cast(bf16x8, w); }
    { u32x4 w = {pk2(c0[8], c0[9]), pk2(c0[10], c0[11]), pk2(c0[12], c0[13]), pk2(c0[14], c0[15])}; pb[1] = __builtin_bit_cast(bf16x8, w); }
    { u32x4 w = {pk2(c1[0], c1[1]), pk2(c1[2], c1[3]), pk2(c1[4], c1[5]), pk2(c1[6], c1[7])}; pb[2] = __builtin_bit_cast(bf16x8, w); }
    { u32x4 w = {pk2(c1[8], c1[9]), pk2(c1[10], c1[11]), pk2(c1[12], c1[13]), pk2(c1[14], c1[15])}; pb[3] = __builtin_bit_cast(bf16x8, w); }
    LAS char* Vb = (LAS char*)(lds + s_cur * SB + KB + vrb);
#pragma unroll
    for (int ks = 0; ks < 4; ++ks) {
      const s16x4 l0 = __builtin_amdgcn_ds_read_tr16_b64_v4i16((LAS s16x4*)(Vb + ((2 * ks) * 2 + 0) * 512));
      const s16x4 h0 = __builtin_amdgcn_ds_read_tr16_b64_v4i16((LAS s16x4*)(Vb + ((2 * ks + 1) * 2 + 0) * 512));
      const s16x4 l1 = __builtin_amdgcn_ds_read_tr16_b64_v4i16((LAS s16x4*)(Vb + ((2 * ks) * 2 + 1) * 512));
      const s16x4 h1 = __builtin_amdgcn_ds_read_tr16_b64_v4i16((LAS s16x4*)(Vb + ((2 * ks + 1) * 2 + 1) * 512));
      const bf16x8 va0 = {l0[0], l0[1], l0[2], l0[3], h0[0], h0[1], h0[2], h0[3]};
      const bf16x8 va1 = {l1[0], l1[1], l1[2], l1[3], h1[0], h1[1], h1[2], h1[3]};
      o0 = mfma(va0, pb[ks], o0); o1 = mfma(va1, pb[ks], o1);
    }
    }
    if (has_wr) sw(s_wr);
    __syncthreads();
  };
  gl(0); sw(0);
  if (NT > 1) { gl(1); sw(1); }
  __syncthreads();
  f32x16 pA0, pA1, pB0, pB1;
#pragma unroll
  for (int r = 0; r < 16; ++r) { pB0[r] = 0.f; pB1[r] = 0.f; }
  if (live(0)) qk(0, pA0, pA1);
  int s_cur = 0, s_nxt = 1, s_wr = 2;
#pragma unroll 1
  for (int i = 0; i < NT; i += 2) {
    step(pA0, pA1, pB0, pB1, i, s_cur, s_nxt, s_wr);
    if (i + 1 >= NT) break;
    step(pB0, pB1, pA0, pA1, i + 1, s_nxt, s_wr, s_cur);
    const int t_ = s_cur; s_cur = s_wr; s_wr = s_nxt; s_nxt = t_;
  }
  const float inv = rcpf_(xsum32(lrun));
  u16* orow = Op + (size_t)(wid * 32 + r32) * 1024;
#pragma unroll
  for (int rg = 0; rg < 4; ++rg) {
    st4(orow + 8 * rg + 4 * hi, o0[4 * rg] * inv, o0[4 * rg + 1] * inv, o0[4 * rg + 2] * inv, o0[4 * rg + 3] * inv);
    st4(orow + 32 + 8 * rg + 4 * hi, o1[4 * rg] * inv, o1[4 * rg + 1] * inv, o1[4 * rg + 2] * inv, o1[4 * rg + 3] * inv);
  }
}

static __device__ __forceinline__ void phase_attn(const P& p, int l, char* lds) {
  if (blockIdx.x < 32) s5_scan_item(p, l, blockIdx.x);
  const int tid = otid();
  const u16* Qm = (const u16*)(p.ws + OFF_QM); const u16* Km = (const u16*)(p.ws + OFF_KM); const u16* Vm = (const u16*)(p.ws + OFF_VM);
  const u16* Qs = (const u16*)(p.ws + OFF_QS); const u16* Ks = (const u16*)(p.ws + OFF_KS); const u16* Vs = (const u16*)(p.ws + OFF_VS);
  u16* mix = (u16*)(p.ws + OFF_MIX);
  constexpr size_t CTX6 = (size_t)NBATCH * 6 * TLAT, CTX2 = (size_t)NBATCH * 2 * TLAT;
  const int nunits = l == NLAYER - 1 ? 3072 : 3168;
  for (int it = blockIdx.x; it < nunits; it += gridDim.x) {
    __syncthreads();
    if (it < 3072) {
      const int u = it < 1536 ? it : it - 1536;
      const int rr = u >> 8, bb = u & 255, bh = rr * 8 + (bb & 7), qb = bb >> 3, b = bh / 6, h = bh % 6, q0 = qb * 256;
      if (it < 1536) {
        const size_t r0 = (size_t)bh * TLAT, c0 = CTX6 + (size_t)bh * TCTX;
        attn_unit<96>(tid, lds, Qm + (r0 + q0) * 96, Km + r0 * 96, Vm + r0 * 64, 128, 0, Km + c0 * 96, Vm + c0 * 64, 4, q0, false, 0.f, 0.f, mix + (size_t)(b * TLAT + q0) * 1024 + h * 64);
      } else {
        const int kvh = h / 3, lo = q0 - 128 < 0 ? 0 : q0 - 128, hi_ = q0 + 384 > TLAT ? TLAT : q0 + 384;
        const size_t r0 = (size_t)(b * 2 + kvh) * TLAT, c0 = CTX2 + (size_t)(b * 2 + kvh) * TCTX;
        attn_unit<64>(tid, lds, Qs + ((size_t)bh * TLAT + q0) * 64, Ks + (r0 + lo) * 64, Vs + (r0 + lo) * 64, (hi_ - lo) >> 6, lo, Ks + c0 * 64, Vs + c0 * 64, 4, q0, true, p.sink[l * 6 + h] * LOG2E, 1.f,
                      mix + (size_t)(b * TLAT + q0) * 1024 + 640 + h * 64);
      }
    } else {
      const int u = it - 3072, ty = u / 48, bh = u % 48, b = bh / 6, h = bh % 6;
      if (ty == 0) {
        const size_t c0 = CTX6 + (size_t)bh * TCTX;
        attn_unit<96>(tid, lds, Qm + c0 * 96, Km + c0 * 96, Vm + c0 * 64, 4, 0, Km, Vm, 0, 0, false, 0.f, 0.f, mix + (size_t)(MLAT + b * TCTX) * 1024 + h * 64);
      } else {
        const int kvh = h / 3; const size_t c0 = CTX2 + (size_t)(b * 2 + kvh) * TCTX;
        attn_unit<64>(tid, lds, Qs + (CTX6 + (size_t)bh * TCTX) * 64, Ks + c0 * 64, Vs + c0 * 64, 4, 0, Ks, Vs, 0, 0, false, p.sink[l * 6 + h] * LOG2E, 1.f, mix + (size_t)(MLAT + b * TCTX) * 1024 + 640 + h * 64);
      }
    }
  }
}

static __device__ __forceinline__ void phase_resid_gemm(const P& p, int l, const u16* A, const u16* W, int ldk, int gate_off, char* lds, bool from_input = false) {
  const int tid = otid(), lane = tid & 63, wid = tid >> 6, r32 = lane & 31, hi = lane >> 5, wm = wid >> 1, wn = wid & 1, lr = tid >> 3;
  const int MT = l == NLAYER - 1 ? 256 : 264;
  const int ns = tile_steps(MT, 8, 4, 8), nk = ldk >> 6;
  u32x4 ra0[4], rb0[2], ra1[4], rb1[2];
  LdRows al, bl; int mt, nt;
  auto mk = [&](int mt_, int nt_, LdRows& a_, LdRows& b_) {
#pragma unroll
    for (int j = 0; j < 4; ++j) a_.p[j] = A + (size_t)(mt_ * 256 + lr + 64 * j) * ldk;
#pragma unroll
    for (int j = 0; j < 2; ++j) b_.p[j] = W + (size_t)(nt_ * 128 + lr + 64 * j) * ldk;
    b_.p[2] = b_.p[3] = b_.p[0];
  };
  int s = tile_next(0, ns, MT, 8, 4, 8, mt, nt);
  if (s >= 0) { mk(mt, nt, al, bl); gemm_issue<4, 2>(tid, al, bl, nk, ra0, rb0, ra1, rb1); }
  while (s >= 0) {
    f32x16 acc[2][2]; zero_acc(acc);
    __syncthreads();
    gemm_run<4, 2, 2, 2, true>(tid, lds + LDS_SCR, al, bl, nk, acc, ra0, rb0, ra1, rb1);
    int mt2 = 0, nt2 = 0; const int s2 = tile_next(s + 1, ns, MT, 8, 4, 8, mt2, nt2);
    if (s2 >= 0) { mk(mt2, nt2, al, bl); gemm_issue<4, 2>(tid, al, bl, nk, ra0, rb0, ra1, rb1); }
    float* xb = xrow(p, mt * 256); const float* gv = modv(p, l, modidx(mt * 256)) + gate_off;
#pragma unroll
    for (int tn = 0; tn < 2; ++tn) {
      const int n = nt * 128 + wn * 64 + 32 * tn + r32; const float g = gv[n];
      float* xp = xb + (size_t)(wm * 64 + 4 * hi) * DM + n;
      const float* xs = (from_input ? xin(p, mt * 256) : (const float*)xb) + (size_t)(wm * 64 + 4 * hi) * DM + n;
      float xv[2][16];
#pragma unroll
      for (int tm = 0; tm < 2; ++tm)
#pragma unroll
        for (int r = 0; r < 16; ++r) xv[tm][r] = xs[(size_t)(32 * tm + (r & 3) + 8 * (r >> 2)) * DM];
#pragma unroll
      for (int tm = 0; tm < 2; ++tm)
#pragma unroll
        for (int r = 0; r < 16; ++r) xp[(size_t)(32 * tm + (r & 3) + 8 * (r >> 2)) * DM] = xv[tm][r] + g * acc[tm][tn][r];
    }
    s = s2; mt = mt2; nt = nt2;
  }
}

static __device__ __forceinline__ void phase_ffn_up(const P& p, int l, char* lds) {
  const int tid = otid(), lane = tid & 63, wid = tid >> 6, r32 = lane & 31, hi = lane >> 5, wm = wid >> 1, wn = wid & 1, lr = tid >> 3;
  const u16* H = (const u16*)(p.ws + OFF_H); const u16* W = wl(p, l) + W_UP; u16* act = (u16*)(p.ws + OFF_ACT);
  const float* cw = p.conv_w + (size_t)l * 3 * 5632; const float* cb = p.conv_b + (size_t)l * 5632;
  char* tile = lds + LDS_SCR;
  const int MEND = l == NLAYER - 1 ? MLAT : MTOT;
  const int RT = (MEND + 253) / 254;
  const int ns = tile_steps(RT, 44, 8, 4);
  u32x4 ra0[4], rb0[2], ra1[4], rb1[2];
  LdRows al, bl; int rt, nt;
  auto mk = [&](int rt_, int nt_, LdRows& a_, LdRows& b_) {
    const int ts_ = 254 * rt_ - 1;
#pragma unroll
    for (int j = 0; j < 4; ++j) { const int tt = ts_ + lr + 64 * j; a_.p[j] = (tt >= 0 && tt < MTOT) ? H + (size_t)tt * 1024 : (const u16*)(p.ws + OFF_ZERO); }
#pragma unroll
    for (int j = 0; j < 2; ++j) b_.p[j] = W + (size_t)(nt_ * 128 + lr + 64 * j) * 1024;
    b_.p[2] = b_.p[3] = b_.p[0];
  };
  int s = tile_next(0, ns, RT, 44, 8, 4, rt, nt);
  if (s >= 0) { mk(rt, nt, al, bl); gemm_issue<4, 2>(tid, al, bl, 16, ra0, rb0, ra1, rb1); }
  while (s >= 0) {
    const int tstart = 254 * rt - 1;
    f32x4 acc[4][4];
#pragma unroll
    for (int a_ = 0; a_ < 4; ++a_)
#pragma unroll
      for (int b_ = 0; b_ < 4; ++b_) acc[a_][b_] = f32x4{0.f, 0.f, 0.f, 0.f};
    __syncthreads();
    gemm_run16<false>(tid, lds + LDS_SCR, al, bl, 16, acc, ra0, rb0, ra1, rb1);
    int rt2 = 0, nt2 = 0; const int s2 = tile_next(s + 1, ns, RT, 44, 8, 4, rt2, nt2);
    if (s2 >= 0) { mk(rt2, nt2, al, bl); gemm_issue<4, 2>(tid, al, bl, 16, ra0, rb0, ra1, rb1); }
#pragma unroll
    for (int tm = 0; tm < 4; ++tm) {
      char* trow = tile + (wm * 64 + 16 * tm + (lane & 15)) * 528 + (wn * 64 + 4 * (lane >> 4)) * 4;
#pragma unroll
      for (int tn = 0; tn < 4; ++tn) *(f32x4*)(trow + 64 * tn) = acc[tm][tn];
    }
    __syncthreads();
    {
      const int cgp = tid & 7, wn2 = cgp >> 2, j0 = (cgp & 3) * 8;
      const int ca0 = nt * 64 + wn2 * 32 + j0;
      const int lca = (wn2 * 64 + j0) * 4, lcg = lca + 128;
      float wa0[8], wa1[8], wa2[8], ba[8], wg0[8], wg1[8], wg2[8], bg[8];
#pragma unroll
      for (int e = 0; e < 8; ++e) {
        wa0[e] = cw[ca0 + e]; wa1[e] = cw[5632 + ca0 + e]; wa2[e] = cw[2 * 5632 + ca0 + e]; ba[e] = cb[ca0 + e];
        wg0[e] = cw[DFF + ca0 + e]; wg1[e] = cw[5632 + DFF + ca0 + e]; wg2[e] = cw[2 * 5632 + DFF + ca0 + e]; bg[e] = cb[DFF + ca0 + e];
      }
#pragma unroll
      for (int jj = 0; jj < 4; ++jj) {
        const int r = (tid >> 3) + 64 * jj, tt = tstart + r;
        if (r >= 1 && r <= 254 && tt < MEND) {
          const int pos = tt < MLAT ? (tt & (TLAT - 1)) : ((tt - MLAT) & (TCTX - 1)), slen = tt < MLAT ? TLAT : TCTX;
          const float fm = pos == 0 ? 0.f : 1.f, fp = pos == slen - 1 ? 0.f : 1.f;
          const char* rp = tile + r * 528;
          float o[8];
#pragma unroll
          for (int hf = 0; hf < 2; ++hf) {
            const f32x4 am = *(const f32x4*)(rp - 528 + lca + hf * 16), a0 = *(const f32x4*)(rp + lca + hf * 16), ap = *(const f32x4*)(rp + 528 + lca + hf * 16);
            const f32x4 gm = *(const f32x4*)(rp - 528 + lcg + hf * 16), g0 = *(const f32x4*)(rp + lcg + hf * 16), gp = *(const f32x4*)(rp + 528 + lcg + hf * 16);
#pragma unroll
            for (int e = 0; e < 4; ++e) {
              const int q = hf * 4 + e;
              const float ua = wa0[q] * (fm * am[e]) + wa1[q] * a0[e] + wa2[q] * (fp * ap[e]) + ba[q];
              const float ug = wg0[q] * (fm * gm[e]) + wg1[q] * g0[e] + wg2[q] * (fp * gp[e]) + bg[q];
              o[q] = silu_f(ug) * ua;
            }
          }
          u32x4 w = {pk2(o[0], o[1]), pk2(o[2], o[3]), pk2(o[4], o[5]), pk2(o[6], o[7])};
          *(u32x4*)(act + (size_t)tt * DFF + ca0) = w;
        }
      }
    }
    s = s2; rt = rt2; nt = nt2;
  }
}

#define XB_TMO      128
#define XB_XCNT(j)  (256  + 64 * (j))
#define XB_XSUB(j)  (1280 + 64 * (j))
#define XB_XGEN(j)  (2304 + 64 * (j))
#define XB_TOP      3328
#define XB_TOPGEN   3392
#define XCD_BAR_WORDS 3456
#define XB_SPIN_CAP (1u << 24)
DI unsigned xb_ld(unsigned* p) { return __hip_atomic_load(p, __ATOMIC_RELAXED, __HIP_MEMORY_SCOPE_AGENT); }
DI unsigned xb_add(unsigned* p, unsigned v) { return __hip_atomic_fetch_add(p, v, __ATOMIC_RELAXED, __HIP_MEMORY_SCOPE_AGENT); }
DI unsigned xb_xcc_id() { return (unsigned)__builtin_amdgcn_s_getreg((3 << 11) | 20) & 0xFu; }
#define XB_SPIN(cond, bar) do { unsigned _sp = 0; while (cond) { __builtin_amdgcn_s_sleep(1); \
    if ((++_sp & 255u) == 0u) { if (xb_ld(&(bar)[XB_TMO])) break; if (_sp > XB_SPIN_CAP) { atomicAdd(&(bar)[XB_TMO], 1u); break; } } } } while (0)
struct XcdBarrier { unsigned* bar; unsigned x; volatile LAS unsigned* st; };
DI XcdBarrier xcd_barrier_post(unsigned* bar, volatile LAS unsigned* st) {
  XcdBarrier b; b.bar = bar; b.x = xb_xcc_id(); b.st = st;
  if (threadIdx.x == 0) (void)xb_add(&bar[XB_XCNT(b.x)], 1u);
  return b;
}
DI void xcd_barrier_complete(unsigned* bar, unsigned x, unsigned& nloc, unsigned& nx) {
  const unsigned G = gridDim.x * gridDim.y * gridDim.z;
  unsigned sum, cnt, mine, sp = 0u;
  for (;;) {
    sum = 0u; cnt = 0u; mine = 0u;
#pragma unroll
    for (unsigned j = 0; j < 16; ++j) { const unsigned c = xb_ld(&bar[XB_XCNT(j)]); sum += c; cnt += (c > 0u) ? 1u : 0u; mine = (j == x) ? c : mine; }
    if (sum == G) break;
    __builtin_amdgcn_s_sleep(1);
    if ((++sp & 255u) == 0u) { if (xb_ld(&bar[XB_TMO])) break; if (sp > XB_SPIN_CAP) { atomicAdd(&bar[XB_TMO], 1u); break; } }
  }
  nloc = mine > 0u ? mine : 1u; nx = cnt > 0u ? cnt : 1u;
}
DI void xcd_barrier(const XcdBarrier& b) {
  asm volatile("s_waitcnt vmcnt(0)" ::: "memory");
  __syncthreads();
  if (threadIdx.x == 0) {
    unsigned* bar = b.bar;
    __builtin_amdgcn_s_waitcnt(0);
    unsigned nloc = b.st[0], nx = b.st[1];
    if (nloc == 0u) { xcd_barrier_complete(bar, b.x, nloc, nx); b.st[0] = nloc; b.st[1] = nx; }
    const unsigned old = xb_add(&bar[XB_XSUB(b.x)], 1u);
    const unsigned gen = old / nloc;
    if (old + 1u == (gen + 1u) * nloc) {
      __builtin_amdgcn_fence(__ATOMIC_RELEASE, "agent");
      asm volatile("s_waitcnt vmcnt(0)" ::: "memory");
      const unsigned og = xb_add(&bar[XB_TOP], 1u);
      const unsigned tg = og / nx;
      if (og + 1u == (tg + 1u) * nx) xb_add(&bar[XB_TOPGEN], 1u);
      else XB_SPIN(xb_ld(&bar[XB_TOPGEN]) == tg, bar);
      __builtin_amdgcn_fence(__ATOMIC_ACQUIRE, "agent");
      xb_add(&bar[XB_XGEN(b.x)], 1u);
      asm volatile("s_waitcnt vmcnt(0)" ::: "memory");
    } else {
      XB_SPIN(xb_ld(&bar[XB_XGEN(b.x)]) == gen, bar);
      __builtin_amdgcn_fence(__ATOMIC_ACQUIRE, "agent");
      asm volatile("s_waitcnt vmcnt(0)" ::: "memory");
    }
  }
  __syncthreads();
}

__global__ void __launch_bounds__(NTHREADS) fwd_kernel(P p) {
  extern __shared__ __attribute__((aligned(16))) char lds_raw[];
  char* lds = lds_raw + LDS_FRONT;
  cg::grid_group grid = cg::this_grid();
  if (threadIdx.x == 0) *(u32x4*)lds_raw = u32x4{0u, 0u, 0u, 0u};
  __syncthreads();
  const XcdBarrier xb = xcd_barrier_post((unsigned*)(p.ws + OFF_BAR), (volatile LAS unsigned*)lds_raw);
  phase_pre(p);
  grid.sync();
  phase0(p, lds);
  xcd_barrier(xb);
  for (int l = 0; l < NLAYER; ++l) {
    phase_norm(p, l, 0);
    xcd_barrier(xb);
    phase_inproj(p, l, lds);
    xcd_barrier(xb);
    phase_mla_prep(p, l, lds);
    phase_s5_states(p, l, lds);
    xcd_barrier(xb);
    phase_attn(p, l, lds);
    xcd_barrier(xb);
    phase_s5_out(p, l, lds);
    xcd_barrier(xb);
    phase_glu(p, l, lds);
    xcd_barrier(xb);
    phase_resid_gemm(p, l, (const u16*)(p.ws + OFF_MIX), wl(p, l) + W_OUT, 1024, 2048, lds, l == 0);
    xcd_barrier(xb);
    phase_norm(p, l, 1);
    xcd_barrier(xb);
    phase_ffn_up(p, l, lds);
    xcd_barrier(xb);
    phase_resid_gemm(p, l, (const u16*)(p.ws + OFF_ACT), wl(p, l) + W_DN, DFF, 5120, lds);
    xcd_barrier(xb);
  }
}

extern "C" void kernel_launch(void* const* d_in, const int* in_sizes, int n_in, void* d_out, int out_size, void* d_ws, size_t ws_size, hipStream_t stream) {
  static int grid_blocks = 0;
  if (!grid_blocks) {
    if (ws_size < WS_NEED) { fprintf(stderr, "kernel_launch: workspace too small: %zu < %zu\n", ws_size, (size_t)WS_NEED); return; }
    if (hipFuncSetAttribute((const void*)fwd_kernel, hipFuncAttributeMaxDynamicSharedMemorySize, LDS_TOTAL) != hipSuccess) { fprintf(stderr, "kernel_launch: LDS attribute failed\n"); return; }
    int dev = 0, cus = 0, per_cu = 0;
    hipGetDevice(&dev);
    hipDeviceGetAttribute(&cus, hipDeviceAttributeMultiprocessorCount, dev);
    hipOccupancyMaxActiveBlocksPerMultiprocessor(&per_cu, fwd_kernel, NTHREADS, LDS_TOTAL);
    if (per_cu < 1) { fprintf(stderr, "kernel_launch: occupancy 0\n"); return; }
    grid_blocks = cus;
  }
  P p{};
  const float** fp = (const float**)&p;
  for (int i = 0; i < 33; ++i) fp[i] = (const float*)d_in[i];
  p.out = (float*)d_out; p.ws = (char*)d_ws;
  (void)hipMemsetAsync((char*)d_ws + OFF_BAR, 0, XCD_BAR_WORDS * 4, stream);
  void* args[] = {&p};
  hipError_t e = hipLaunchCooperativeKernel((void*)fwd_kernel, dim3(grid_blocks), dim3(NTHREADS), args, LDS_TOTAL, stream);
  if (e != hipSuccess) fprintf(stderr, "cooperative launch failed: %s (grid %d)\n", hipGetErrorString(e), grid_blocks);
}
```

```cpp
#include <hip/hip_runtime.h>
#include <hip/hip_cooperative_groups.h>
#include <cstdio>
#include <cstdint>
namespace cg = cooperative_groups;

typedef unsigned short u16;
typedef short bf16x8 __attribute__((ext_vector_type(8)));
typedef short s16x4 __attribute__((ext_vector_type(4)));
typedef float f32x16 __attribute__((ext_vector_type(16)));
typedef float f32x4 __attribute__((ext_vector_type(4)));
typedef float f32x2 __attribute__((ext_vector_type(2)));
typedef unsigned u32x4 __attribute__((ext_vector_type(4)));
typedef unsigned u32x2 __attribute__((ext_vector_type(2)));
typedef __bf16 bf16x2_t __attribute__((ext_vector_type(2)));
#define DI __device__ __forceinline__
#define LAS __attribute__((address_space(3)))

constexpr int DM = 1024, NBATCH = 8, TLAT = 8192, NLAYER = 4, TCTX = 256;
constexpr int MLAT = NBATCH * TLAT, MCTX = NBATCH * TCTX, MTOT = MLAT + MCTX;
constexpr int PROJ_LD = 928, DFF = 2816;
constexpr float EPS = 1e-6f, LOG2E = 1.4426950408889634f;
constexpr int NTHREADS = 512;
constexpr int PITCH = 144;
constexpr int LDS_SCR = 2048;
constexpr int LDS_FRONT = 256;
constexpr int LDS_TOTAL = LDS_FRONT + LDS_SCR + 256 * 528;

constexpr size_t al256(size_t x) { return (x + 255) / 256 * 256; }
constexpr size_t OFF_CTXX = 0;
constexpr size_t OFF_MOD = OFF_CTXX + (size_t)MCTX * DM * 4;
constexpr size_t OFF_ROPE = OFF_MOD + al256((size_t)NLAYER * 9 * 6144 * 4);
constexpr size_t ROPE_COSA = 0, ROPE_SINA = (size_t)TLAT * 16 * 4, ROPE_COSS = 2 * ROPE_SINA, ROPE_SINS = ROPE_COSS + (size_t)TLAT * 32 * 4;
constexpr size_t OFF_S5PW = OFF_ROPE + 2 * (size_t)TLAT * 16 * 4 + 2 * (size_t)TLAT * 32 * 4;
constexpr size_t OFF_S5Q = OFF_S5PW + (size_t)NLAYER * 2 * 16 * 64 * 65 * 16;
constexpr size_t OFF_W = OFF_S5Q + (size_t)NLAYER * 2 * 16 * 64 * 16;
constexpr size_t W_IN = 0, W_OUT = W_IN + (size_t)1664 * 1024, W_UP = W_OUT + (size_t)1024 * 1024, W_DN = W_UP + (size_t)5632 * 1024,
                 W_UQ = W_DN + (size_t)1024 * 2816, W_UKV = W_UQ + (size_t)576 * 384, W_GLU = W_UKV + (size_t)768 * 256, W_LAYER = W_GLU + (size_t)256 * 256;
constexpr size_t OFF_S5T = OFF_W + (size_t)NLAYER * W_LAYER * 2;
constexpr size_t S5_KC = 0, S5_BST = S5_KC + (size_t)16 * 127 * 256, S5_MRD = S5_BST + (size_t)16 * 256 * 1024, S5_LAYER = S5_MRD + (size_t)16 * 1024 * 256;
constexpr size_t OFF_H = OFF_S5T + (size_t)NLAYER * S5_LAYER * 2;
constexpr size_t OFF_MIX = OFF_H + (size_t)MTOT * 1024 * 2;
constexpr size_t OFF_SST = OFF_MIX + (size_t)MTOT * 1024 * 2;
constexpr size_t OFF_HIN = OFF_SST + (size_t)1056 * 16 * 256 * 4;
constexpr size_t OFF_ZB = OFF_HIN + (size_t)1056 * 16 * 256 * 2;
constexpr size_t OFF_BIG = OFF_ZB + (size_t)MTOT * 256 * 2;
constexpr size_t OFF_PROJ = OFF_BIG;
constexpr size_t OFF_QM = OFF_PROJ + (size_t)MTOT * PROJ_LD * 2;
constexpr size_t OFF_KM = OFF_QM + (size_t)MTOT * 576 * 2;
constexpr size_t OFF_VM = OFF_KM + (size_t)MTOT * 576 * 2;
constexpr size_t OFF_QS = OFF_VM + (size_t)MTOT * 384 * 2;
constexpr size_t OFF_KS = OFF_QS + (size_t)MTOT * 384 * 2;
constexpr size_t OFF_VS = OFF_KS + (size_t)MTOT * 128 * 2;
constexpr size_t OFF_END1 = OFF_VS + (size_t)MTOT * 128 * 2;
constexpr size_t OFF_ACT = OFF_BIG;
constexpr size_t OFF_END2 = OFF_ACT + (size_t)MTOT * DFF * 2;
constexpr size_t OFF_ZERO = OFF_END1 > OFF_END2 ? OFF_END1 : OFF_END2;
constexpr size_t OFF_BAR = OFF_ZERO + 8192;
constexpr size_t WS_NEED = OFF_BAR + 16384;

struct P {
  const float *x, *c, *ctx, *c_ctx, *w_mod, *b_mod, *norm1, *w_in, *q_lora_g, *w_uq, *kv_lora_g, *w_ukv, *q_norm, *k_norm, *a_re, *a_im, *log_dt, *b_re, *b_im, *c_re,
      *c_im, *s5_d, *w_glu, *b_glu, *sq_norm, *sk_norm, *sink, *w_out, *norm2, *w_up, *conv_w, *conv_b, *w_down;
  float* out;
  char* ws;
};

DI unsigned pk2(float a, float b) { f32x2 v = {a, b}; bf16x2_t r = __builtin_convertvector(v, bf16x2_t); return __builtin_bit_cast(unsigned, r); }
DI float bflo(unsigned w) { return __uint_as_float(w << 16); }
DI float bfhi(unsigned w) { return __uint_as_float(w & 0xffff0000u); }
DI int otid() { int t = threadIdx.x; asm volatile("" : "+v"(t)); return t; }
DI int crow(int r, int hi) { return (r & 3) + 8 * (r >> 2) + 4 * hi; }
DI f32x16 mfma(bf16x8 a, bf16x8 b, f32x16 c) { return __builtin_amdgcn_mfma_f32_32x32x16_bf16(a, b, c, 0, 0, 0); }
DI float ex2(float x) { return __builtin_amdgcn_exp2f(x); }
DI float rcpf_(float x) { return __builtin_amdgcn_rcpf(x); }
DI float xsum32(float v) { auto rr = __builtin_amdgcn_permlane32_swap(__float_as_uint(v), __float_as_uint(v), false, false); return __uint_as_float(rr[0]) + __uint_as_float(rr[1]); }
DI float xmax32(float v) { auto rr = __builtin_amdgcn_permlane32_swap(__float_as_uint(v), __float_as_uint(v), false, false); return fmaxf(__uint_as_float(rr[0]), __uint_as_float(rr[1])); }
DI void st4(u16* p, float a, float b, float c, float d) { u32x2 w = {pk2(a, b), pk2(c, d)}; *(u32x2*)p = w; }
DI float silu_f(float g) { return g * rcpf_(1.f + ex2(-g * LOG2E)); }
DI float sigmoid_f(float g) { return rcpf_(1.f + ex2(-g * LOG2E)); }
DI float gelu_tanh(float x) { const float u = 0.7978845608028654f * (x + 0.044715f * x * x * x); const float th = 1.f - 2.f * rcpf_(1.f + ex2(2.f * LOG2E * u)); return 0.5f * x * (1.f + th); }
DI const float* xin(const P& p, int m) { return m < MLAT ? p.x + (size_t)m * DM : p.ctx + (size_t)(m - MLAT) * DM; }
DI float* xrow(const P& p, int m) { return m < MLAT ? p.out + (size_t)m * DM : (float*)(p.ws + OFF_CTXX) + (size_t)(m - MLAT) * DM; }
DI int modidx(int m) { return m < MLAT ? (m >> 13) : 8; }
DI const float* modv(const P& p, int l, int mi) { return (const float*)(p.ws + OFF_MOD) + ((size_t)l * 9 + mi) * 6144; }
DI size_t head_row(int m, int h, int H) {
  if (m < MLAT) return ((size_t)((m >> 13) * H + h) << 13) + (m & 8191);
  const int r = m - MLAT; return (size_t)NBATCH * H * TLAT + (size_t)((r >> 8) * H + h) * TCTX + (r & 255);
}
DI u16* wl(const P& p, int l) { return (u16*)(p.ws + OFF_W) + (size_t)l * W_LAYER; }
DI u16* s5t(const P& p, int l) { return (u16*)(p.ws + OFF_S5T) + (size_t)l * S5_LAYER; }
DI int s5_tokbase(int row) { return row < 1024 ? (row >> 7) * TLAT + (row & 127) * 64 : MLAT + ((row - 1024) >> 2) * TCTX + ((row - 1024) & 3) * 64; }

DI int tile_steps(int MT, int NT, int RM, int RN) {
  if (gridDim.x == 256) { const int SM = (MT + RM - 1) / RM, SN = (NT + RN - 1) / RN; return (SM * SN + 7) >> 3; }
  return (MT * NT + gridDim.x - 1) / gridDim.x;
}
DI bool tile_get(int s, int MT, int NT, int RM, int RN, int& mt, int& nt) {
  if (gridDim.x == 256) {
    const int xcd = blockIdx.x & 7, slot = blockIdx.x >> 3; const int SM = (MT + RM - 1) / RM, SN = (NT + RN - 1) / RN;
    const int st = s * 8 + xcd; if (st >= SM * SN) return false;
    mt = (st / SN) * RM + slot % RM; nt = (st % SN) * RN + slot / RM;
    return mt < MT && nt < NT;
  }
  const int it = s * gridDim.x + blockIdx.x; if (it >= MT * NT) return false;
  mt = it / NT; nt = it % NT; return true;
}

struct LdRows {
  const u16* p[4];
  DI u32x4 load(int j, int kc) const { return *(const u32x4*)(p[j] + (size_t)kc * 8); }
};
struct LdS5A {
  const u16* pu[4]; const u16* ph[4];
  DI u32x4 load(int j, int kc) const {
    const u16* q = kc < 128 ? pu[j] + (size_t)(kc >> 1) * PROJ_LD + (kc & 1) * 8 : ph[j] + (kc - 128) * 8;
    return *(const u32x4*)q;
  }
};
struct LdS5B {
  const u16* pk[2]; const u16* pm[2];
  DI u32x4 load(int j, int kc) const {
    const u16* q = kc < 128 ? pk[j] - (kc >> 1) * 256 + (kc & 1) * 8 : pm[j] + (kc - 128) * 8;
    return *(const u32x4*)q;
  }
};

template <int NA, int NB, class AL, class BL>
DI void gemm_issue(int tid, const AL& al, const BL& bl, int nk, u32x4 (&ra0)[NA], u32x4 (&rb0)[NB], u32x4 (&ra1)[NA], u32x4 (&rb1)[NB]) {
  const int lc = tid & 7, k1 = nk > 1 ? 1 : 0;
#pragma unroll
  for (int j = 0; j < NA; ++j) ra0[j] = al.load(j, lc);
#pragma unroll
  for (int j = 0; j < NB; ++j) rb0[j] = bl.load(j, lc);
#pragma unroll
  for (int j = 0; j < NA; ++j) ra1[j] = al.load(j, k1 * 8 + lc);
#pragma unroll
  for (int j = 0; j < NB; ++j) rb1[j] = bl.load(j, k1 * 8 + lc);
}
template <int WM, int WN, int TM, int TN, bool SW = false, class AL, class BL>
DI void gemm_run(int tid, char* lds, const AL& al, const BL& bl, int nk, f32x16 (&acc)[TM][TN], u32x4 (&ra0)[WM * TM / 2], u32x4 (&rb0)[WN * TN / 2], u32x4 (&ra1)[WM * TM / 2], u32x4 (&rb1)[WN * TN / 2]) {
  constexpr int BM = WM * TM * 32, BN = WN * TN * 32, NA = BM / 64, NB = BN / 64;
  constexpr int AB = BM * PITCH, STAGE = (BM + BN) * PITCH;
  const int lane = tid & 63, wid = tid >> 6, r32 = lane & 31, hi = lane >> 5;
  const int wm = wid / WN, wn = wid % WN, lr = tid >> 3, lc = tid & 7;
  char* const wa = lds + lr * PITCH + lc * 16;
  const int aoff = (wm * TM * 32 + r32) * PITCH + hi * 16;
  const int boff = AB + (wn * TN * 32 + r32) * PITCH + hi * 16;
#define GLOAD(RA, RB, KT) do { const int kc_ = (KT) * 8 + lc; _Pragma("unroll") for (int j = 0; j < NA; ++j) RA[j] = al.load(j, kc_); _Pragma("unroll") for (int j = 0; j < NB; ++j) RB[j] = bl.load(j, kc_); } while (0)
#define LWRITE(RA, RB, BUF) do { char* w_ = wa + (BUF) * STAGE; _Pragma("unroll") for (int j = 0; j < NA; ++j) *(u32x4*)(w_ + j * 64 * PITCH) = RA[j]; _Pragma("unroll") for (int j = 0; j < NB; ++j) *(u32x4*)(w_ + AB + j * 64 * PITCH) = RB[j]; } while (0)
#define COMPUTE(BUF, RA, RB, WBUF) do { const char* sb = lds + (BUF) * STAGE; char* w_ = wa + (WBUF) * STAGE; _Pragma("unroll") for (int ks = 0; ks < 4; ++ks) { bf16x8 wf[TN], xf[TM]; \
    _Pragma("unroll") for (int tn = 0; tn < TN; ++tn) wf[tn] = *(const bf16x8*)(sb + boff + tn * 32 * PITCH + ks * 32); \
    _Pragma("unroll") for (int tm = 0; tm < TM; ++tm) xf[tm] = *(const bf16x8*)(sb + aoff + tm * 32 * PITCH + ks * 32); \
    _Pragma("unroll") for (int tm = 0; tm < TM; ++tm) _Pragma("unroll") for (int tn = 0; tn < TN; ++tn) acc[tm][tn] = SW ? mfma(xf[tm], wf[tn], acc[tm][tn]) : mfma(wf[tn], xf[tm], acc[tm][tn]); \
    _Pragma("unroll") for (int j = 0; j < NA; ++j) if (1 + j % 3 == ks) *(u32x4*)(w_ + j * 64 * PITCH) = RA[j]; \
    _Pragma("unroll") for (int j = 0; j < NB; ++j) if (1 + (NA + j) % 3 == ks) *(u32x4*)(w_ + AB + j * 64 * PITCH) = RB[j]; } } while (0)
  const int kl = nk - 1;
  LWRITE(ra0, rb0, 0);
  __syncthreads();
#pragma unroll 1
  for (int kt = 0; kt < nk; kt += 2) {
    GLOAD(ra0, rb0, (kt + 2 < kl ? kt + 2 : kl));
    COMPUTE(0, ra1, rb1, 1);
    __syncthreads();
    if (kt + 1 >= nk) break;
    GLOAD(ra1, rb1, (kt + 3 < kl ? kt + 3 : kl));
    COMPUTE(1, ra0, rb0, 0);
    __syncthreads();
  }
#undef GLOAD
#undef LWRITE
#undef COMPUTE
}
template <int WM, int WN, int TM, int TN, bool SW = false, class AL, class BL>
DI void gemm_main(int tid, char* lds, const AL& al, const BL& bl, int nk, f32x16 (&acc)[TM][TN]) {
  constexpr int NA = WM * TM / 2, NB = WN * TN / 2;
  u32x4 ra0[NA], rb0[NB], ra1[NA], rb1[NB];
  gemm_issue<NA, NB>(tid, al, bl, nk, ra0, rb0, ra1, rb1);
  gemm_run<WM, WN, TM, TN, SW>(tid, lds, al, bl, nk, acc, ra0, rb0, ra1, rb1);
}
template <bool SW, class AL, class BL>
DI void gemm_run16(int tid, char* lds, const AL& al, const BL& bl, int nk, f32x4 (&acc)[4][4], u32x4 (&ra0)[4], u32x4 (&rb0)[2], u32x4 (&ra1)[4], u32x4 (&rb1)[2]) {
  constexpr int NA = 4, NB = 2, RB_ = 128, AB = 256 * RB_, STAGE = 384 * RB_;
  const int lane = tid & 63, wid = tid >> 6, l15 = lane & 15, g = lane >> 4;
  const int wm = wid >> 1, wn = wid & 1, lr = tid >> 3, lc = tid & 7;
  char* const wa = lds + lr * RB_ + ((lc ^ ((lr >> 1) & 7)) << 4);
  const int o0 = (g ^ ((lane >> 1) & 7)) << 4, o1 = o0 ^ 64;
  const int aoff = (wm * 64 + l15) * RB_, boff = AB + (wn * 64 + l15) * RB_;
#define GLOAD(RA, RB, KT) do { const int kc_ = (KT) * 8 + lc; _Pragma("unroll") for (int j = 0; j < NA; ++j) RA[j] = al.load(j, kc_); _Pragma("unroll") for (int j = 0; j < NB; ++j) RB[j] = bl.load(j, kc_); } while (0)
#define LWRITE(RA, RB, BUF) do { char* w_ = wa + (BUF) * STAGE; _Pragma("unroll") for (int j = 0; j < NA; ++j) *(u32x4*)(w_ + j * 64 * RB_) = RA[j]; _Pragma("unroll") for (int j = 0; j < NB; ++j) *(u32x4*)(w_ + AB + j * 64 * RB_) = RB[j]; } while (0)
#define KSTEP(OFF) do { bf16x8 wf[4], xf[4]; \
    _Pragma("unroll") for (int t = 0; t < 4; ++t) { wf[t] = *(const bf16x8*)(sb + boff + t * 16 * RB_ + (OFF)); xf[t] = *(const bf16x8*)(sb + aoff + t * 16 * RB_ + (OFF)); } \
    _Pragma("unroll") for (int tm = 0; tm < 4; ++tm) _Pragma("unroll") for (int tn = 0; tn < 4; ++tn) \
      acc[tm][tn] = SW ? __builtin_amdgcn_mfma_f32_16x16x32_bf16(xf[tm], wf[tn], acc[tm][tn], 0, 0, 0) : __builtin_amdgcn_mfma_f32_16x16x32_bf16(wf[tn], xf[tm], acc[tm][tn], 0, 0, 0); } while (0)
#define COMPUTE(BUF, RA, RB, WBUF) do { const char* sb = lds + (BUF) * STAGE; char* w_ = wa + (WBUF) * STAGE; \
    KSTEP(o0); *(u32x4*)(w_) = RA[0]; *(u32x4*)(w_ + 64 * RB_) = RA[1]; *(u32x4*)(w_ + 128 * RB_) = RA[2]; \
    KSTEP(o1); *(u32x4*)(w_ + 192 * RB_) = RA[3]; *(u32x4*)(w_ + AB) = RB[0]; *(u32x4*)(w_ + AB + 64 * RB_) = RB[1]; } while (0)
  const int kl = nk - 1;
  LWRITE(ra0, rb0, 0);
  __syncthreads();
#pragma unroll 1
  for (int kt = 0; kt < nk; kt += 2) {
    GLOAD(ra0, rb0, (kt + 2 < kl ? kt + 2 : kl));
    COMPUTE(0, ra1, rb1, 1);
    __syncthreads();
    if (kt + 1 >= nk) break;
    GLOAD(ra1, rb1, (kt + 3 < kl ? kt + 3 : kl));
    COMPUTE(1, ra0, rb0, 0);
    __syncthreads();
  }
#undef GLOAD
#undef LWRITE
#undef KSTEP
#undef COMPUTE
}
DI int tile_next(int s, int ns, int MT, int NT, int RM, int RN, int& mt, int& nt) {
  for (; s < ns; ++s) if (tile_get(s, MT, NT, RM, RN, mt, nt)) return s;
  return -1;
}
template <int TM, int TN> DI void zero_acc(f32x16 (&acc)[TM][TN]) {
#pragma unroll
  for (int a = 0; a < TM; ++a)
#pragma unroll
    for (int b = 0; b < TN; ++b)
#pragma unroll
      for (int r = 0; r < 16; ++r) acc[a][b][r] = 0.f;
}

struct dc { double re, im; };
DI dc cmul(dc a, dc b) { return {a.re * b.re - a.im * b.im, a.re * b.im + a.im * b.re}; }

static __device__ __forceinline__ void phase_pre(const P& p) {
  const int gt = blockIdx.x * NTHREADS + threadIdx.x;
  if (gt < 512) ((u32x4*)(p.ws + OFF_ZERO))[gt] = u32x4{0, 0, 0, 0};
  if (gt < NLAYER * 2 * 16 * 64) {
    const int ldg = gt >> 6;
    const double lre = p.a_re[gt], lim = p.a_im[gt];
    const double dt = exp((double)p.log_dt[ldg]);
    double s, c; sincos(lim * dt, &s, &c);
    const double e = exp(lre * dt);
    const dc a = {e * c, e * s};
    const double den = lre * lre + lim * lim;
    const dc am1 = {a.re - 1.0, a.im};
    const dc q = {(am1.re * lre + am1.im * lim) / den, (am1.im * lre - am1.re * lim) / den};
    dc* pw = (dc*)(p.ws + OFF_S5PW) + (size_t)gt * 65;
    dc r = {1.0, 0.0};
    for (int k = 0; k <= 64; ++k) { pw[k] = r; r = cmul(r, a); }
    ((dc*)(p.ws + OFF_S5Q))[gt] = q;
  }
}

DI int nmap_in(int n) { return n < 640 ? n : (n < 1536 ? n + 32 : n - 896); }
DI int nmap_up(int n) { const int q = n >> 6, r = n & 63; return r < 32 ? 32 * q + r : DFF + 32 * q + (r - 32); }

static __device__ __forceinline__ void transpose_tile(const float* src, int ldsrc, int K, int Nd, int nmap, const float* kscale, u16* dst, int kt, int ntile, char* lds) {
  float* tile = (float*)lds;
  const int tid = threadIdx.x;
  __syncthreads();
  {
    const int n = tid & 63, kk = tid >> 6;
    const int nd = ntile * 64 + n;
    const int ns = nmap == 1 ? nmap_in(nd) : (nmap == 2 ? nmap_up(nd) : nd);
#pragma unroll
    for (int j = 0; j < 8; ++j) {
      const int k = kk + 8 * j, kg = kt * 64 + k;
      float v = 0.f;
      if (nd < Nd) { v = src[(size_t)kg * ldsrc + ns]; if (kscale) v *= kscale[kg]; }
      tile[k * 65 + n] = v;
    }
  }
  __syncthreads();
  {
    const int n = tid >> 3, kc = tid & 7, nd = ntile * 64 + n;
    if (nd < Nd) {
      const float* t = tile + (kc * 8) * 65 + n;
      u32x4 w = {pk2(t[0], t[65]), pk2(t[130], t[195]), pk2(t[260], t[325]), pk2(t[390], t[455])};
      *(u32x4*)(dst + (size_t)nd * K + kt * 64 + kc * 8) = w;
    }
  }
}

static __device__ __forceinline__ void mod_item(const P& p, int it, char* lds) {
  const int l = it / 96, n0 = (it % 96) * 64, tid = threadIdx.x;
  float* sv = (float*)lds;
  float* red = sv + 9 * 1024;
  __syncthreads();
  for (int i = tid; i < 9 * 1024; i += NTHREADS) { const int j = i >> 10, k = i & 1023; const float v = j < 8 ? p.c[j * 1024 + k] : p.c_ctx[k]; sv[i] = v / (1.f + expf(-v)); }
  __syncthreads();
  const int c = tid & 63, kg = tid >> 6;
  float acc[9];
#pragma unroll
  for (int j = 0; j < 9; ++j) acc[j] = 0.f;
  const float* w = p.w_mod + ((size_t)l * 1024 + kg * 128) * 6144 + n0 + c;
  for (int kk = 0; kk < 128; ++kk) {
    const float wv = w[(size_t)kk * 6144];
#pragma unroll
    for (int j = 0; j < 9; ++j) acc[j] += sv[j * 1024 + kg * 128 + kk] * wv;
  }
#pragma unroll
  for (int j = 0; j < 9; ++j) red[(kg * 9 + j) * 64 + c] = acc[j];
  __syncthreads();
  for (int q = tid; q < 576; q += NTHREADS) {
    const int j = q >> 6, cc = q & 63; float s = 0.f;
#pragma unroll
    for (int g = 0; g < 8; ++g) s += red[(g * 9 + j) * 64 + cc];
    ((float*)(p.ws + OFF_MOD))[((size_t)l * 9 + j) * 6144 + n0 + cc] = s + p.b_mod[l * 6144 + n0 + cc];
  }
}

static __device__ __forceinline__ void phase0(const P& p, char* lds) {
  constexpr int NMOD = 384, TPL = 2886;
  for (int it = blockIdx.x; it < NMOD + NLAYER * TPL; it += gridDim.x) {
    if (it < NMOD) { mod_item(p, it, lds); continue; }
    const int u = it - NMOD, l = u / TPL, r = u % TPL;
    u16* W = wl(p, l);
    if (r < 400) transpose_tile(p.w_in + (size_t)l * 1024 * 1568, 1568, 1024, 1568, 1, nullptr, W + W_IN, r / 25, r % 25, lds);
    else if (r < 656) { const int q = r - 400; transpose_tile(p.w_out + (size_t)l * 1024 * 1024, 1024, 1024, 1024, 0, nullptr, W + W_OUT, q / 16, q % 16, lds); }
    else if (r < 2064) { const int q = r - 656; transpose_tile(p.w_up + (size_t)l * 1024 * 5632, 5632, 1024, 5632, 2, nullptr, W + W_UP, q / 88, q % 88, lds); }
    else if (r < 2768) { const int q = r - 2064; transpose_tile(p.w_down + (size_t)l * 2816 * 1024, 1024, 2816, 1024, 0, nullptr, W + W_DN, q / 16, q % 16, lds); }
    else if (r < 2822) { const int q = r - 2768; transpose_tile(p.w_uq + (size_t)l * 384 * 576, 576, 384, 576, 0, p.q_lora_g + l * 384, W + W_UQ, q / 9, q % 9, lds); }
    else if (r < 2870) { const int q = r - 2822; transpose_tile(p.w_ukv + (size_t)l * 256 * 768, 768, 256, 768, 0, p.kv_lora_g + l * 256, W + W_UKV, q / 12, q % 12, lds); }
    else { const int q = r - 2870; transpose_tile(p.w_glu + (size_t)l * 256 * 256, 256, 256, 256, 0, nullptr, W + W_GLU, q / 4, q % 4, lds); }
  }
  const size_t gt = (size_t)blockIdx.x * NTHREADS + threadIdx.x, gn = (size_t)gridDim.x * NTHREADS;
  for (size_t i = gt; i < (size_t)TLAT * 48; i += gn) {
    const int t = (int)(i / 48), j = (int)(i % 48);
    const int row = t >> 6, col = t & 63;
    int pos; double ex; float* cd; float* sd;
    if (j < 16) { const int f = j & 7; pos = j < 8 ? row : col; ex = -(double)f / 8.0; cd = (float*)(p.ws + OFF_ROPE + ROPE_COSA) + t * 16 + j; sd = (float*)(p.ws + OFF_ROPE + ROPE_SINA) + t * 16 + j; }
    else { const int jj = j - 16, f = jj & 15; pos = jj < 16 ? row : col; ex = -(double)f / 16.0; cd = (float*)(p.ws + OFF_ROPE + ROPE_COSS) + t * 32 + jj; sd = (float*)(p.ws + OFF_ROPE + ROPE_SINS) + t * 32 + jj; }
    const float inv = (float)exp(ex * 9.210340371976184);
    const float ang = (float)pos * inv;
    double s, c; sincos((double)ang, &s, &c);
    *cd = (float)c; *sd = (float)s;
  }
  const dc* PW = (const dc*)(p.ws + OFF_S5PW); const dc* QQ = (const dc*)(p.ws + OFF_S5Q);
  for (size_t i = gt; i < (size_t)NLAYER * 16 * 127 * 16; i += gn) {
    const int ii = (int)(i & 15); const int rest = (int)(i >> 4); const int dd = rest % 127, lg = rest / 127, g = lg & 15, l = lg >> 4;
    const int d = dd - 63;
    double acc[16];
#pragma unroll
    for (int o = 0; o < 16; ++o) acc[o] = 0.0;
    for (int dir = 0; dir < 2; ++dir) {
      if ((dir == 0 && d < 0) || (dir == 1 && d > 0)) continue;
      const int base = ((l * 2 + dir) * 16 + g) * 64; const int ad = d < 0 ? -d : d;
      const float* cr = p.c_re + (size_t)((l * 2 + dir) * 16 + g) * 16 * 64; const float* ci_ = p.c_im + (size_t)((l * 2 + dir) * 16 + g) * 16 * 64;
      for (int pp = 0; pp < 64; ++pp) {
        const dc a = PW[(size_t)(base + pp) * 65 + ad], q = QQ[base + pp];
        const size_t bi = (size_t)(base + pp) * 16 + ii; const dc B = {(double)p.b_re[bi], (double)p.b_im[bi]};
        const dc t1 = cmul(cmul(a, q), B);
#pragma unroll
        for (int o = 0; o < 16; ++o) acc[o] += (double)cr[o * 64 + pp] * t1.re - (double)ci_[o * 64 + pp] * t1.im;
      }
    }
    if (d == 0) acc[ii] += (double)p.s5_d[l * 256 + g * 16 + ii];
    u16* dst = s5t(p, l) + S5_KC + (size_t)(g * 127 + dd) * 256 + ii;
#pragma unroll
    for (int o = 0; o < 16; ++o) dst[o * 16] = (u16)(pk2((float)acc[o], 0.f) & 0xffff);
  }
  for (size_t i = gt; i < (size_t)NLAYER * 16 * 256 * 1024; i += gn) {
    const int k = (int)(i & 1023), n = (int)((i >> 10) & 255), g = (int)((i >> 18) & 15), l = (int)(i >> 22);
    const int dir = n >> 7, pp = (n >> 1) & 63, reim = n & 1, s = k >> 4, ii = k & 15;
    const int base = ((l * 2 + dir) * 16 + g) * 64 + pp; const int e = dir == 0 ? 63 - s : s;
    const size_t bi = (size_t)base * 16 + ii; const dc B = {(double)p.b_re[bi], (double)p.b_im[bi]};
    const dc v = cmul(cmul(PW[(size_t)base * 65 + e], QQ[base]), B);
    (s5t(p, l) + S5_BST)[((size_t)g * 256 + n) * 1024 + k] = (u16)(pk2((float)(reim ? v.im : v.re), 0.f) & 0xffff);
  }
  for (size_t i = gt; i < (size_t)NLAYER * 16 * 1024 * 256; i += gn) {
    const int k = (int)(i & 255), n = (int)((i >> 8) & 1023), g = (int)((i >> 18) & 15), l = (int)(i >> 22);
    const int dir = k >> 7, pp = (k >> 1) & 63, reim = k & 1, t = n >> 4, o = n & 15;
    const int base = ((l * 2 + dir) * 16 + g) * 64 + pp; const int e = dir == 0 ? t + 1 : 64 - t;
    const size_t ci = ((size_t)(((l * 2 + dir) * 16 + g) * 16 + o)) * 64 + pp; const dc C = {(double)p.c_re[ci], (double)p.c_im[ci]};
    const dc v = cmul(C, PW[(size_t)base * 65 + e]);
    (s5t(p, l) + S5_MRD)[((size_t)g * 1024 + n) * 256 + k] = (u16)(pk2((float)(reim ? -v.im : v.re), 0.f) & 0xffff);
  }
}

static __device__ __forceinline__ void phase_norm(const P& p, int l, int which) {
  const int tid = otid(), lane = tid & 63, wid = tid >> 6;
  const float* gw = (which ? p.norm2 : p.norm1) + l * 1024;
  u16* H = (u16*)(p.ws + OFF_H);
  const int mend = (which == 1 && l == NLAYER - 1) ? MLAT : MTOT;
  const bool first = l == 0 && which == 0;
  f32x4 gq[4];
#pragma unroll
  for (int j = 0; j < 4; ++j) gq[j] = *(const f32x4*)(gw + j * 256 + lane * 4);
  for (int m0 = blockIdx.x * 8 + wid; m0 < mend; m0 += gridDim.x * 16) {
    const int m1 = m0 + gridDim.x * 8; const bool has1 = m1 < mend; const int m1c = has1 ? m1 : m0;
    const float* xr0 = first ? xin(p, m0) : xrow(p, m0); const float* xr1 = first ? xin(p, m1c) : xrow(p, m1c);
    const float* mv0 = modv(p, l, modidx(m0)) + which * 3072; const float* mv1 = modv(p, l, modidx(m1c)) + which * 3072;
    f32x4 v0[4], v1[4], sh0[4], sc0[4], sh1[4], sc1[4];
#pragma unroll
    for (int j = 0; j < 4; ++j) { v0[j] = *(const f32x4*)(xr0 + j * 256 + lane * 4); v1[j] = *(const f32x4*)(xr1 + j * 256 + lane * 4); }
#pragma unroll
    for (int j = 0; j < 4; ++j) { const int c = j * 256 + lane * 4; sh0[j] = *(const f32x4*)(mv0 + c); sc0[j] = *(const f32x4*)(mv0 + 1024 + c); sh1[j] = *(const f32x4*)(mv1 + c); sc1[j] = *(const f32x4*)(mv1 + 1024 + c); }
    float s0 = 0.f, s1 = 0.f;
#pragma unroll
    for (int j = 0; j < 4; ++j)
#pragma unroll
      for (int e = 0; e < 4; ++e) { s0 += v0[j][e] * v0[j][e]; s1 += v1[j][e] * v1[j][e]; }
#pragma unroll
    for (int o = 32; o > 0; o >>= 1) { s0 += __shfl_xor(s0, o); s1 += __shfl_xor(s1, o); }
    const float r0 = rsqrtf(s0 * (1.f / 1024.f) + EPS), r1 = rsqrtf(s1 * (1.f / 1024.f) + EPS);
#pragma unroll
    for (int j = 0; j < 4; ++j) {
      const int c = j * 256 + lane * 4;
      float o[4];
#pragma unroll
      for (int e = 0; e < 4; ++e) o[e] = v0[j][e] * r0 * gq[j][e] * (1.f + sc0[j][e]) + sh0[j][e];
      st4(H + (size_t)m0 * 1024 + c, o[0], o[1], o[2], o[3]);
    }
    if (has1) {
#pragma unroll
      for (int j = 0; j < 4; ++j) {
        const int c = j * 256 + lane * 4;
        float o[4];
#pragma unroll
        for (int e = 0; e < 4; ++e) o[e] = v1[j][e] * r1 * gq[j][e] * (1.f + sc1[j][e]) + sh1[j][e];
        st4(H + (size_t)m1 * 1024 + c, o[0], o[1], o[2], o[3]);
      }
    }
  }
}

static __device__ __forceinline__ void phase_inproj(const P& p, int l, char* lds) {
  const int tid = otid(), lane = tid & 63, wid = tid >> 6, r32 = lane & 31, hi = lane >> 5, wm = wid >> 1, wn = wid & 1, lr = tid >> 3;
  const u16* H = (const u16*)(p.ws + OFF_H); const u16* W = wl(p, l) + W_IN;
  u16* proj = (u16*)(p.ws + OFF_PROJ);
  const float* cosS = (const float*)(p.ws + OFF_ROPE + ROPE_COSS); const float* sinS = (const float*)(p.ws + OFF_ROPE + ROPE_SINS);
  const int ns = tile_steps(264, 12, 16, 2);
  u32x4 ra0[4], rb0[2], ra1[4], rb1[2];
  LdRows al, bl; int mt, nt;
  auto mk = [&](int mt_, int nt_, LdRows& a_, LdRows& b_) {
#pragma unroll
    for (int j = 0; j < 4; ++j) a_.p[j] = H + (size_t)(mt_ * 256 + lr + 64 * j) * 1024;
#pragma unroll
    for (int j = 0; j < 2; ++j) b_.p[j] = W + (size_t)(nt_ * 128 + lr + 64 * j) * 1024;
    b_.p[2] = b_.p[3] = b_.p[0];
  };
  int s = tile_next(0, ns, 264, 12, 16, 2, mt, nt);
  if (s >= 0) { mk(mt, nt, al, bl); gemm_issue<4, 2>(tid, al, bl, 16, ra0, rb0, ra1, rb1); }
  while (s >= 0) {
    f32x4 acc[4][4];
#pragma unroll
    for (int a_ = 0; a_ < 4; ++a_)
#pragma unroll
      for (int b_ = 0; b_ < 4; ++b_) acc[a_][b_] = f32x4{0.f, 0.f, 0.f, 0.f};
    __syncthreads();
    gemm_run16<false>(tid, lds + LDS_SCR, al, bl, 16, acc, ra0, rb0, ra1, rb1);
    int mt2 = 0, nt2 = 0; const int s2 = tile_next(s + 1, ns, 264, 12, 16, 2, mt2, nt2);
    if (s2 >= 0) { mk(mt2, nt2, al, bl); gemm_issue<4, 2>(tid, al, bl, 16, ra0, rb0, ra1, rb1); }
    const int n0w = nt * 128 + wn * 64, mw = mt * 256 + wm * 64, l15 = lane & 15, g4 = (lane >> 4) * 4;
    if (n0w < 896) {
#pragma unroll
      for (int tm = 0; tm < 4; ++tm) {
        u16* dst = proj + (size_t)(mw + 16 * tm + l15) * PROJ_LD + n0w + g4;
#pragma unroll
        for (int tn = 0; tn < 4; ++tn) st4(dst + 16 * tn, acc[tm][tn][0], acc[tm][tn][1], acc[tm][tn][2], acc[tm][tn][3]);
      }
    } else if (n0w < 1408) {
      const bool isq = n0w < 1280; const int head = isq ? (n0w - 896) >> 6 : (n0w - 1280) >> 6;
      const float* gn = (isq ? p.sq_norm : p.sk_norm) + l * 64;
      u16* dbase = (u16*)(p.ws + (isq ? OFF_QS : OFF_KS));
      const float osc = isq ? 0.125f * LOG2E : 1.f;
      f32x4 g1q[2], g2q[2];
#pragma unroll
      for (int tn = 0; tn < 2; ++tn) { g1q[tn] = *(const f32x4*)(gn + 16 * tn + g4); g2q[tn] = *(const f32x4*)(gn + 32 + 16 * tn + g4); }
#pragma unroll
      for (int hf = 0; hf < 2; ++hf) {
        f32x4 csq[2][2], snq[2][2]; float rsq[2];
#pragma unroll
        for (int t2 = 0; t2 < 2; ++t2) {
          const int tm = 2 * hf + t2, m = mw + 16 * tm + l15; const bool lat = m < MLAT; const int t = m & 8191;
#pragma unroll
          for (int tn = 0; tn < 2; ++tn) {
            csq[t2][tn] = f32x4{1.f, 1.f, 1.f, 1.f}; snq[t2][tn] = f32x4{0.f, 0.f, 0.f, 0.f};
            if (lat) { csq[t2][tn] = *(const f32x4*)(cosS + t * 32 + 16 * tn + g4); snq[t2][tn] = *(const f32x4*)(sinS + t * 32 + 16 * tn + g4); }
          }
          float ss = 0.f;
#pragma unroll
          for (int tn = 0; tn < 4; ++tn)
#pragma unroll
            for (int e = 0; e < 4; ++e) ss += acc[tm][tn][e] * acc[tm][tn][e];
          ss += __shfl_xor(ss, 16); ss = xsum32(ss);
          rsq[t2] = rsqrtf(ss * (1.f / 64.f) + EPS);
        }
#pragma unroll
        for (int t2 = 0; t2 < 2; ++t2) {
          const int tm = 2 * hf + t2, m = mw + 16 * tm + l15;
          u16* dst = dbase + head_row(m, head, isq ? 6 : 2) * 64 + g4;
#pragma unroll
          for (int tn = 0; tn < 2; ++tn) {
            float y1[4], y2[4];
#pragma unroll
            for (int e = 0; e < 4; ++e) {
              const float x1 = acc[tm][tn][e] * rsq[t2] * g1q[tn][e], x2 = acc[tm][tn + 2][e] * rsq[t2] * g2q[tn][e];
              y1[e] = (x1 * csq[t2][tn][e] - x2 * snq[t2][tn][e]) * osc; y2[e] = (x1 * snq[t2][tn][e] + x2 * csq[t2][tn][e]) * osc;
            }
            st4(dst + 16 * tn, y1[0], y1[1], y1[2], y1[3]); st4(dst + 32 + 16 * tn, y2[0], y2[1], y2[2], y2[3]);
          }
        }
      }
    } else if (n0w < 1536) {
      const int head = (n0w - 1408) >> 6;
      u16* dbase = (u16*)(p.ws + OFF_VS);
#pragma unroll
      for (int tm = 0; tm < 4; ++tm) {
        u16* dst = dbase + head_row(mw + 16 * tm + l15, head, 2) * 64 + g4;
#pragma unroll
        for (int tn = 0; tn < 4; ++tn) st4(dst + 16 * tn, acc[tm][tn][0], acc[tm][tn][1], acc[tm][tn][2], acc[tm][tn][3]);
      }
    }
    s = s2; mt = mt2; nt = nt2;
  }
  for (int it = blockIdx.x; it < 264; it += gridDim.x) {
    LdRows a2, b2;
#pragma unroll
    for (int j = 0; j < 4; ++j) a2.p[j] = H + (size_t)(it * 256 + lr + 64 * j) * 1024;
    b2.p[0] = W + (size_t)(1536 + (lr < 32 ? lr : 31)) * 1024; b2.p[1] = b2.p[2] = b2.p[3] = b2.p[0];
    f32x16 acc2[1][2]; zero_acc(acc2);
    __syncthreads();
    gemm_main<8, 1, 1, 2>(tid, lds + LDS_SCR, a2, b2, 16, acc2);
    u16* dst = proj + (size_t)(it * 256 + wid * 32 + r32) * PROJ_LD + 896;
#pragma unroll
    for (int rg = 0; rg < 4; ++rg) st4(dst + 8 * rg + 4 * hi, acc2[0][0][4 * rg], acc2[0][0][4 * rg + 1], acc2[0][0][4 * rg + 2], acc2[0][0][4 * rg + 3]);
  }
}

template <int NCOLS>
DI void lora_rstd(int tid, const u16* proj, int m0, int col0, float* scr) {
  constexpr int NCH = NCOLS / 64;
  const int sub = tid & 7, rs = tid >> 3;
  u32x4 w[4][NCH];
#pragma unroll
  for (int j = 0; j < 4; ++j) {
    const u16* src = proj + (size_t)(m0 + rs + 64 * j) * PROJ_LD + col0 + sub * 8;
#pragma unroll
    for (int c = 0; c < NCH; ++c) w[j][c] = *(const u32x4*)(src + c * 64);
  }
#pragma unroll
  for (int j = 0; j < 4; ++j) {
    float ss = 0.f;
#pragma unroll
    for (int c = 0; c < NCH; ++c)
#pragma unroll
      for (int e = 0; e < 4; ++e) { const float a = bflo(w[j][c][e]), b = bfhi(w[j][c][e]); ss += a * a + b * b; }
    ss += __shfl_xor(ss, 1); ss += __shfl_xor(ss, 2); ss += __shfl_xor(ss, 4);
    if (sub == 0) scr[rs + 64 * j] = rsqrtf(ss * (1.f / (float)NCOLS) + EPS);
  }
}

static __device__ __forceinline__ void phase_mla_prep(const P& p, int l, char* lds) {
  const int tid = otid(), lane = tid & 63, wid = tid >> 6, r32 = lane & 31, hi = lane >> 5, lr = tid >> 3;
  const u16* proj = (const u16*)(p.ws + OFF_PROJ);
  float* scr = (float*)lds;
  const float* cosA = (const float*)(p.ws + OFF_ROPE + ROPE_COSA); const float* sinA = (const float*)(p.ws + OFF_ROPE + ROPE_SINA);
  {
    const u16* W = wl(p, l) + W_UQ; const float* g = p.q_norm + l * 96; u16* Qm = (u16*)(p.ws + OFF_QM);
    const int wm = wid >> 1, wn = wid & 1;
    const float osc = 0.10206207261596577f * LOG2E;
    for (int s = 0, ns = tile_steps(264, 3, 32, 1); s < ns; ++s) {
      int mt, nt; if (!tile_get(s, 264, 3, 32, 1, mt, nt)) continue;
      const int m0 = mt * 256;
      __syncthreads();
      lora_rstd<384>(tid, proj, m0, 0, scr);
      LdRows al, bl;
#pragma unroll
      for (int j = 0; j < 4; ++j) al.p[j] = proj + (size_t)(m0 + lr + 64 * j) * PROJ_LD;
#pragma unroll
      for (int j = 0; j < 3; ++j) bl.p[j] = W + (size_t)(nt * 192 + lr + 64 * j) * 384;
      bl.p[3] = bl.p[0];
      f32x16 acc[2][3]; zero_acc(acc);
      gemm_main<4, 2, 2, 3>(tid, lds + LDS_SCR, al, bl, 6, acc);
      const int head = nt * 2 + wn;
#pragma unroll
      for (int tm = 0; tm < 2; ++tm) {
        const int rl = wm * 64 + 32 * tm + r32, m = m0 + rl;
        const float rlo = scr[rl];
        float ss = 0.f;
#pragma unroll
        for (int tn = 0; tn < 3; ++tn)
#pragma unroll
          for (int r = 0; r < 16; ++r) ss += acc[tm][tn][r] * acc[tm][tn][r];
        ss = xsum32(ss);
        const float f = rlo * rsqrtf(rlo * rlo * ss * (1.f / 96.f) + EPS);
        u16* dst = Qm + head_row(m, head, 6) * 96;
        const bool lat = m < MLAT; const int t = m & 8191;
        f32x4 gq[2][4], r1q[2], r2q[2], csq[2], snq[2];
#pragma unroll
        for (int tn = 0; tn < 2; ++tn)
#pragma unroll
          for (int rg = 0; rg < 4; ++rg) gq[tn][rg] = *(const f32x4*)(g + 32 * tn + 8 * rg + 4 * hi);
#pragma unroll
        for (int rg = 0; rg < 2; ++rg) {
          const int j = 8 * rg + 4 * hi; r1q[rg] = *(const f32x4*)(g + 64 + j); r2q[rg] = *(const f32x4*)(g + 80 + j);
          csq[rg] = f32x4{1.f, 1.f, 1.f, 1.f}; snq[rg] = f32x4{0.f, 0.f, 0.f, 0.f};
          if (lat) { csq[rg] = *(const f32x4*)(cosA + t * 16 + j); snq[rg] = *(const f32x4*)(sinA + t * 16 + j); }
        }
#pragma unroll
        for (int tn = 0; tn < 2; ++tn)
#pragma unroll
          for (int rg = 0; rg < 4; ++rg) {
            const int d = 32 * tn + 8 * rg + 4 * hi; const f32x4 gv = gq[tn][rg];
            st4(dst + d, acc[tm][tn][4 * rg] * f * gv[0] * osc, acc[tm][tn][4 * rg + 1] * f * gv[1] * osc, acc[tm][tn][4 * rg + 2] * f * gv[2] * osc, acc[tm][tn][4 * rg + 3] * f * gv[3] * osc);
          }
#pragma unroll
        for (int rg = 0; rg < 2; ++rg) {
          const int j = 8 * rg + 4 * hi; const f32x4 g1 = r1q[rg], g2 = r2q[rg], cs = csq[rg], sn = snq[rg];
          float y1[4], y2[4];
#pragma unroll
          for (int e = 0; e < 4; ++e) {
            const float x1 = acc[tm][2][4 * rg + e] * f * g1[e], x2 = acc[tm][2][8 + 4 * rg + e] * f * g2[e];
            y1[e] = (x1 * cs[e] - x2 * sn[e]) * osc; y2[e] = (x1 * sn[e] + x2 * cs[e]) * osc;
          }
          st4(dst + 64 + j, y1[0], y1[1], y1[2], y1[3]); st4(dst + 80 + j, y2[0], y2[1], y2[2], y2[3]);
        }
      }
    }
  }
  {
    const u16* W = wl(p, l) + W_UKV; const float* g = p.k_norm + l * 96; u16* Km = (u16*)(p.ws + OFF_KM); u16* Vm = (u16*)(p.ws + OFF_VM);
    for (int s = 0, ns = tile_steps(264, 6, 16, 2); s < ns; ++s) {
      int mt, head; if (!tile_get(s, 264, 6, 16, 2, mt, head)) continue;
      const int m0 = mt * 256;
      __syncthreads();
      lora_rstd<256>(tid, proj, m0, 384, scr);
      LdRows al, bl;
#pragma unroll
      for (int j = 0; j < 4; ++j) al.p[j] = proj + (size_t)(m0 + lr + 64 * j) * PROJ_LD + 384;
#pragma unroll
      for (int j = 0; j < 2; ++j) bl.p[j] = W + (size_t)(head * 128 + lr + 64 * j) * 256;
      bl.p[2] = bl.p[3] = bl.p[0];
      f32x16 acc[1][4]; zero_acc(acc);
      gemm_main<8, 1, 1, 4>(tid, lds + LDS_SCR, al, bl, 4, acc);
      const int rl = wid * 32 + r32, m = m0 + rl;
      const float rlo = scr[rl];
      float ssr = 0.f; u32x4 wx1, wx2;
      {
        const u16* kp = proj + (size_t)m * PROJ_LD + 896;
        const u32x4 w0 = *(const u32x4*)(kp), w1 = *(const u32x4*)(kp + 8), w2 = *(const u32x4*)(kp + 16), w3 = *(const u32x4*)(kp + 24);
#pragma unroll
        for (int e = 0; e < 4; ++e) {
          ssr += bflo(w0[e]) * bflo(w0[e]) + bfhi(w0[e]) * bfhi(w0[e]) + bflo(w1[e]) * bflo(w1[e]) + bfhi(w1[e]) * bfhi(w1[e]);
          ssr += bflo(w2[e]) * bflo(w2[e]) + bfhi(w2[e]) * bfhi(w2[e]) + bflo(w3[e]) * bflo(w3[e]) + bfhi(w3[e]) * bfhi(w3[e]);
        }
        wx1 = hi ? w1 : w0; wx2 = hi ? w3 : w2;
      }
      float ss = 0.f;
#pragma unroll
      for (int tn = 0; tn < 2; ++tn)
#pragma unroll
        for (int r = 0; r < 16; ++r) ss += acc[0][tn][r] * acc[0][tn][r];
      ss = xsum32(ss);
      const float rk = rsqrtf((rlo * rlo * ss + ssr) * (1.f / 96.f) + EPS);
      const size_t hr = head_row(m, head, 6);
      u16* kd = Km + hr * 96; u16* vd = Vm + hr * 64;
      const bool lat = m < MLAT; const int t = m & 8191;
      f32x4 gq[2][4]; float gr1[8], gr2[8], csr[8], snr[8];
#pragma unroll
      for (int tn = 0; tn < 2; ++tn)
#pragma unroll
        for (int rg = 0; rg < 4; ++rg) gq[tn][rg] = *(const f32x4*)(g + 32 * tn + 8 * rg + 4 * hi);
#pragma unroll
      for (int e = 0; e < 8; ++e) {
        const int j = 8 * hi + e; gr1[e] = g[64 + j]; gr2[e] = g[80 + j]; csr[e] = 1.f; snr[e] = 0.f;
        if (lat) { csr[e] = cosA[t * 16 + j]; snr[e] = sinA[t * 16 + j]; }
      }
#pragma unroll
      for (int tn = 0; tn < 2; ++tn)
#pragma unroll
        for (int rg = 0; rg < 4; ++rg) {
          const int d = 32 * tn + 8 * rg + 4 * hi; const f32x4 gv = gq[tn][rg]; const float f = rlo * rk;
          st4(kd + d, acc[0][tn][4 * rg] * f * gv[0], acc[0][tn][4 * rg + 1] * f * gv[1], acc[0][tn][4 * rg + 2] * f * gv[2], acc[0][tn][4 * rg + 3] * f * gv[3]);
          st4(vd + d, acc[0][2 + tn][4 * rg] * rlo, acc[0][2 + tn][4 * rg + 1] * rlo, acc[0][2 + tn][4 * rg + 2] * rlo, acc[0][2 + tn][4 * rg + 3] * rlo);
        }
      {
        float y1[8], y2[8];
#pragma unroll
        for (int e = 0; e < 8; ++e) {
          const int j = 8 * hi + e;
          const float k1 = (e & 1) ? bfhi(wx1[e >> 1]) : bflo(wx1[e >> 1]), k2 = (e & 1) ? bfhi(wx2[e >> 1]) : bflo(wx2[e >> 1]);
          const float x1 = k1 * rk * gr1[e], x2 = k2 * rk * gr2[e];
          const float cs = csr[e], sn = snr[e];
          y1[e] = x1 * cs - x2 * sn; y2[e] = x1 * sn + x2 * cs;
        }
        u32x4 w1 = {pk2(y1[0], y1[1]), pk2(y1[2], y1[3]), pk2(y1[4], y1[5]), pk2(y1[6], y1[7])};
        u32x4 w2 = {pk2(y2[0], y2[1]), pk2(y2[2], y2[3]), pk2(y2[4], y2[5]), pk2(y2[6], y2[7])};
        *(u32x4*)(kd + 64 + 8 * hi) = w1; *(u32x4*)(kd + 80 + 8 * hi) = w2;
      }
    }
  }
}

static __device__ __forceinline__ void phase_s5_states(const P& p, int l, char* lds) {
  const int tid = otid(), lane = tid & 63, wid = tid >> 6, r32 = lane & 31, hi = lane >> 5, wm = wid >> 1, wn = wid & 1, lr = tid >> 3;
  const u16* proj = (const u16*)(p.ws + OFF_PROJ); float* Sst = (float*)(p.ws + OFF_SST);
  for (int it = blockIdx.x; it < 160; it += gridDim.x) {
    const int g = it / 10, r = it % 10, mt = r >> 1, nt = r & 1;
    LdS5A al; LdRows bl;
#pragma unroll
    for (int j = 0; j < 4; ++j) { const int row = mt * 256 + lr + 64 * j; al.pu[j] = proj + (size_t)s5_tokbase(row < 1056 ? row : 0) * PROJ_LD + 640 + g * 16; al.ph[j] = al.pu[j]; }
    const u16* B = s5t(p, l) + S5_BST + (size_t)g * 256 * 1024;
#pragma unroll
    for (int j = 0; j < 2; ++j) bl.p[j] = B + (size_t)(nt * 128 + lr + 64 * j) * 1024;
    bl.p[2] = bl.p[3] = bl.p[0];
    f32x16 acc[2][2]; zero_acc(acc);
    __syncthreads();
    gemm_main<4, 2, 2, 2>(tid, lds + LDS_SCR, al, bl, 16, acc);
#pragma unroll
    for (int tm = 0; tm < 2; ++tm) {
      const int row = mt * 256 + wm * 64 + 32 * tm + r32;
      if (row < 1056) {
        float* dst = Sst + ((size_t)row * 16 + g) * 256 + nt * 128 + wn * 64;
#pragma unroll
        for (int tn = 0; tn < 2; ++tn)
#pragma unroll
          for (int rg = 0; rg < 4; ++rg) { f32x4 v = {acc[tm][tn][4 * rg], acc[tm][tn][4 * rg + 1], acc[tm][tn][4 * rg + 2], acc[tm][tn][4 * rg + 3]}; *(f32x4*)(dst + 32 * tn + 8 * rg + 4 * hi) = v; }
      }
    }
  }
}

static __device__ __forceinline__ void s5_scan_item(const P& p, int l, int blk) {
  const int gt = blk * NTHREADS + otid();
  const int pp = gt & 63, dir = (gt >> 6) & 1, g = (gt >> 7) & 15, b = gt >> 11;
  const dc a64d = ((const dc*)(p.ws + OFF_S5PW))[(size_t)((((l * 2 + dir) * 16 + g) * 64) + pp) * 65 + 64];
  const float ar = (float)a64d.re, ai = (float)a64d.im;
  const float* Sst = (const float*)(p.ws + OFF_SST); unsigned* Hin = (unsigned*)(p.ws + OFF_HIN);
  const int col = g * 256 + dir * 128 + 2 * pp;
  float hr = 0.f, hi_ = 0.f;
#pragma unroll 1
  for (int s0 = 0; s0 < 132; s0 += 4) {
    int rows[4]; f32x2 sv[4];
#pragma unroll
    for (int e = 0; e < 4; ++e) {
      const int st = s0 + e; int row;
      if (st < 4) { const int c = dir ? 3 - st : st; row = 1024 + b * 4 + c; } else { const int s2 = st - 4; const int c = dir ? 127 - s2 : s2; row = b * 128 + c; }
      rows[e] = row; sv[e] = *(const f32x2*)(Sst + (size_t)row * 4096 + col);
    }
#pragma unroll
    for (int e = 0; e < 4; ++e) {
      Hin[((size_t)rows[e] * 4096 + col) >> 1] = pk2(hr, hi_);
      const float nr = ar * hr - ai * hi_ + sv[e][0], ni = ar * hi_ + ai * hr + sv[e][1];
      hr = nr; hi_ = ni;
    }
  }
}

static __device__ __forceinline__ void phase_s5_out(const P& p, int l, char* lds) {
  const int tid = otid(), lane = tid & 63, wid = tid >> 6, r32 = lane & 31, hi = lane >> 5, wm = wid >> 1, wn = wid & 1, lr = tid >> 3;
  const u16* proj = (const u16*)(p.ws + OFF_PROJ); const u16* Hin = (const u16*)(p.ws + OFF_HIN); u16* zb = (u16*)(p.ws + OFF_ZB);
  const int per_g = l == NLAYER - 1 ? 32 : 40;
  for (int it = blockIdx.x; it < 16 * per_g; it += gridDim.x) {
    const int g = it / per_g, r = it % per_g, mt = r >> 3, nt = r & 7;
    LdS5A al; LdS5B bl;
#pragma unroll
    for (int j = 0; j < 4; ++j) {
      const int row = mt * 256 + lr + 64 * j;
      al.pu[j] = proj + (size_t)s5_tokbase(row < 1056 ? row : 0) * PROJ_LD + 640 + g * 16;
      al.ph[j] = Hin + ((size_t)(row < 1056 ? row : 0) * 16 + g) * 256;
    }
    const u16* Kc = s5t(p, l) + S5_KC + (size_t)g * 127 * 256; const u16* Mrd = s5t(p, l) + S5_MRD + (size_t)g * 1024 * 256;
#pragma unroll
    for (int j = 0; j < 2; ++j) { const int n = nt * 128 + lr + 64 * j; bl.pk[j] = Kc + ((n >> 4) + 63) * 256 + (n & 15) * 16; bl.pm[j] = Mrd + (size_t)n * 256; }
    f32x16 acc[2][2]; zero_acc(acc);
    __syncthreads();
    gemm_main<4, 2, 2, 2>(tid, lds + LDS_SCR, al, bl, 20, acc);
#pragma unroll
    for (int tm = 0; tm < 2; ++tm) {
      const int row = mt * 256 + wm * 64 + 32 * tm + r32;
      if (row < 1056) {
        const int tb = s5_tokbase(row);
#pragma unroll
        for (int tn = 0; tn < 2; ++tn)
#pragma unroll
          for (int rg = 0; rg < 4; ++rg) {
            const int n = nt * 128 + wn * 64 + 32 * tn + 8 * rg + 4 * hi;
            u16* dst = zb + (size_t)(tb + (n >> 4)) * 256 + g * 16 + (n & 15);
            st4(dst, gelu_tanh(acc[tm][tn][4 * rg]), gelu_tanh(acc[tm][tn][4 * rg + 1]), gelu_tanh(acc[tm][tn][4 * rg + 2]), gelu_tanh(acc[tm][tn][4 * rg + 3]));
          }
      }
    }
  }
}

static __device__ __forceinline__ void phase_glu(const P& p, int l, char* lds) {
  const int tid = otid(), lane = tid & 63, wid = tid >> 6, r32 = lane & 31, hi = lane >> 5, wm = wid >> 1, wn = wid & 1, lr = tid >> 3;
  const u16* zb = (const u16*)(p.ws + OFF_ZB); const u16* W = wl(p, l) + W_GLU; u16* mix = (u16*)(p.ws + OFF_MIX); const float* bg = p.b_glu + l * 256;
  const int MT = l == NLAYER - 1 ? 256 : 264;
  for (int s = 0, ns = tile_steps(MT, 2, 16, 2); s < ns; ++s) {
    int mt, nt; if (!tile_get(s, MT, 2, 16, 2, mt, nt)) continue;
    LdRows al, bl;
#pragma unroll
    for (int j = 0; j < 4; ++j) al.p[j] = zb + (size_t)(mt * 256 + lr + 64 * j) * 256;
#pragma unroll
    for (int j = 0; j < 2; ++j) bl.p[j] = W + (size_t)(nt * 128 + lr + 64 * j) * 256;
    bl.p[2] = bl.p[3] = bl.p[0];
    f32x16 acc[2][2]; zero_acc(acc);
    __syncthreads();
    gemm_main<4, 2, 2, 2>(tid, lds + LDS_SCR, al, bl, 4, acc);
    u32x2 zq[2][2][4]; f32x4 bq[2][4];
#pragma unroll
    for (int tn = 0; tn < 2; ++tn)
#pragma unroll
      for (int rg = 0; rg < 4; ++rg) {
        const int n = nt * 128 + wn * 64 + 32 * tn + 8 * rg + 4 * hi; bq[tn][rg] = *(const f32x4*)(bg + n);
#pragma unroll
        for (int tm = 0; tm < 2; ++tm) zq[tm][tn][rg] = *(const u32x2*)(zb + (size_t)(mt * 256 + wm * 64 + 32 * tm + r32) * 256 + n);
      }
#pragma unroll
    for (int tm = 0; tm < 2; ++tm) {
      const int m = mt * 256 + wm * 64 + 32 * tm + r32;
#pragma unroll
      for (int tn = 0; tn < 2; ++tn)
#pragma unroll
        for (int rg = 0; rg < 4; ++rg) {
          const int n = nt * 128 + wn * 64 + 32 * tn + 8 * rg + 4 * hi;
          const u32x2 zw = zq[tm][tn][rg]; const f32x4 bv = bq[tn][rg];
          const float z0 = bflo(zw[0]), z1 = bfhi(zw[0]), z2 = bflo(zw[1]), z3 = bfhi(zw[1]);
          st4(mix + (size_t)m * 1024 + 384 + n, z0 * sigmoid_f(acc[tm][tn][4 * rg] + bv[0]), z1 * sigmoid_f(acc[tm][tn][4 * rg + 1] + bv[1]), z2 * sigmoid_f(acc[tm][tn][4 * rg + 2] + bv[2]),
              z3 * sigmoid_f(acc[tm][tn][4 * rg + 3] + bv[3]));
        }
    }
  }
}

template <int DQK>
DI void attn_unit(int tid, char* lds, const u16* Qp, const u16* K1, const u16* V1, int nt1, int kpos0, const u16* K2, const u16* V2, int nt2, int qpos0, bool mask, float m_init, float l_init, u16* Op) {
  constexpr int KP = DQK * 2 + 16, KB = 64 * KP, VB = 8192, SB = KB + VB, NCH = DQK / 8, NKC = 64 * NCH, ND = DQK / 16;
  const int lane = tid & 63, wid = tid >> 6, r32 = lane & 31, hi = lane >> 5;
  bf16x8 qr[ND];
  {
    const u16* qrow = Qp + (size_t)(wid * 32 + r32) * DQK + hi * 8;
#pragma unroll
    for (int d0 = 0; d0 < ND; ++d0) qr[d0] = *(const bf16x8*)(qrow + d0 * 16);
  }
  const int kk0 = tid / NCH, kc0 = tid % NCH;
  const int id1 = tid + NTHREADS; const bool has1 = id1 < NKC; const int kk1 = id1 / NCH, kc1 = id1 % NCH;
  const int idl = has1 ? id1 : tid;
  const int vkey = tid >> 3, vc = tid & 7;
  const int vst = ((vkey >> 3) * 2 + (vc >> 2)) * 512 + (vkey & 7) * 64 + (vc & 3) * 16;
  const int vrb = ((lane & 3) << 3) | (((lane >> 2) & 3) << 6) | (((lane >> 4) & 1) << 5) | (((lane >> 5) & 1) << 8);
  const int kw0 = kk0 * KP + kc0 * 16, kw1 = kk1 * KP + kc1 * 16, kro = r32 * KP + hi * 16;
  f32x16 o0, o1;
#pragma unroll
  for (int r = 0; r < 16; ++r) { o0[r] = 0.f; o1[r] = 0.f; }
  constexpr float THR = 8.f;
  float mrun = m_init, lrun = hi == 0 ? l_init : 0.f;
  f32x16 negm;
#pragma unroll
  for (int r = 0; r < 16; ++r) negm[r] = -mrun;
  const int NT = nt1 + nt2;
  const int qpos = qpos0 + wid * 32 + r32;
  u32x4 sk0, sk1, sv;
  auto gl = [&](int i) {
    const u16* kp; const u16* vp;
    if (i < nt1) { kp = K1 + (size_t)i * 64 * DQK; vp = V1 + (size_t)i * 4096; } else { kp = K2 + (size_t)(i - nt1) * 64 * DQK; vp = V2 + (size_t)(i - nt1) * 4096; }
    sk0 = *(const u32x4*)(kp + (size_t)tid * 8); sk1 = *(const u32x4*)(kp + (size_t)idl * 8); sv = *(const u32x4*)(vp + (size_t)tid * 8);
  };
  auto sw = [&](int st) {
    char* b = lds + st * SB;
    *(u32x4*)(b + kw0) = sk0; if (has1) *(u32x4*)(b + kw1) = sk1; *(u32x4*)(b + KB + vst) = sv;
  };
  auto qk = [&](int st, f32x16& p0, f32x16& p1) {
    const char* Kb = lds + st * SB + kro;
#pragma unroll
    for (int d0 = 0; d0 < ND; ++d0) {
      const bf16x8 a0 = *(const bf16x8*)(Kb + d0 * 32);
      const bf16x8 a1 = *(const bf16x8*)(Kb + 32 * KP + d0 * 32);
      if (d0 == 0) { p0 = mfma(a0, qr[0], negm); p1 = mfma(a1, qr[0], negm); } else { p0 = mfma(a0, qr[d0], p0); p1 = mfma(a1, qr[d0], p1); }
    }
  };
  const int qw0 = qpos0 + wid * 32;
  auto live = [&](int i) { if (!mask || i >= nt1) return true; const int kb = kpos0 + i * 64; return kb + 63 >= qw0 - 128 && kb <= qw0 + 31 + 128; };
  auto step = [&](f32x16& c0, f32x16& c1, f32x16& n0, f32x16& n1, int i, int s_cur, int s_nxt, int s_wr) {
    const bool has_nxt = i + 1 < NT, has_wr = i + 2 < NT;
    if (has_wr) gl(i + 2);
    if (has_nxt && live(i + 1)) qk(s_nxt, n0, n1);
    if (live(i)) {
    if (mask && i < nt1) {
      const int kb = kpos0 + i * 64 - qpos;
#pragma unroll
      for (int r = 0; r < 16; ++r) {
        const int d0_ = kb + crow(r, hi), d1_ = d0_ + 32;
        if (d0_ > 128 || d0_ < -128) c0[r] = -1e30f;
        if (d1_ > 128 || d1_ < -128) c1[r] = -1e30f;
      }
    }
    float mt = c0[0];
#pragma unroll
    for (int r = 1; r < 16; ++r) mt = fmaxf(mt, c0[r]);
#pragma unroll
    for (int r = 0; r < 16; ++r) mt = fmaxf(mt, c1[r]);
    mt = xmax32(mt);
    if (__any(mt > THR)) {
      const float delta = fmaxf(mt, 0.f), alpha = ex2(-delta);
      mrun += delta; lrun *= alpha;
#pragma unroll
      for (int r = 0; r < 16; ++r) { o0[r] *= alpha; o1[r] *= alpha; c0[r] -= delta; c1[r] -= delta; n0[r] -= delta; n1[r] -= delta; negm[r] = -mrun; }
    }
    float ls = 0.f;
#pragma unroll
    for (int r = 0; r < 16; ++r) { c0[r] = ex2(c0[r]); c1[r] = ex2(c1[r]); ls += c0[r] + c1[r]; }
    lrun += ls;
    bf16x8 pb[4];
    { u32x4 w = {pk2(c0[0], c0[1]), pk2(c0[2], c0[3]), pk2(c0[4], c0[5]), pk2(c0[6], c0[7])}; pb[0] = __builtin_bit_cast(bf16x8, w); }
    { u32x4 w = {pk2(c0[8], c0[9]), pk2(c0[10], c0[11]), pk2(c0[12], c0[13]), pk2(c0[14], c0[15])}; pb[1] = __builtin_bit_cast(bf16x8, w); }
    { u32x4 w = {pk2(c1[0], c1[1]), pk2(c1[2], c1[3]), pk2(c1[4], c1[5]), pk2(c1[6], c1[7])}; pb[2] = __builtin_bit_cast(bf16x8, w); }
    { u32x4 w = {pk2(c1[8], c1[9]), pk2(c1[10], c1[11]), pk2(c1[12], c1[13]), pk2(c1[14], c1[15])}; pb[3] = __builtin_bit_cast(bf16x8, w); }
    LAS char* Vb = (LAS char*)(lds + s_cur * SB + KB + vrb);
#pragma unroll
    for (int ks = 0; ks < 4; ++ks) {
      const s16x4 l0 = __builtin_amdgcn_ds_read_tr16_b64_v4i16((LAS s16x4*)(Vb + ((2 * ks) * 2 + 0) * 512));
      const s16x4 h0 = __builtin_amdgcn_ds_read_tr16_b64_v4i16((LAS s16x4*)(Vb + ((2 * ks + 1) * 2 + 0) * 512));
      const s16x4 l1 = __builtin_amdgcn_ds_read_tr16_b64_v4i16((LAS s16x4*)(Vb + ((2 * ks) * 2 + 1) * 512));
      const s16x4 h1 = __builtin_amdgcn_ds_read_tr16_b64_v4i16((LAS s16x4*)(Vb + ((2 * ks + 1) * 2 + 1) * 512));
      const bf16x8 va0 = {l0[0], l0[1], l0[2], l0[3], h0[0], h0[1], h0[2], h0[3]};
      const bf16x8 va1 = {l1[0], l1[1], l1[2], l1[3], h1[0], h1[1], h1[2], h1[3]};
      o0 = mfma(va0, pb[ks], o0); o1 = mfma(va1, pb[ks], o1);
    }
    }
    if (has_wr) sw(s_wr);
    __syncthreads();
  };
  gl(0); sw(0);
  if (NT > 1) { gl(1); sw(1); }
  __syncthreads();
  f32x16 pA0, pA1, pB0, pB1;
#pragma unroll
  for (int r = 0; r < 16; ++r) { pB0[r] = 0.f; pB1[r] = 0.f; }
  if (live(0)) qk(0, pA0, pA1);
  int s_cur = 0, s_nxt = 1, s_wr = 2;
#pragma unroll 1
  for (int i = 0; i < NT; i += 2) {
    step(pA0, pA1, pB0, pB1, i, s_cur, s_nxt, s_wr);
    if (i + 1 >= NT) break;
    step(pB0, pB1, pA0, pA1, i + 1, s_nxt, s_wr, s_cur);
    const int t_ = s_cur; s_cur = s_wr; s_wr = s_nxt; s_nxt = t_;
  }
  const float inv = rcpf_(xsum32(lrun));
  u16* orow = Op + (size_t)(wid * 32 + r32) * 1024;
#pragma unroll
  for (int rg = 0; rg < 4; ++rg) {
    st4(orow + 8 * rg + 4 * hi, o0[4 * rg] * inv, o0[4 * rg + 1] * inv, o0[4 * rg + 2] * inv, o0[4 * rg + 3] * inv);
    st4(orow + 32 + 8 * rg + 4 * hi, o1[4 * rg] * inv, o1[4 * rg + 1] * inv, o1[4 * rg + 2] * inv, o1[4 * rg + 3] * inv);
  }
}

static __device__ __forceinline__ void phase_attn(const P& p, int l, char* lds) {
  if (blockIdx.x < 32) s5_scan_item(p, l, blockIdx.x);
  const int tid = otid();
  const u16* Qm = (const u16*)(p.ws + OFF_QM); const u16* Km = (const u16*)(p.ws + OFF_KM); const u16* Vm = (const u16*)(p.ws + OFF_VM);
  const u16* Qs = (const u16*)(p.ws + OFF_QS); const u16* Ks = (const u16*)(p.ws + OFF_KS); const u16* Vs = (const u16*)(p.ws + OFF_VS);
  u16* mix = (u16*)(p.ws + OFF_MIX);
  constexpr size_t CTX6 = (size_t)NBATCH * 6 * TLAT, CTX2 = (size_t)NBATCH * 2 * TLAT;
  const int nunits = l == NLAYER - 1 ? 3072 : 3168;
  for (int it = blockIdx.x; it < nunits; it += gridDim.x) {
    __syncthreads();
    if (it < 3072) {
      const int u = it < 1536 ? it : it - 1536;
      const int rr = u >> 8, bb = u & 255, bh = rr * 8 + (bb & 7), qb = bb >> 3, b = bh / 6, h = bh % 6, q0 = qb * 256;
      if (it < 1536) {
        const size_t r0 = (size_t)bh * TLAT, c0 = CTX6 + (size_t)bh * TCTX;
        attn_unit<96>(tid, lds, Qm + (r0 + q0) * 96, Km + r0 * 96, Vm + r0 * 64, 128, 0, Km + c0 * 96, Vm + c0 * 64, 4, q0, false, 0.f, 0.f, mix + (size_t)(b * TLAT + q0) * 1024 + h * 64);
      } else {
        const int kvh = h / 3, lo = q0 - 128 < 0 ? 0 : q0 - 128, hi_ = q0 + 384 > TLAT ? TLAT : q0 + 384;
        const size_t r0 = (size_t)(b * 2 + kvh) * TLAT, c0 = CTX2 + (size_t)(b * 2 + kvh) * TCTX;
        attn_unit<64>(tid, lds, Qs + ((size_t)bh * TLAT + q0) * 64, Ks + (r0 + lo) * 64, Vs + (r0 + lo) * 64, (hi_ - lo) >> 6, lo, Ks + c0 * 64, Vs + c0 * 64, 4, q0, true, p.sink[l * 6 + h] * LOG2E, 1.f,
                      mix + (size_t)(b * TLAT + q0) * 1024 + 640 + h * 64);
      }
    } else {
      const int u = it - 3072, ty = u / 48, bh = u % 48, b = bh / 6, h = bh % 6;
      if (ty == 0) {
        const size_t c0 = CTX6 + (size_t)bh * TCTX;
        attn_unit<96>(tid, lds, Qm + c0 * 96, Km + c0 * 96, Vm + c0 * 64, 4, 0, Km, Vm, 0, 0, false, 0.f, 0.f, mix + (size_t)(MLAT + b * TCTX) * 1024 + h * 64);
      } else {
        const int kvh = h / 3; const size_t c0 = CTX2 + (size_t)(b * 2 + kvh) * TCTX;
        attn_unit<64>(tid, lds, Qs + (CTX6 + (size_t)bh * TCTX) * 64, Ks + c0 * 64, Vs + c0 * 64, 4, 0, Ks, Vs, 0, 0, false, p.sink[l * 6 + h] * LOG2E, 1.f, mix + (size_t)(MLAT + b * TCTX) * 1024 + 640 + h * 64);
      }
    }
  }
}

static __device__ __forceinline__ void phase_resid_gemm(const P& p, int l, const u16* A, const u16* W, int ldk, int gate_off, char* lds, bool from_input = false) {
  const int tid = otid(), lane = tid & 63, wid = tid >> 6, r32 = lane & 31, hi = lane >> 5, wm = wid >> 1, wn = wid & 1, lr = tid >> 3;
  const int MT = l == NLAYER - 1 ? 256 : 264;
  const int ns = tile_steps(MT, 8, 4, 8), nk = ldk >> 6;
  u32x4 ra0[4], rb0[2], ra1[4], rb1[2];
  LdRows al, bl; int mt, nt;
  auto mk = [&](int mt_, int nt_, LdRows& a_, LdRows& b_) {
#pragma unroll
    for (int j = 0; j < 4; ++j) a_.p[j] = A + (size_t)(mt_ * 256 + lr + 64 * j) * ldk;
#pragma unroll
    for (int j = 0; j < 2; ++j) b_.p[j] = W + (size_t)(nt_ * 128 + lr + 64 * j) * ldk;
    b_.p[2] = b_.p[3] = b_.p[0];
  };
  int s = tile_next(0, ns, MT, 8, 4, 8, mt, nt);
  if (s >= 0) { mk(mt, nt, al, bl); gemm_issue<4, 2>(tid, al, bl, nk, ra0, rb0, ra1, rb1); }
  while (s >= 0) {
    f32x16 acc[2][2]; zero_acc(acc);
    __syncthreads();
    gemm_run<4, 2, 2, 2, true>(tid, lds + LDS_SCR, al, bl, nk, acc, ra0, rb0, ra1, rb1);
    int mt2 = 0, nt2 = 0; const int s2 = tile_next(s + 1, ns, MT, 8, 4, 8, mt2, nt2);
    if (s2 >= 0) { mk(mt2, nt2, al, bl); gemm_issue<4, 2>(tid, al, bl, nk, ra0, rb0, ra1, rb1); }
    float* xb = xrow(p, mt * 256); const float* gv = modv(p, l, modidx(mt * 256)) + gate_off;
#pragma unroll
    for (int tn = 0; tn < 2; ++tn) {
      const int n = nt * 128 + wn * 64 + 32 * tn + r32; const float g = gv[n];
      float* xp = xb + (size_t)(wm * 64 + 4 * hi) * DM + n;
      const float* xs = (from_input ? xin(p, mt * 256) : (const float*)xb) + (size_t)(wm * 64 + 4 * hi) * DM + n;
      float xv[2][16];
#pragma unroll
      for (int tm = 0; tm < 2; ++tm)
#pragma unroll
        for (int r = 0; r < 16; ++r) xv[tm][r] = xs[(size_t)(32 * tm + (r & 3) + 8 * (r >> 2)) * DM];
#pragma unroll
      for (int tm = 0; tm < 2; ++tm)
#pragma unroll
        for (int r = 0; r < 16; ++r) xp[(size_t)(32 * tm + (r & 3) + 8 * (r >> 2)) * DM] = xv[tm][r] + g * acc[tm][tn][r];
    }
    s = s2; mt = mt2; nt = nt2;
  }
}

static __device__ __forceinline__ void phase_ffn_up(const P& p, int l, char* lds) {
  const int tid = otid(), lane = tid & 63, wid = tid >> 6, r32 = lane & 31, hi = lane >> 5, wm = wid >> 1, wn = wid & 1, lr = tid >> 3;
  const u16* H = (const u16*)(p.ws + OFF_H); const u16* W = wl(p, l) + W_UP; u16* act = (u16*)(p.ws + OFF_ACT);
  const float* cw = p.conv_w + (size_t)l * 3 * 5632; const float* cb = p.conv_b + (size_t)l * 5632;
  char* tile = lds + LDS_SCR;
  const int MEND = l == NLAYER - 1 ? MLAT : MTOT;
  const int RT = (MEND + 253) / 254;
  const int ns = tile_steps(RT, 44, 8, 4);
  u32x4 ra0[4], rb0[2], ra1[4], rb1[2];
  LdRows al, bl; int rt, nt;
  auto mk = [&](int rt_, int nt_, LdRows& a_, LdRows& b_) {
    const int ts_ = 254 * rt_ - 1;
#pragma unroll
    for (int j = 0; j < 4; ++j) { const int tt = ts_ + lr + 64 * j; a_.p[j] = (tt >= 0 && tt < MTOT) ? H + (size_t)tt * 1024 : (const u16*)(p.ws + OFF_ZERO); }
#pragma unroll
    for (int j = 0; j < 2; ++j) b_.p[j] = W + (size_t)(nt_ * 128 + lr + 64 * j) * 1024;
    b_.p[2] = b_.p[3] = b_.p[0];
  };
  int s = tile_next(0, ns, RT, 44, 8, 4, rt, nt);
  if (s >= 0) { mk(rt, nt, al, bl); gemm_issue<4, 2>(tid, al, bl, 16, ra0, rb0, ra1, rb1); }
  while (s >= 0) {
    const int tstart = 254 * rt - 1;
    f32x4 acc[4][4];
#pragma unroll
    for (int a_ = 0; a_ < 4; ++a_)
#pragma unroll
      for (int b_ = 0; b_ < 4; ++b_) acc[a_][b_] = f32x4{0.f, 0.f, 0.f, 0.f};
    __syncthreads();
    gemm_run16<false>(tid, lds + LDS_SCR, al, bl, 16, acc, ra0, rb0, ra1, rb1);
    int rt2 = 0, nt2 = 0; const int s2 = tile_next(s + 1, ns, RT, 44, 8, 4, rt2, nt2);
    if (s2 >= 0) { mk(rt2, nt2, al, bl); gemm_issue<4, 2>(tid, al, bl, 16, ra0, rb0, ra1, rb1); }
#pragma unroll
    for (int tm = 0; tm < 4; ++tm) {
      char* trow = tile + (wm * 64 + 16 * tm + (lane & 15)) * 528 + (wn * 64 + 4 * (lane >> 4)) * 4;
#pragma unroll
      for (int tn = 0; tn < 4; ++tn) *(f32x4*)(trow + 64 * tn) = acc[tm][tn];
    }
    __syncthreads();
    {
      const int cgp = tid & 7, wn2 = cgp >> 2, j0 = (cgp & 3) * 8;
      const int ca0 = nt * 64 + wn2 * 32 + j0;
      const int lca = (wn2 * 64 + j0) * 4, lcg = lca + 128;
      float wa0[8], wa1[8], wa2[8], ba[8], wg0[8], wg1[8], wg2[8], bg[8];
#pragma unroll
      for (int e = 0; e < 8; ++e) {
        wa0[e] = cw[ca0 + e]; wa1[e] = cw[5632 + ca0 + e]; wa2[e] = cw[2 * 5632 + ca0 + e]; ba[e] = cb[ca0 + e];
        wg0[e] = cw[DFF + ca0 + e]; wg1[e] = cw[5632 + DFF + ca0 + e]; wg2[e] = cw[2 * 5632 + DFF + ca0 + e]; bg[e] = cb[DFF + ca0 + e];
      }
#pragma unroll
      for (int jj = 0; jj < 4; ++jj) {
        const int r = (tid >> 3) + 64 * jj, tt = tstart + r;
        if (r >= 1 && r <= 254 && tt < MEND) {
          const int pos = tt < MLAT ? (tt & (TLAT - 1)) : ((tt - MLAT) & (TCTX - 1)), slen = tt < MLAT ? TLAT : TCTX;
          const float fm = pos == 0 ? 0.f : 1.f, fp = pos == slen - 1 ? 0.f : 1.f;
          const char* rp = tile + r * 528;
          float o[8];
#pragma unroll
          for (int hf = 0; hf < 2; ++hf) {
            const f32x4 am = *(const f32x4*)(rp - 528 + lca + hf * 16), a0 = *(const f32x4*)(rp + lca + hf * 16), ap = *(const f32x4*)(rp + 528 + lca + hf * 16);
            const f32x4 gm = *(const f32x4*)(rp - 528 + lcg + hf * 16), g0 = *(const f32x4*)(rp + lcg + hf * 16), gp = *(const f32x4*)(rp + 528 + lcg + hf * 16);
#pragma unroll
            for (int e = 0; e < 4; ++e) {
              const int q = hf * 4 + e;
              const float ua = wa0[q] * (fm * am[e]) + wa1[q] * a0[e] + wa2[q] * (fp * ap[e]) + ba[q];
              const float ug = wg0[q] * (fm * gm[e]) + wg1[q] * g0[e] + wg2[q] * (fp * gp[e]) + bg[q];
              o[q] = silu_f(ug) * ua;
            }
          }
          u32x4 w = {pk2(o[0], o[1]), pk2(o[2], o[3]), pk2(o[4], o[5]), pk2(o[6], o[7])};
          *(u32x4*)(act + (size_t)tt * DFF + ca0) = w;
        }
      }
    }
    s = s2; rt = rt2; nt = nt2;
  }
}

#define XB_TMO      128
#define XB_XCNT(j)  (256  + 64 * (j))
#define XB_XSUB(j)  (1280 + 64 * (j))
#define XB_XGEN(j)  (2304 + 64 * (j))
#define XB_TOP      3328
#define XB_TOPGEN   3392
#define XCD_BAR_WORDS 3456
#define XB_SPIN_CAP (1u << 24)
DI unsigned xb_ld(unsigned* p) { return __hip_atomic_load(p, __ATOMIC_RELAXED, __HIP_MEMORY_SCOPE_AGENT); }
DI unsigned xb_add(unsigned* p, unsigned v) { return __hip_atomic_fetch_add(p, v, __ATOMIC_RELAXED, __HIP_MEMORY_SCOPE_AGENT); }
DI unsigned xb_xcc_id() { return (unsigned)__builtin_amdgcn_s_getreg((3 << 11) | 20) & 0xFu; }
#define XB_SPIN(cond, bar) do { unsigned _sp = 0; while (cond) { __builtin_amdgcn_s_sleep(1); \
    if ((++_sp & 255u) == 0u) { if (xb_ld(&(bar)[XB_TMO])) break; if (_sp > XB_SPIN_CAP) { atomicAdd(&(bar)[XB_TMO], 1u); break; } } } } while (0)
struct XcdBarrier { unsigned* bar; unsigned x; volatile LAS unsigned* st; };
DI XcdBarrier xcd_barrier_post(unsigned* bar, volatile LAS unsigned* st) {
  XcdBarrier b; b.bar = bar; b.x = xb_xcc_id(); b.st = st;
  if (threadIdx.x == 0) (void)xb_add(&bar[XB_XCNT(b.x)], 1u);
  return b;
}
DI void xcd_barrier_complete(unsigned* bar, unsigned x, unsigned& nloc, unsigned& nx) {
  const unsigned G = gridDim.x * gridDim.y * gridDim.z;
  unsigned sum, cnt, mine, sp = 0u;
  for (;;) {
    sum = 0u; cnt = 0u; mine = 0u;
#pragma unroll
    for (unsigned j = 0; j < 16; ++j) { const unsigned c = xb_ld(&bar[XB_XCNT(j)]); sum += c; cnt += (c > 0u) ? 1u : 0u; mine = (j == x) ? c : mine; }
    if (sum == G) break;
    __builtin_amdgcn_s_sleep(1);
    if ((++sp & 255u) == 0u) { if (xb_ld(&bar[XB_TMO])) break; if (sp > XB_SPIN_CAP) { atomicAdd(&bar[XB_TMO], 1u); break; } }
  }
  nloc = mine > 0u ? mine : 1u; nx = cnt > 0u ? cnt : 1u;
}
DI void xcd_barrier(const XcdBarrier& b) {
  asm volatile("s_waitcnt vmcnt(0)" ::: "memory");
  __syncthreads();
  if (threadIdx.x == 0) {
    unsigned* bar = b.bar;
    __builtin_amdgcn_s_waitcnt(0);
    unsigned nloc = b.st[0], nx = b.st[1];
    if (nloc == 0u) { xcd_barrier_complete(bar, b.x, nloc, nx); b.st[0] = nloc; b.st[1] = nx; }
    const unsigned old = xb_add(&bar[XB_XSUB(b.x)], 1u);
    const unsigned gen = old / nloc;
    if (old + 1u == (gen + 1u) * nloc) {
      __builtin_amdgcn_fence(__ATOMIC_RELEASE, "agent");
      asm volatile("s_waitcnt vmcnt(0)" ::: "memory");
      const unsigned og = xb_add(&bar[XB_TOP], 1u);
      const unsigned tg = og / nx;
      if (og + 1u == (tg + 1u) * nx) xb_add(&bar[XB_TOPGEN], 1u);
      else XB_SPIN(xb_ld(&bar[XB_TOPGEN]) == tg, bar);
      __builtin_amdgcn_fence(__ATOMIC_ACQUIRE, "agent");
      xb_add(&bar[XB_XGEN(b.x)], 1u);
      asm volatile("s_waitcnt vmcnt(0)" ::: "memory");
    } else {
      XB_SPIN(xb_ld(&bar[XB_XGEN(b.x)]) == gen, bar);
      __builtin_amdgcn_fence(__ATOMIC_ACQUIRE, "agent");
      asm volatile("s_waitcnt vmcnt(0)" ::: "memory");
    }
  }
  __syncthreads();
}

__global__ void __launch_bounds__(NTHREADS) fwd_kernel(P p) {
  extern __shared__ __attribute__((aligned(16))) char lds_raw[];
  char* lds = lds_raw + LDS_FRONT;
  cg::grid_group grid = cg::this_grid();
  if (threadIdx.x == 0) *(u32x4*)lds_raw = u32x4{0u, 0u, 0u, 0u};
  __syncthreads();
  (void)xcd_barrier_post((unsigned*)(p.ws + OFF_BAR), (volatile LAS unsigned*)lds_raw);
#define GBAR() do { XcdBarrier xb_; xb_.bar = (unsigned*)(p.ws + OFF_BAR); xb_.x = xb_xcc_id(); xb_.st = (volatile LAS unsigned*)lds_raw; xcd_barrier(xb_); } while (0)
  phase_pre(p);
  grid.sync();
  phase0(p, lds);
  GBAR();
  for (int l = 0; l < NLAYER; ++l) {
    phase_norm(p, l, 0);
    GBAR();
    phase_inproj(p, l, lds);
    GBAR();
    phase_mla_prep(p, l, lds);
    phase_s5_states(p, l, lds);
    GBAR();
    phase_attn(p, l, lds);
    GBAR();
    phase_s5_out(p, l, lds);
    GBAR();
    phase_glu(p, l, lds);
    GBAR();
    phase_resid_gemm(p, l, (const u16*)(p.ws + OFF_MIX), wl(p, l) + W_OUT, 1024, 2048, lds, l == 0);
    GBAR();
    phase_norm(p, l, 1);
    GBAR();
    phase_ffn_up(p, l, lds);
    GBAR();
    phase_resid_gemm(p, l, (const u16*)(p.ws + OFF_ACT), wl(p, l) + W_DN, DFF, 5120, lds);
    GBAR();
  }
}

extern "C" void kernel_launch(void* const* d_in, const int* in_sizes, int n_in, void* d_out, int out_size, void* d_ws, size_t ws_size, hipStream_t stream) {
  static int grid_blocks = 0;
  if (!grid_blocks) {
    if (ws_size < WS_NEED) { fprintf(stderr, "kernel_launch: workspace too small: %zu < %zu\n", ws_size, (size_t)WS_NEED); return; }
    if (hipFuncSetAttribute((const void*)fwd_kernel, hipFuncAttributeMaxDynamicSharedMemorySize, LDS_TOTAL) != hipSuccess) { fprintf(stderr, "kernel_launch: LDS attribute failed\n"); return; }
    int dev = 0, cus = 0, per_cu = 0;
    hipGetDevice(&dev);
    hipDeviceGetAttribute(&cus, hipDeviceAttributeMultiprocessorCount, dev);
    hipOccupancyMaxActiveBlocksPerMultiprocessor(&per_cu, fwd_kernel, NTHREADS, LDS_TOTAL);
    if (per_cu < 1) { fprintf(stderr, "kernel_launch: occupancy 0\n"); return; }
    grid_blocks = cus;
  }
  P p{};
  const float** fp = (const float**)&p;
  for (int i = 0; i < 33; ++i) fp[i] = (const float*)d_in[i];
  p.out = (float*)d_out; p.ws = (char*)d_ws;
  (void)hipMemsetAsync((char*)d_ws + OFF_BAR, 0, XCD_BAR_WORDS * 4, stream);
  void* args[] = {&p};
  hipError_t e = hipLaunchCooperativeKernel((void*)fwd_kernel, dim3(grid_blocks), dim3(NTHREADS), args, LDS_TOTAL, stream);
  if (e != hipSuccess) fprintf(stderr, "cooperative launch failed: %s (grid %d)\n", hipGetErrorString(e), grid_blocks);
}
```

```cpp
#include <hip/hip_runtime.h>
#include <hip/hip_cooperative_groups.h>
#include <cstdio>
#include <cstdint>
namespace cg = cooperative_groups;

typedef unsigned short u16;
typedef short bf16x8 __attribute__((ext_vector_type(8)));
typedef short s16x4 __attribute__((ext_vector_type(4)));
typedef float f32x16 __attribute__((ext_vector_type(16)));
typedef float f32x4 __attribute__((ext_vector_type(4)));
typedef float f32x2 __attribute__((ext_vector_type(2)));
typedef unsigned u32x4 __attribute__((ext_vector_type(4)));
typedef unsigned u32x2 __attribute__((ext_vector_type(2)));
typedef __bf16 bf16x2_t __attribute__((ext_vector_type(2)));
#define DI __device__ __forceinline__
#define LAS __attribute__((address_space(3)))

constexpr int DM = 1024, NBATCH = 8, TLAT = 8192, NLAYER = 4, TCTX = 256;
constexpr int MLAT = NBATCH * TLAT, MCTX = NBATCH * TCTX, MTOT = MLAT + MCTX;
constexpr int PROJ_LD = 928, DFF = 2816;
constexpr float EPS = 1e-6f, LOG2E = 1.4426950408889634f;
constexpr int NTHREADS = 512;
constexpr int PITCH = 144;
constexpr int LDS_SCR = 2048;
constexpr int LDS_FRONT = 256;
constexpr int LDS_TOTAL = LDS_FRONT + LDS_SCR + 256 * 528;

constexpr size_t al256(size_t x) { return (x + 255) / 256 * 256; }
constexpr size_t OFF_CTXX = 0;
constexpr size_t OFF_MOD = OFF_CTXX + (size_t)MCTX * DM * 4;
constexpr size_t OFF_ROPE = OFF_MOD + al256((size_t)NLAYER * 9 * 6144 * 4);
constexpr size_t ROPE_COSA = 0, ROPE_SINA = (size_t)TLAT * 16 * 4, ROPE_COSS = 2 * ROPE_SINA, ROPE_SINS = ROPE_COSS + (size_t)TLAT * 32 * 4;
constexpr size_t OFF_S5PW = OFF_ROPE + 2 * (size_t)TLAT * 16 * 4 + 2 * (size_t)TLAT * 32 * 4;
constexpr size_t OFF_S5Q = OFF_S5PW + (size_t)NLAYER * 2 * 16 * 64 * 65 * 16;
constexpr size_t OFF_W = OFF_S5Q + (size_t)NLAYER * 2 * 16 * 64 * 16;
constexpr size_t W_IN = 0, W_OUT = W_IN + (size_t)1664 * 1024, W_UP = W_OUT + (size_t)1024 * 1024, W_DN = W_UP + (size_t)5632 * 1024,
                 W_UQ = W_DN + (size_t)1024 * 2816, W_UKV = W_UQ + (size_t)576 * 384, W_GLU = W_UKV + (size_t)768 * 256, W_LAYER = W_GLU + (size_t)256 * 256;
constexpr size_t OFF_S5T = OFF_W + (size_t)NLAYER * W_LAYER * 2;
constexpr size_t S5_KC = 0, S5_BST = S5_KC + (size_t)16 * 127 * 256, S5_MRD = S5_BST + (size_t)16 * 256 * 1024, S5_LAYER = S5_MRD + (size_t)16 * 1024 * 256;
constexpr size_t OFF_H = OFF_S5T + (size_t)NLAYER * S5_LAYER * 2;
constexpr size_t OFF_MIX = OFF_H + (size_t)MTOT * 1024 * 2;
constexpr size_t OFF_SST = OFF_MIX + (size_t)MTOT * 1024 * 2;
constexpr size_t OFF_HIN = OFF_SST + (size_t)1056 * 16 * 256 * 4;
constexpr size_t OFF_ZB = OFF_HIN + (size_t)1056 * 16 * 256 * 2;
constexpr size_t OFF_BIG = OFF_ZB + (size_t)MTOT * 256 * 2;
constexpr size_t OFF_PROJ = OFF_BIG;
constexpr size_t OFF_QM = OFF_PROJ + (size_t)MTOT * PROJ_LD * 2;
constexpr size_t OFF_KM = OFF_QM + (size_t)MTOT * 576 * 2;
constexpr size_t OFF_VM = OFF_KM + (size_t)MTOT * 576 * 2;
constexpr size_t OFF_QS = OFF_VM + (size_t)MTOT * 384 * 2;
constexpr size_t OFF_KS = OFF_QS + (size_t)MTOT * 384 * 2;
constexpr size_t OFF_VS = OFF_KS + (size_t)MTOT * 128 * 2;
constexpr size_t OFF_END1 = OFF_VS + (size_t)MTOT * 128 * 2;
constexpr size_t OFF_ACT = OFF_BIG;
constexpr size_t OFF_END2 = OFF_ACT + (size_t)MTOT * DFF * 2;
constexpr size_t OFF_ZERO = OFF_END1 > OFF_END2 ? OFF_END1 : OFF_END2;
constexpr size_t OFF_BAR = OFF_ZERO + 8192;
constexpr size_t WS_NEED = OFF_BAR + 16384;

struct P {
  const float *x, *c, *ctx, *c_ctx, *w_mod, *b_mod, *norm1, *w_in, *q_lora_g, *w_uq, *kv_lora_g, *w_ukv, *q_norm, *k_norm, *a_re, *a_im, *log_dt, *b_re, *b_im, *c_re,
      *c_im, *s5_d, *w_glu, *b_glu, *sq_norm, *sk_norm, *sink, *w_out, *norm2, *w_up, *conv_w, *conv_b, *w_down;
  float* out;
  char* ws;
};

DI unsigned pk2(float a, float b) { f32x2 v = {a, b}; bf16x2_t r = __builtin_convertvector(v, bf16x2_t); return __builtin_bit_cast(unsigned, r); }
DI float bflo(unsigned w) { return __uint_as_float(w << 16); }
DI float bfhi(unsigned w) { return __uint_as_float(w & 0xffff0000u); }
DI int otid() { int t = threadIdx.x; asm volatile("" : "+v"(t)); return t; }
DI int crow(int r, int hi) { return (r & 3) + 8 * (r >> 2) + 4 * hi; }
DI f32x16 mfma(bf16x8 a, bf16x8 b, f32x16 c) { return __builtin_amdgcn_mfma_f32_32x32x16_bf16(a, b, c, 0, 0, 0); }
DI float ex2(float x) { return __builtin_amdgcn_exp2f(x); }
DI float rcpf_(float x) { return __builtin_amdgcn_rcpf(x); }
DI float xsum32(float v) { auto rr = __builtin_amdgcn_permlane32_swap(__float_as_uint(v), __float_as_uint(v), false, false); return __uint_as_float(rr[0]) + __uint_as_float(rr[1]); }
DI float xmax32(float v) { auto rr = __builtin_amdgcn_permlane32_swap(__float_as_uint(v), __float_as_uint(v), false, false); return fmaxf(__uint_as_float(rr[0]), __uint_as_float(rr[1])); }
DI void st4(u16* p, float a, float b, float c, float d) { u32x2 w = {pk2(a, b), pk2(c, d)}; *(u32x2*)p = w; }
DI float silu_f(float g) { return g * rcpf_(1.f + ex2(-g * LOG2E)); }
DI float sigmoid_f(float g) { return rcpf_(1.f + ex2(-g * LOG2E)); }
DI float gelu_tanh(float x) { const float u = 0.7978845608028654f * (x + 0.044715f * x * x * x); const float th = 1.f - 2.f * rcpf_(1.f + ex2(2.f * LOG2E * u)); return 0.5f * x * (1.f + th); }
DI const float* xin(const P& p, int m) { return m < MLAT ? p.x + (size_t)m * DM : p.ctx + (size_t)(m - MLAT) * DM; }
DI float* xrow(const P& p, int m) { return m < MLAT ? p.out + (size_t)m * DM : (float*)(p.ws + OFF_CTXX) + (size_t)(m - MLAT) * DM; }
DI int modidx(int m) { return m < MLAT ? (m >> 13) : 8; }
DI const float* modv(const P& p, int l, int mi) { return (const float*)(p.ws + OFF_MOD) + ((size_t)l * 9 + mi) * 6144; }
DI size_t head_row(int m, int h, int H) {
  if (m < MLAT) return ((size_t)((m >> 13) * H + h) << 13) + (m & 8191);
  const int r = m - MLAT; return (size_t)NBATCH * H * TLAT + (size_t)((r >> 8) * H + h) * TCTX + (r & 255);
}
DI u16* wl(const P& p, int l) { return (u16*)(p.ws + OFF_W) + (size_t)l * W_LAYER; }
DI u16* s5t(const P& p, int l) { return (u16*)(p.ws + OFF_S5T) + (size_t)l * S5_LAYER; }
DI int s5_tokbase(int row) { return row < 1024 ? (row >> 7) * TLAT + (row & 127) * 64 : MLAT + ((row - 1024) >> 2) * TCTX + ((row - 1024) & 3) * 64; }

DI int tile_steps(int MT, int NT, int RM, int RN) {
  if (gridDim.x == 256) { const int SM = (MT + RM - 1) / RM, SN = (NT + RN - 1) / RN; return (SM * SN + 7) >> 3; }
  return (MT * NT + gridDim.x - 1) / gridDim.x;
}
DI bool tile_get(int s, int MT, int NT, int RM, int RN, int& mt, int& nt) {
  if (gridDim.x == 256) {
    const int xcd = blockIdx.x & 7, slot = blockIdx.x >> 3; const int SM = (MT + RM - 1) / RM, SN = (NT + RN - 1) / RN;
    const int st = s * 8 + xcd; if (st >= SM * SN) return false;
    mt = (st / SN) * RM + slot % RM; nt = (st % SN) * RN + slot / RM;
    return mt < MT && nt < NT;
  }
  const int it = s * gridDim.x + blockIdx.x; if (it >= MT * NT) return false;
  mt = it / NT; nt = it % NT; return true;
}

struct LdRows {
  const u16* p[4];
  DI u32x4 load(int j, int kc) const { return *(const u32x4*)(p[j] + (size_t)kc * 8); }
};
struct LdS5A {
  const u16* pu[4]; const u16* ph[4];
  DI u32x4 load(int j, int kc) const {
    const u16* q = kc < 128 ? pu[j] + (size_t)(kc >> 1) * PROJ_LD + (kc & 1) * 8 : ph[j] + (kc - 128) * 8;
    return *(const u32x4*)q;
  }
};
struct LdS5B {
  const u16* pk[2]; const u16* pm[2];
  DI u32x4 load(int j, int kc) const {
    const u16* q = kc < 128 ? pk[j] - (kc >> 1) * 256 + (kc & 1) * 8 : pm[j] + (kc - 128) * 8;
    return *(const u32x4*)q;
  }
};

template <int NA, int NB, class AL, class BL>
DI void gemm_issue(int tid, const AL& al, const BL& bl, int nk, u32x4 (&ra0)[NA], u32x4 (&rb0)[NB], u32x4 (&ra1)[NA], u32x4 (&rb1)[NB]) {
  const int lc = tid & 7, k1 = nk > 1 ? 1 : 0;
#pragma unroll
  for (int j = 0; j < NA; ++j) ra0[j] = al.load(j, lc);
#pragma unroll
  for (int j = 0; j < NB; ++j) rb0[j] = bl.load(j, lc);
#pragma unroll
  for (int j = 0; j < NA; ++j) ra1[j] = al.load(j, k1 * 8 + lc);
#pragma unroll
  for (int j = 0; j < NB; ++j) rb1[j] = bl.load(j, k1 * 8 + lc);
}
template <int WM, int WN, int TM, int TN, bool SW = false, class AL, class BL>
DI void gemm_run(int tid, char* lds, const AL& al, const BL& bl, int nk, f32x16 (&acc)[TM][TN], u32x4 (&ra0)[WM * TM / 2], u32x4 (&rb0)[WN * TN / 2], u32x4 (&ra1)[WM * TM / 2], u32x4 (&rb1)[WN * TN / 2]) {
  constexpr int BM = WM * TM * 32, BN = WN * TN * 32, NA = BM / 64, NB = BN / 64;
  constexpr int AB = BM * PITCH, STAGE = (BM + BN) * PITCH;
  const int lane = tid & 63, wid = tid >> 6, r32 = lane & 31, hi = lane >> 5;
  const int wm = wid / WN, wn = wid % WN, lr = tid >> 3, lc = tid & 7;
  char* const wa = lds + lr * PITCH + lc * 16;
  const int aoff = (wm * TM * 32 + r32) * PITCH + hi * 16;
  const int boff = AB + (wn * TN * 32 + r32) * PITCH + hi * 16;
#define GLOAD(RA, RB, KT) do { const int kc_ = (KT) * 8 + lc; _Pragma("unroll") for (int j = 0; j < NA; ++j) RA[j] = al.load(j, kc_); _Pragma("unroll") for (int j = 0; j < NB; ++j) RB[j] = bl.load(j, kc_); } while (0)
#define LWRITE(RA, RB, BUF) do { char* w_ = wa + (BUF) * STAGE; _Pragma("unroll") for (int j = 0; j < NA; ++j) *(u32x4*)(w_ + j * 64 * PITCH) = RA[j]; _Pragma("unroll") for (int j = 0; j < NB; ++j) *(u32x4*)(w_ + AB + j * 64 * PITCH) = RB[j]; } while (0)
#define COMPUTE(BUF, RA, RB, WBUF) do { const char* sb = lds + (BUF) * STAGE; char* w_ = wa + (WBUF) * STAGE; _Pragma("unroll") for (int ks = 0; ks < 4; ++ks) { bf16x8 wf[TN], xf[TM]; \
    _Pragma("unroll") for (int tn = 0; tn < TN; ++tn) wf[tn] = *(const bf16x8*)(sb + boff + tn * 32 * PITCH + ks * 32); \
    _Pragma("unroll") for (int tm = 0; tm < TM; ++tm) xf[tm] = *(const bf16x8*)(sb + aoff + tm * 32 * PITCH + ks * 32); \
    _Pragma("unroll") for (int tm = 0; tm < TM; ++tm) _Pragma("unroll") for (int tn = 0; tn < TN; ++tn) acc[tm][tn] = SW ? mfma(xf[tm], wf[tn], acc[tm][tn]) : mfma(wf[tn], xf[tm], acc[tm][tn]); \
    _Pragma("unroll") for (int j = 0; j < NA; ++j) if (1 + j % 3 == ks) *(u32x4*)(w_ + j * 64 * PITCH) = RA[j]; \
    _Pragma("unroll") for (int j = 0; j < NB; ++j) if (1 + (NA + j) % 3 == ks) *(u32x4*)(w_ + AB + j * 64 * PITCH) = RB[j]; } } while (0)
  const int kl = nk - 1;
  LWRITE(ra0, rb0, 0);
  __syncthreads();
#pragma unroll 1
  for (int kt = 0; kt < nk; kt += 2) {
    GLOAD(ra0, rb0, (kt + 2 < kl ? kt + 2 : kl));
    COMPUTE(0, ra1, rb1, 1);
    __syncthreads();
    if (kt + 1 >= nk) break;
    GLOAD(ra1, rb1, (kt + 3 < kl ? kt + 3 : kl));
    COMPUTE(1, ra0, rb0, 0);
    __syncthreads();
  }
#undef GLOAD
#undef LWRITE
#undef COMPUTE
}
template <int WM, int WN, int TM, int TN, bool SW = false, class AL, class BL>
DI void gemm_main(int tid, char* lds, const AL& al, const BL& bl, int nk, f32x16 (&acc)[TM][TN]) {
  constexpr int NA = WM * TM / 2, NB = WN * TN / 2;
  u32x4 ra0[NA], rb0[NB], ra1[NA], rb1[NB];
  gemm_issue<NA, NB>(tid, al, bl, nk, ra0, rb0, ra1, rb1);
  gemm_run<WM, WN, TM, TN, SW>(tid, lds, al, bl, nk, acc, ra0, rb0, ra1, rb1);
}
template <bool SW, class AL, class BL>
DI void gemm_run16(int tid, char* lds, const AL& al, const BL& bl, int nk, f32x4 (&acc)[4][4], u32x4 (&ra0)[4], u32x4 (&rb0)[2], u32x4 (&ra1)[4], u32x4 (&rb1)[2]) {
  constexpr int NA = 4, NB = 2, RB_ = 128, AB = 256 * RB_, STAGE = 384 * RB_;
  const int lane = tid & 63, wid = tid >> 6, l15 = lane & 15, g = lane >> 4;
  const int wm = wid >> 1, wn = wid & 1, lr = tid >> 3, lc = tid & 7;
  char* const wa = lds + lr * RB_ + ((lc ^ ((lr >> 1) & 7)) << 4);
  const int o0 = (g ^ ((lane >> 1) & 7)) << 4, o1 = o0 ^ 64;
  const int aoff = (wm * 64 + l15) * RB_, boff = AB + (wn * 64 + l15) * RB_;
#define GLOAD(RA, RB, KT) do { const int kc_ = (KT) * 8 + lc; _Pragma("unroll") for (int j = 0; j < NA; ++j) RA[j] = al.load(j, kc_); _Pragma("unroll") for (int j = 0; j < NB; ++j) RB[j] = bl.load(j, kc_); } while (0)
#define LWRITE(RA, RB, BUF) do { char* w_ = wa + (BUF) * STAGE; _Pragma("unroll") for (int j = 0; j < NA; ++j) *(u32x4*)(w_ + j * 64 * RB_) = RA[j]; _Pragma("unroll") for (int j = 0; j < NB; ++j) *(u32x4*)(w_ + AB + j * 64 * RB_) = RB[j]; } while (0)
#define KSTEP(OFF) do { bf16x8 wf[4], xf[4]; \
    _Pragma("unroll") for (int t = 0; t < 4; ++t) { wf[t] = *(const bf16x8*)(sb + boff + t * 16 * RB_ + (OFF)); xf[t] = *(const bf16x8*)(sb + aoff + t * 16 * RB_ + (OFF)); } \
    _Pragma("unroll") for (int tm = 0; tm < 4; ++tm) _Pragma("unroll") for (int tn = 0; tn < 4; ++tn) \
      acc[tm][tn] = SW ? __builtin_amdgcn_mfma_f32_16x16x32_bf16(xf[tm], wf[tn], acc[tm][tn], 0, 0, 0) : __builtin_amdgcn_mfma_f32_16x16x32_bf16(wf[tn], xf[tm], acc[tm][tn], 0, 0, 0); } while (0)
#define COMPUTE(BUF, RA, RB, WBUF) do { const char* sb = lds + (BUF) * STAGE; char* w_ = wa + (WBUF) * STAGE; \
    KSTEP(o0); *(u32x4*)(w_) = RA[0]; *(u32x4*)(w_ + 64 * RB_) = RA[1]; *(u32x4*)(w_ + 128 * RB_) = RA[2]; \
    KSTEP(o1); *(u32x4*)(w_ + 192 * RB_) = RA[3]; *(u32x4*)(w_ + AB) = RB[0]; *(u32x4*)(w_ + AB + 64 * RB_) = RB[1]; } while (0)
  const int kl = nk - 1;
  LWRITE(ra0, rb0, 0);
  __syncthreads();
#pragma unroll 1
  for (int kt = 0; kt < nk; kt += 2) {
    GLOAD(ra0, rb0, (kt + 2 < kl ? kt + 2 : kl));
    COMPUTE(0, ra1, rb1, 1);
    __syncthreads();
    if (kt + 1 >= nk) break;
    GLOAD(ra1, rb1, (kt + 3 < kl ? kt + 3 : kl));
    COMPUTE(1, ra0, rb0, 0);
    __syncthreads();
  }
#undef GLOAD
#undef LWRITE
#undef KSTEP
#undef COMPUTE
}
DI int tile_next(int s, int ns, int MT, int NT, int RM, int RN, int& mt, int& nt) {
  for (; s < ns; ++s) if (tile_get(s, MT, NT, RM, RN, mt, nt)) return s;
  return -1;
}
template <int TM, int TN> DI void zero_acc(f32x16 (&acc)[TM][TN]) {
#pragma unroll
  for (int a = 0; a < TM; ++a)
#pragma unroll
    for (int b = 0; b < TN; ++b)
#pragma unroll
      for (int r = 0; r < 16; ++r) acc[a][b][r] = 0.f;
}

struct dc { double re, im; };
DI dc cmul(dc a, dc b) { return {a.re * b.re - a.im * b.im, a.re * b.im + a.im * b.re}; }

static __device__ __forceinline__ void phase_pre(const P& p) {
  const int gt = blockIdx.x * NTHREADS + threadIdx.x;
  if (gt < 512) ((u32x4*)(p.ws + OFF_ZERO))[gt] = u32x4{0, 0, 0, 0};
  if (gt < NLAYER * 2 * 16 * 64) {
    const int ldg = gt >> 6;
    const double lre = p.a_re[gt], lim = p.a_im[gt];
    const double dt = exp((double)p.log_dt[ldg]);
    double s, c; sincos(lim * dt, &s, &c);
    const double e = exp(lre * dt);
    const dc a = {e * c, e * s};
    const double den = lre * lre + lim * lim;
    const dc am1 = {a.re - 1.0, a.im};
    const dc q = {(am1.re * lre + am1.im * lim) / den, (am1.im * lre - am1.re * lim) / den};
    dc* pw = (dc*)(p.ws + OFF_S5PW) + (size_t)gt * 65;
    dc r = {1.0, 0.0};
    for (int k = 0; k <= 64; ++k) { pw[k] = r; r = cmul(r, a); }
    ((dc*)(p.ws + OFF_S5Q))[gt] = q;
  }
}

DI int nmap_in(int n) { return n < 640 ? n : (n < 1536 ? n + 32 : n - 896); }
DI int nmap_up(int n) { const int q = n >> 6, r = n & 63; return r < 32 ? 32 * q + r : DFF + 32 * q + (r - 32); }

static __device__ __forceinline__ void transpose_tile(const float* src, int ldsrc, int K, int Nd, int nmap, const float* kscale, u16* dst, int kt, int ntile, char* lds) {
  float* tile = (float*)lds;
  const int tid = threadIdx.x;
  __syncthreads();
  {
    const int n = tid & 63, kk = tid >> 6;
    const int nd = ntile * 64 + n;
    const int ns = nmap == 1 ? nmap_in(nd) : (nmap == 2 ? nmap_up(nd) : nd);
#pragma unroll
    for (int j = 0; j < 8; ++j) {
      const int k = kk + 8 * j, kg = kt * 64 + k;
      float v = 0.f;
      if (nd < Nd) { v = __builtin_nontemporal_load(src + (size_t)kg * ldsrc + ns); if (kscale) v *= kscale[kg]; }
      tile[k * 65 + n] = v;
    }
  }
  __syncthreads();
  {
    const int n = tid >> 3, kc = tid & 7, nd = ntile * 64 + n;
    if (nd < Nd) {
      const float* t = tile + (kc * 8) * 65 + n;
      u32x4 w = {pk2(t[0], t[65]), pk2(t[130], t[195]), pk2(t[260], t[325]), pk2(t[390], t[455])};
      *(u32x4*)(dst + (size_t)nd * K + kt * 64 + kc * 8) = w;
    }
  }
}

static __device__ __forceinline__ void mod_item(const P& p, int it, char* lds) {
  const int l = it / 96, n0 = (it % 96) * 64, tid = threadIdx.x;
  float* sv = (float*)lds;
  float* red = sv + 9 * 1024;
  __syncthreads();
  for (int i = tid; i < 9 * 1024; i += NTHREADS) { const int j = i >> 10, k = i & 1023; const float v = j < 8 ? p.c[j * 1024 + k] : p.c_ctx[k]; sv[i] = v / (1.f + expf(-v)); }
  __syncthreads();
  const int c = tid & 63, kg = tid >> 6;
  float acc[9];
#pragma unroll
  for (int j = 0; j < 9; ++j) acc[j] = 0.f;
  const float* w = p.w_mod + ((size_t)l * 1024 + kg * 128) * 6144 + n0 + c;
  for (int kk = 0; kk < 128; ++kk) {
    const float wv = __builtin_nontemporal_load(w + (size_t)kk * 6144);
#pragma unroll
    for (int j = 0; j < 9; ++j) acc[j] += sv[j * 1024 + kg * 128 + kk] * wv;
  }
#pragma unroll
  for (int j = 0; j < 9; ++j) red[(kg * 9 + j) * 64 + c] = acc[j];
  __syncthreads();
  for (int q = tid; q < 576; q += NTHREADS) {
    const int j = q >> 6, cc = q & 63; float s = 0.f;
#pragma unroll
    for (int g = 0; g < 8; ++g) s += red[(g * 9 + j) * 64 + cc];
    ((float*)(p.ws + OFF_MOD))[((size_t)l * 9 + j) * 6144 + n0 + cc] = s + p.b_mod[l * 6144 + n0 + cc];
  }
}

static __device__ __forceinline__ void phase0(const P& p, char* lds) {
  constexpr int NMOD = 384, TPL = 2886;
  for (int it = blockIdx.x; it < NMOD + NLAYER * TPL; it += gridDim.x) {
    if (it < NMOD) { mod_item(p, it, lds); continue; }
    const int u = it - NMOD, l = u / TPL, r = u % TPL;
    u16* W = wl(p, l);
    if (r < 400) transpose_tile(p.w_in + (size_t)l * 1024 * 1568, 1568, 1024, 1568, 1, nullptr, W + W_IN, r / 25, r % 25, lds);
    else if (r < 656) { const int q = r - 400; transpose_tile(p.w_out + (size_t)l * 1024 * 1024, 1024, 1024, 1024, 0, nullptr, W + W_OUT, q / 16, q % 16, lds); }
    else if (r < 2064) { const int q = r - 656; transpose_tile(p.w_up + (size_t)l * 1024 * 5632, 5632, 1024, 5632, 2, nullptr, W + W_UP, q / 88, q % 88, lds); }
    else if (r < 2768) { const int q = r - 2064; transpose_tile(p.w_down + (size_t)l * 2816 * 1024, 1024, 2816, 1024, 0, nullptr, W + W_DN, q / 16, q % 16, lds); }
    else if (r < 2822) { const int q = r - 2768; transpose_tile(p.w_uq + (size_t)l * 384 * 576, 576, 384, 576, 0, p.q_lora_g + l * 384, W + W_UQ, q / 9, q % 9, lds); }
    else if (r < 2870) { const int q = r - 2822; transpose_tile(p.w_ukv + (size_t)l * 256 * 768, 768, 256, 768, 0, p.kv_lora_g + l * 256, W + W_UKV, q / 12, q % 12, lds); }
    else { const int q = r - 2870; transpose_tile(p.w_glu + (size_t)l * 256 * 256, 256, 256, 256, 0, nullptr, W + W_GLU, q / 4, q % 4, lds); }
  }
  const size_t gt = (size_t)blockIdx.x * NTHREADS + threadIdx.x, gn = (size_t)gridDim.x * NTHREADS;
  for (size_t i = gt; i < (size_t)TLAT * 48; i += gn) {
    const int t = (int)(i / 48), j = (int)(i % 48);
    const int row = t >> 6, col = t & 63;
    int pos; double ex; float* cd; float* sd;
    if (j < 16) { const int f = j & 7; pos = j < 8 ? row : col; ex = -(double)f / 8.0; cd = (float*)(p.ws + OFF_ROPE + ROPE_COSA) + t * 16 + j; sd = (float*)(p.ws + OFF_ROPE + ROPE_SINA) + t * 16 + j; }
    else { const int jj = j - 16, f = jj & 15; pos = jj < 16 ? row : col; ex = -(double)f / 16.0; cd = (float*)(p.ws + OFF_ROPE + ROPE_COSS) + t * 32 + jj; sd = (float*)(p.ws + OFF_ROPE + ROPE_SINS) + t * 32 + jj; }
    const float inv = (float)exp(ex * 9.210340371976184);
    const float ang = (float)pos * inv;
    double s, c; sincos((double)ang, &s, &c);
    *cd = (float)c; *sd = (float)s;
  }
  const dc* PW = (const dc*)(p.ws + OFF_S5PW); const dc* QQ = (const dc*)(p.ws + OFF_S5Q);
  for (size_t i = gt; i < (size_t)NLAYER * 16 * 127 * 16; i += gn) {
    const int ii = (int)(i & 15); const int rest = (int)(i >> 4); const int dd = rest % 127, lg = rest / 127, g = lg & 15, l = lg >> 4;
    const int d = dd - 63;
    double acc[16];
#pragma unroll
    for (int o = 0; o < 16; ++o) acc[o] = 0.0;
    for (int dir = 0; dir < 2; ++dir) {
      if ((dir == 0 && d < 0) || (dir == 1 && d > 0)) continue;
      const int base = ((l * 2 + dir) * 16 + g) * 64; const int ad = d < 0 ? -d : d;
      const float* cr = p.c_re + (size_t)((l * 2 + dir) * 16 + g) * 16 * 64; const float* ci_ = p.c_im + (size_t)((l * 2 + dir) * 16 + g) * 16 * 64;
      for (int pp = 0; pp < 64; ++pp) {
        const dc a = PW[(size_t)(base + pp) * 65 + ad], q = QQ[base + pp];
        const size_t bi = (size_t)(base + pp) * 16 + ii; const dc B = {(double)p.b_re[bi], (double)p.b_im[bi]};
        const dc t1 = cmul(cmul(a, q), B);
#pragma unroll
        for (int o = 0; o < 16; ++o) acc[o] += (double)cr[o * 64 + pp] * t1.re - (double)ci_[o * 64 + pp] * t1.im;
      }
    }
    if (d == 0) acc[ii] += (double)p.s5_d[l * 256 + g * 16 + ii];
    u16* dst = s5t(p, l) + S5_KC + (size_t)(g * 127 + dd) * 256 + ii;
#pragma unroll
    for (int o = 0; o < 16; ++o) dst[o * 16] = (u16)(pk2((float)acc[o], 0.f) & 0xffff);
  }
  for (size_t i = gt; i < (size_t)NLAYER * 16 * 256 * 1024; i += gn) {
    const int k = (int)(i & 1023), n = (int)((i >> 10) & 255), g = (int)((i >> 18) & 15), l = (int)(i >> 22);
    const int dir = n >> 7, pp = (n >> 1) & 63, reim = n & 1, s = k >> 4, ii = k & 15;
    const int base = ((l * 2 + dir) * 16 + g) * 64 + pp; const int e = dir == 0 ? 63 - s : s;
    const size_t bi = (size_t)base * 16 + ii; const dc B = {(double)p.b_re[bi], (double)p.b_im[bi]};
    const dc v = cmul(cmul(PW[(size_t)base * 65 + e], QQ[base]), B);
    (s5t(p, l) + S5_BST)[((size_t)g * 256 + n) * 1024 + k] = (u16)(pk2((float)(reim ? v.im : v.re), 0.f) & 0xffff);
  }
  for (size_t i = gt; i < (size_t)NLAYER * 16 * 1024 * 256; i += gn) {
    const int k = (int)(i & 255), n = (int)((i >> 8) & 1023), g = (int)((i >> 18) & 15), l = (int)(i >> 22);
    const int dir = k >> 7, pp = (k >> 1) & 63, reim = k & 1, t = n >> 4, o = n & 15;
    const int base = ((l * 2 + dir) * 16 + g) * 64 + pp; const int e = dir == 0 ? t + 1 : 64 - t;
    const size_t ci = ((size_t)(((l * 2 + dir) * 16 + g) * 16 + o)) * 64 + pp; const dc C = {(double)p.c_re[ci], (double)p.c_im[ci]};
    const dc v = cmul(C, PW[(size_t)base * 65 + e]);
    (s5t(p, l) + S5_MRD)[((size_t)g * 1024 + n) * 256 + k] = (u16)(pk2((float)(reim ? -v.im : v.re), 0.f) & 0xffff);
  }
}

static __device__ __forceinline__ void phase_norm(const P& p, int l, int which) {
  const int tid = otid(), lane = tid & 63, wid = tid >> 6;
  const float* gw = (which ? p.norm2 : p.norm1) + l * 1024;
  u16* H = (u16*)(p.ws + OFF_H);
  const int mend = (which == 1 && l == NLAYER - 1) ? MLAT : MTOT;
  const bool first = l == 0 && which == 0;
  f32x4 gq[4];
#pragma unroll
  for (int j = 0; j < 4; ++j) gq[j] = *(const f32x4*)(gw + j * 256 + lane * 4);
  for (int m0 = blockIdx.x * 8 + wid; m0 < mend; m0 += gridDim.x * 16) {
    const int m1 = m0 + gridDim.x * 8; const bool has1 = m1 < mend; const int m1c = has1 ? m1 : m0;
    const float* xr0 = first ? xin(p, m0) : xrow(p, m0); const float* xr1 = first ? xin(p, m1c) : xrow(p, m1c);
    const float* mv0 = modv(p, l, modidx(m0)) + which * 3072; const float* mv1 = modv(p, l, modidx(m1c)) + which * 3072;
    f32x4 v0[4], v1[4], sh0[4], sc0[4], sh1[4], sc1[4];
#pragma unroll
    for (int j = 0; j < 4; ++j) { v0[j] = __builtin_nontemporal_load((const f32x4*)(xr0 + j * 256 + lane * 4)); v1[j] = __builtin_nontemporal_load((const f32x4*)(xr1 + j * 256 + lane * 4)); }
#pragma unroll
    for (int j = 0; j < 4; ++j) { const int c = j * 256 + lane * 4; sh0[j] = *(const f32x4*)(mv0 + c); sc0[j] = *(const f32x4*)(mv0 + 1024 + c); sh1[j] = *(const f32x4*)(mv1 + c); sc1[j] = *(const f32x4*)(mv1 + 1024 + c); }
    float s0 = 0.f, s1 = 0.f;
#pragma unroll
    for (int j = 0; j < 4; ++j)
#pragma unroll
      for (int e = 0; e < 4; ++e) { s0 += v0[j][e] * v0[j][e]; s1 += v1[j][e] * v1[j][e]; }
#pragma unroll
    for (int o = 32; o > 0; o >>= 1) { s0 += __shfl_xor(s0, o); s1 += __shfl_xor(s1, o); }
    const float r0 = rsqrtf(s0 * (1.f / 1024.f) + EPS), r1 = rsqrtf(s1 * (1.f / 1024.f) + EPS);
#pragma unroll
    for (int j = 0; j < 4; ++j) {
      const int c = j * 256 + lane * 4;
      float o[4];
#pragma unroll
      for (int e = 0; e < 4; ++e) o[e] = v0[j][e] * r0 * gq[j][e] * (1.f + sc0[j][e]) + sh0[j][e];
      st4(H + (size_t)m0 * 1024 + c, o[0], o[1], o[2], o[3]);
    }
    if (has1) {
#pragma unroll
      for (int j = 0; j < 4; ++j) {
        const int c = j * 256 + lane * 4;
        float o[4];
#pragma unroll
        for (int e = 0; e < 4; ++e) o[e] = v1[j][e] * r1 * gq[j][e] * (1.f + sc1[j][e]) + sh1[j][e];
        st4(H + (size_t)m1 * 1024 + c, o[0], o[1], o[2], o[3]);
      }
    }
  }
}

static __device__ __forceinline__ void phase_inproj(const P& p, int l, char* lds) {
  const int tid = otid(), lane = tid & 63, wid = tid >> 6, r32 = lane & 31, hi = lane >> 5, wm = wid >> 1, wn = wid & 1, lr = tid >> 3;
  const u16* H = (const u16*)(p.ws + OFF_H); const u16* W = wl(p, l) + W_IN;
  u16* proj = (u16*)(p.ws + OFF_PROJ);
  const float* cosS = (const float*)(p.ws + OFF_ROPE + ROPE_COSS); const float* sinS = (const float*)(p.ws + OFF_ROPE + ROPE_SINS);
  const int ns = tile_steps(264, 12, 16, 2);
  u32x4 ra0[4], rb0[2], ra1[4], rb1[2];
  LdRows al, bl; int mt, nt;
  auto mk = [&](int mt_, int nt_, LdRows& a_, LdRows& b_) {
#pragma unroll
    for (int j = 0; j < 4; ++j) a_.p[j] = H + (size_t)(mt_ * 256 + lr + 64 * j) * 1024;
#pragma unroll
    for (int j = 0; j < 2; ++j) b_.p[j] = W + (size_t)(nt_ * 128 + lr + 64 * j) * 1024;
    b_.p[2] = b_.p[3] = b_.p[0];
  };
  int s = tile_next(0, ns, 264, 12, 16, 2, mt, nt);
  if (s >= 0) { mk(mt, nt, al, bl); gemm_issue<4, 2>(tid, al, bl, 16, ra0, rb0, ra1, rb1); }
  while (s >= 0) {
    f32x4 acc[4][4];
#pragma unroll
    for (int a_ = 0; a_ < 4; ++a_)
#pragma unroll
      for (int b_ = 0; b_ < 4; ++b_) acc[a_][b_] = f32x4{0.f, 0.f, 0.f, 0.f};
    __syncthreads();
    gemm_run16<false>(tid, lds + LDS_SCR, al, bl, 16, acc, ra0, rb0, ra1, rb1);
    int mt2 = 0, nt2 = 0; const int s2 = tile_next(s + 1, ns, 264, 12, 16, 2, mt2, nt2);
    if (s2 >= 0) { mk(mt2, nt2, al, bl); gemm_issue<4, 2>(tid, al, bl, 16, ra0, rb0, ra1, rb1); }
    const int n0w = nt * 128 + wn * 64, mw = mt * 256 + wm * 64, l15 = lane & 15, g4 = (lane >> 4) * 4;
    if (n0w < 896) {
#pragma unroll
      for (int tm = 0; tm < 4; ++tm) {
        u16* dst = proj + (size_t)(mw + 16 * tm + l15) * PROJ_LD + n0w + g4;
#pragma unroll
        for (int tn = 0; tn < 4; ++tn) st4(dst + 16 * tn, acc[tm][tn][0], acc[tm][tn][1], acc[tm][tn][2], acc[tm][tn][3]);
      }
    } else if (n0w < 1408) {
      const bool isq = n0w < 1280; const int head = isq ? (n0w - 896) >> 6 : (n0w - 1280) >> 6;
      const float* gn = (isq ? p.sq_norm : p.sk_norm) + l * 64;
      u16* dbase = (u16*)(p.ws + (isq ? OFF_QS : OFF_KS));
      const float osc = isq ? 0.125f * LOG2E : 1.f;
      f32x4 g1q[2], g2q[2];
#pragma unroll
      for (int tn = 0; tn < 2; ++tn) { g1q[tn] = *(const f32x4*)(gn + 16 * tn + g4); g2q[tn] = *(const f32x4*)(gn + 32 + 16 * tn + g4); }
#pragma unroll
      for (int hf = 0; hf < 2; ++hf) {
        f32x4 csq[2][2], snq[2][2]; float rsq[2];
#pragma unroll
        for (int t2 = 0; t2 < 2; ++t2) {
          const int tm = 2 * hf + t2, m = mw + 16 * tm + l15; const bool lat = m < MLAT; const int t = m & 8191;
#pragma unroll
          for (int tn = 0; tn < 2; ++tn) {
            csq[t2][tn] = f32x4{1.f, 1.f, 1.f, 1.f}; snq[t2][tn] = f32x4{0.f, 0.f, 0.f, 0.f};
            if (lat) { csq[t2][tn] = *(const f32x4*)(cosS + t * 32 + 16 * tn + g4); snq[t2][tn] = *(const f32x4*)(sinS + t * 32 + 16 * tn + g4); }
          }
          float ss = 0.f;
#pragma unroll
          for (int tn = 0; tn < 4; ++tn)
#pragma unroll
            for (int e = 0; e < 4; ++e) ss += acc[tm][tn][e] * acc[tm][tn][e];
          ss += __shfl_xor(ss, 16); ss = xsum32(ss);
          rsq[t2] = rsqrtf(ss * (1.f / 64.f) + EPS);
        }
#pragma unroll
        for (int t2 = 0; t2 < 2; ++t2) {
          const int tm = 2 * hf + t2, m = mw + 16 * tm + l15;
          u16* dst = dbase + head_row(m, head, isq ? 6 : 2) * 64 + g4;
#pragma unroll
          for (int tn = 0; tn < 2; ++tn) {
            float y1[4], y2[4];
#pragma unroll
            for (int e = 0; e < 4; ++e) {
              const float x1 = acc[tm][tn][e] * rsq[t2] * g1q[tn][e], x2 = acc[tm][tn + 2][e] * rsq[t2] * g2q[tn][e];
              y1[e] = (x1 * csq[t2][tn][e] - x2 * snq[t2][tn][e]) * osc; y2[e] = (x1 * snq[t2][tn][e] + x2 * csq[t2][tn][e]) * osc;
            }
            st4(dst + 16 * tn, y1[0], y1[1], y1[2], y1[3]); st4(dst + 32 + 16 * tn, y2[0], y2[1], y2[2], y2[3]);
          }
        }
      }
    } else if (n0w < 1536) {
      const int head = (n0w - 1408) >> 6;
      u16* dbase = (u16*)(p.ws + OFF_VS);
#pragma unroll
      for (int tm = 0; tm < 4; ++tm) {
        u16* dst = dbase + head_row(mw + 16 * tm + l15, head, 2) * 64 + g4;
#pragma unroll
        for (int tn = 0; tn < 4; ++tn) st4(dst + 16 * tn, acc[tm][tn][0], acc[tm][tn][1], acc[tm][tn][2], acc[tm][tn][3]);
      }
    }
    s = s2; mt = mt2; nt = nt2;
  }
  for (int it = blockIdx.x; it < 264; it += gridDim.x) {
    LdRows a2, b2;
#pragma unroll
    for (int j = 0; j < 4; ++j) a2.p[j] = H + (size_t)(it * 256 + lr + 64 * j) * 1024;
    b2.p[0] = W + (size_t)(1536 + (lr < 32 ? lr : 31)) * 1024; b2.p[1] = b2.p[2] = b2.p[3] = b2.p[0];
    f32x16 acc2[1][2]; zero_acc(acc2);
    __syncthreads();
    gemm_main<8, 1, 1, 2>(tid, lds + LDS_SCR, a2, b2, 16, acc2);
    u16* dst = proj + (size_t)(it * 256 + wid * 32 + r32) * PROJ_LD + 896;
#pragma unroll
    for (int rg = 0; rg < 4; ++rg) st4(dst + 8 * rg + 4 * hi, acc2[0][0][4 * rg], acc2[0][0][4 * rg + 1], acc2[0][0][4 * rg + 2], acc2[0][0][4 * rg + 3]);
  }
}

template <int NCOLS>
DI void lora_rstd(int tid, const u16* proj, int m0, int col0, float* scr) {
  constexpr int NCH = NCOLS / 64;
  const int sub = tid & 7, rs = tid >> 3;
  u32x4 w[4][NCH];
#pragma unroll
  for (int j = 0; j < 4; ++j) {
    const u16* src = proj + (size_t)(m0 + rs + 64 * j) * PROJ_LD + col0 + sub * 8;
#pragma unroll
    for (int c = 0; c < NCH; ++c) w[j][c] = *(const u32x4*)(src + c * 64);
  }
#pragma unroll
  for (int j = 0; j < 4; ++j) {
    float ss = 0.f;
#pragma unroll
    for (int c = 0; c < NCH; ++c)
#pragma unroll
      for (int e = 0; e < 4; ++e) { const float a = bflo(w[j][c][e]), b = bfhi(w[j][c][e]); ss += a * a + b * b; }
    ss += __shfl_xor(ss, 1); ss += __shfl_xor(ss, 2); ss += __shfl_xor(ss, 4);
    if (sub == 0) scr[rs + 64 * j] = rsqrtf(ss * (1.f / (float)NCOLS) + EPS);
  }
}

static __device__ __forceinline__ void phase_mla_prep(const P& p, int l, char* lds) {
  const int tid = otid(), lane = tid & 63, wid = tid >> 6, r32 = lane & 31, hi = lane >> 5, lr = tid >> 3;
  const u16* proj = (const u16*)(p.ws + OFF_PROJ);
  float* scr = (float*)lds;
  const float* cosA = (const float*)(p.ws + OFF_ROPE + ROPE_COSA); const float* sinA = (const float*)(p.ws + OFF_ROPE + ROPE_SINA);
  {
    const u16* W = wl(p, l) + W_UQ; const float* g = p.q_norm + l * 96; u16* Qm = (u16*)(p.ws + OFF_QM);
    const int wm = wid >> 1, wn = wid & 1;
    const float osc = 0.10206207261596577f * LOG2E;
    for (int s = 0, ns = tile_steps(264, 3, 32, 1); s < ns; ++s) {
      int mt, nt; if (!tile_get(s, 264, 3, 32, 1, mt, nt)) continue;
      const int m0 = mt * 256;
      __syncthreads();
      lora_rstd<384>(tid, proj, m0, 0, scr);
      LdRows al, bl;
#pragma unroll
      for (int j = 0; j < 4; ++j) al.p[j] = proj + (size_t)(m0 + lr + 64 * j) * PROJ_LD;
#pragma unroll
      for (int j = 0; j < 3; ++j) bl.p[j] = W + (size_t)(nt * 192 + lr + 64 * j) * 384;
      bl.p[3] = bl.p[0];
      f32x16 acc[2][3]; zero_acc(acc);
      gemm_main<4, 2, 2, 3>(tid, lds + LDS_SCR, al, bl, 6, acc);
      const int head = nt * 2 + wn;
#pragma unroll
      for (int tm = 0; tm < 2; ++tm) {
        const int rl = wm * 64 + 32 * tm + r32, m = m0 + rl;
        const float rlo = scr[rl];
        float ss = 0.f;
#pragma unroll
        for (int tn = 0; tn < 3; ++tn)
#pragma unroll
          for (int r = 0; r < 16; ++r) ss += acc[tm][tn][r] * acc[tm][tn][r];
        ss = xsum32(ss);
        const float f = rlo * rsqrtf(rlo * rlo * ss * (1.f / 96.f) + EPS);
        u16* dst = Qm + head_row(m, head, 6) * 96;
        const bool lat = m < MLAT; const int t = m & 8191;
        f32x4 gq[2][4], r1q[2], r2q[2], csq[2], snq[2];
#pragma unroll
        for (int tn = 0; tn < 2; ++tn)
#pragma unroll
          for (int rg = 0; rg < 4; ++rg) gq[tn][rg] = *(const f32x4*)(g + 32 * tn + 8 * rg + 4 * hi);
#pragma unroll
        for (int rg = 0; rg < 2; ++rg) {
          const int j = 8 * rg + 4 * hi; r1q[rg] = *(const f32x4*)(g + 64 + j); r2q[rg] = *(const f32x4*)(g + 80 + j);
          csq[rg] = f32x4{1.f, 1.f, 1.f, 1.f}; snq[rg] = f32x4{0.f, 0.f, 0.f, 0.f};
          if (lat) { csq[rg] = *(const f32x4*)(cosA + t * 16 + j); snq[rg] = *(const f32x4*)(sinA + t * 16 + j); }
        }
#pragma unroll
        for (int tn = 0; tn < 2; ++tn)
#pragma unroll
          for (int rg = 0; rg < 4; ++rg) {
            const int d = 32 * tn + 8 * rg + 4 * hi; const f32x4 gv = gq[tn][rg];
            st4(dst + d, acc[tm][tn][4 * rg] * f * gv[0] * osc, acc[tm][tn][4 * rg + 1] * f * gv[1] * osc, acc[tm][tn][4 * rg + 2] * f * gv[2] * osc, acc[tm][tn][4 * rg + 3] * f * gv[3] * osc);
          }
#pragma unroll
        for (int rg = 0; rg < 2; ++rg) {
          const int j = 8 * rg + 4 * hi; const f32x4 g1 = r1q[rg], g2 = r2q[rg], cs = csq[rg], sn = snq[rg];
          float y1[4], y2[4];
#pragma unroll
          for (int e = 0; e < 4; ++e) {
            const float x1 = acc[tm][2][4 * rg + e] * f * g1[e], x2 = acc[tm][2][8 + 4 * rg + e] * f * g2[e];
            y1[e] = (x1 * cs[e] - x2 * sn[e]) * osc; y2[e] = (x1 * sn[e] + x2 * cs[e]) * osc;
          }
          st4(dst + 64 + j, y1[0], y1[1], y1[2], y1[3]); st4(dst + 80 + j, y2[0], y2[1], y2[2], y2[3]);
        }
      }
    }
  }
  {
    const u16* W = wl(p, l) + W_UKV; const float* g = p.k_norm + l * 96; u16* Km = (u16*)(p.ws + OFF_KM); u16* Vm = (u16*)(p.ws + OFF_VM);
    for (int s = 0, ns = tile_steps(264, 6, 16, 2); s < ns; ++s) {
      int mt, head; if (!tile_get(s, 264, 6, 16, 2, mt, head)) continue;
      const int m0 = mt * 256;
      __syncthreads();
      lora_rstd<256>(tid, proj, m0, 384, scr);
      LdRows al, bl;
#pragma unroll
      for (int j = 0; j < 4; ++j) al.p[j] = proj + (size_t)(m0 + lr + 64 * j) * PROJ_LD + 384;
#pragma unroll
      for (int j = 0; j < 2; ++j) bl.p[j] = W + (size_t)(head * 128 + lr + 64 * j) * 256;
      bl.p[2] = bl.p[3] = bl.p[0];
      f32x16 acc[1][4]; zero_acc(acc);
      gemm_main<8, 1, 1, 4>(tid, lds + LDS_SCR, al, bl, 4, acc);
      const int rl = wid * 32 + r32, m = m0 + rl;
      const float rlo = scr[rl];
      float ssr = 0.f; u32x4 wx1, wx2;
      {
        const u16* kp = proj + (size_t)m * PROJ_LD + 896;
        const u32x4 w0 = *(const u32x4*)(kp), w1 = *(const u32x4*)(kp + 8), w2 = *(const u32x4*)(kp + 16), w3 = *(const u32x4*)(kp + 24);
#pragma unroll
        for (int e = 0; e < 4; ++e) {
          ssr += bflo(w0[e]) * bflo(w0[e]) + bfhi(w0[e]) * bfhi(w0[e]) + bflo(w1[e]) * bflo(w1[e]) + bfhi(w1[e]) * bfhi(w1[e]);
          ssr += bflo(w2[e]) * bflo(w2[e]) + bfhi(w2[e]) * bfhi(w2[e]) + bflo(w3[e]) * bflo(w3[e]) + bfhi(w3[e]) * bfhi(w3[e]);
        }
        wx1 = hi ? w1 : w0; wx2 = hi ? w3 : w2;
      }
      float ss = 0.f;
#pragma unroll
      for (int tn = 0; tn < 2; ++tn)
#pragma unroll
        for (int r = 0; r < 16; ++r) ss += acc[0][tn][r] * acc[0][tn][r];
      ss = xsum32(ss);
      const float rk = rsqrtf((rlo * rlo * ss + ssr) * (1.f / 96.f) + EPS);
      const size_t hr = head_row(m, head, 6);
      u16* kd = Km + hr * 96; u16* vd = Vm + hr * 64;
      const bool lat = m < MLAT; const int t = m & 8191;
      f32x4 gq[2][4]; float gr1[8], gr2[8], csr[8], snr[8];
#pragma unroll
      for (int tn = 0; tn < 2; ++tn)
#pragma unroll
        for (int rg = 0; rg < 4; ++rg) gq[tn][rg] = *(const f32x4*)(g + 32 * tn + 8 * rg + 4 * hi);
#pragma unroll
      for (int e = 0; e < 8; ++e) {
        const int j = 8 * hi + e; gr1[e] = g[64 + j]; gr2[e] = g[80 + j]; csr[e] = 1.f; snr[e] = 0.f;
        if (lat) { csr[e] = cosA[t * 16 + j]; snr[e] = sinA[t * 16 + j]; }
      }
#pragma unroll
      for (int tn = 0; tn < 2; ++tn)
#pragma unroll
        for (int rg = 0; rg < 4; ++rg) {
          const int d = 32 * tn + 8 * rg + 4 * hi; const f32x4 gv = gq[tn][rg]; const float f = rlo * rk;
          st4(kd + d, acc[0][tn][4 * rg] * f * gv[0], acc[0][tn][4 * rg + 1] * f * gv[1], acc[0][tn][4 * rg + 2] * f * gv[2], acc[0][tn][4 * rg + 3] * f * gv[3]);
          st4(vd + d, acc[0][2 + tn][4 * rg] * rlo, acc[0][2 + tn][4 * rg + 1] * rlo, acc[0][2 + tn][4 * rg + 2] * rlo, acc[0][2 + tn][4 * rg + 3] * rlo);
        }
      {
        float y1[8], y2[8];
#pragma unroll
        for (int e = 0; e < 8; ++e) {
          const int j = 8 * hi + e;
          const float k1 = (e & 1) ? bfhi(wx1[e >> 1]) : bflo(wx1[e >> 1]), k2 = (e & 1) ? bfhi(wx2[e >> 1]) : bflo(wx2[e >> 1]);
          const float x1 = k1 * rk * gr1[e], x2 = k2 * rk * gr2[e];
          const float cs = csr[e], sn = snr[e];
          y1[e] = x1 * cs - x2 * sn; y2[e] = x1 * sn + x2 * cs;
        }
        u32x4 w1 = {pk2(y1[0], y1[1]), pk2(y1[2], y1[3]), pk2(y1[4], y1[5]), pk2(y1[6], y1[7])};
        u32x4 w2 = {pk2(y2[0], y2[1]), pk2(y2[2], y2[3]), pk2(y2[4], y2[5]), pk2(y2[6], y2[7])};
        *(u32x4*)(kd + 64 + 8 * hi) = w1; *(u32x4*)(kd + 80 + 8 * hi) = w2;
      }
    }
  }
}

static __device__ __forceinline__ void phase_s5_states(const P& p, int l, char* lds) {
  const int tid = otid(), lane = tid & 63, wid = tid >> 6, r32 = lane & 31, hi = lane >> 5, wm = wid >> 1, wn = wid & 1, lr = tid >> 3;
  const u16* proj = (const u16*)(p.ws + OFF_PROJ); float* Sst = (float*)(p.ws + OFF_SST);
  for (int it = blockIdx.x; it < 160; it += gridDim.x) {
    const int g = it / 10, r = it % 10, mt = r >> 1, nt = r & 1;
    LdS5A al; LdRows bl;
#pragma unroll
    for (int j = 0; j < 4; ++j) { const int row = mt * 256 + lr + 64 * j; al.pu[j] = proj + (size_t)s5_tokbase(row < 1056 ? row : 0) * PROJ_LD + 640 + g * 16; al.ph[j] = al.pu[j]; }
    const u16* B = s5t(p, l) + S5_BST + (size_t)g * 256 * 1024;
#pragma unroll
    for (int j = 0; j < 2; ++j) bl.p[j] = B + (size_t)(nt * 128 + lr + 64 * j) * 1024;
    bl.p[2] = bl.p[3] = bl.p[0];
    f32x16 acc[2][2]; zero_acc(acc);
    __syncthreads();
    gemm_main<4, 2, 2, 2>(tid, lds + LDS_SCR, al, bl, 16, acc);
#pragma unroll
    for (int tm = 0; tm < 2; ++tm) {
      const int row = mt * 256 + wm * 64 + 32 * tm + r32;
      if (row < 1056) {
        float* dst = Sst + ((size_t)row * 16 + g) * 256 + nt * 128 + wn * 64;
#pragma unroll
        for (int tn = 0; tn < 2; ++tn)
#pragma unroll
          for (int rg = 0; rg < 4; ++rg) { f32x4 v = {acc[tm][tn][4 * rg], acc[tm][tn][4 * rg + 1], acc[tm][tn][4 * rg + 2], acc[tm][tn][4 * rg + 3]}; *(f32x4*)(dst + 32 * tn + 8 * rg + 4 * hi) = v; }
      }
    }
  }
}

static __device__ __forceinline__ void s5_scan_item(const P& p, int l, int blk) {
  const int gt = blk * NTHREADS + otid();
  const int pp = gt & 63, dir = (gt >> 6) & 1, g = (gt >> 7) & 15, b = gt >> 11;
  const dc a64d = ((const dc*)(p.ws + OFF_S5PW))[(size_t)((((l * 2 + dir) * 16 + g) * 64) + pp) * 65 + 64];
  const float ar = (float)a64d.re, ai = (float)a64d.im;
  const float* Sst = (const float*)(p.ws + OFF_SST); unsigned* Hin = (unsigned*)(p.ws + OFF_HIN);
  const int col = g * 256 + dir * 128 + 2 * pp;
  float hr = 0.f, hi_ = 0.f;
#pragma unroll 1
  for (int s0 = 0; s0 < 132; s0 += 4) {
    int rows[4]; f32x2 sv[4];
#pragma unroll
    for (int e = 0; e < 4; ++e) {
      const int st = s0 + e; int row;
      if (st < 4) { const int c = dir ? 3 - st : st; row = 1024 + b * 4 + c; } else { const int s2 = st - 4; const int c = dir ? 127 - s2 : s2; row = b * 128 + c; }
      rows[e] = row; sv[e] = *(const f32x2*)(Sst + (size_t)row * 4096 + col);
    }
#pragma unroll
    for (int e = 0; e < 4; ++e) {
      Hin[((size_t)rows[e] * 4096 + col) >> 1] = pk2(hr, hi_);
      const float nr = ar * hr - ai * hi_ + sv[e][0], ni = ar * hi_ + ai * hr + sv[e][1];
      hr = nr; hi_ = ni;
    }
  }
}

static __device__ __forceinline__ void phase_s5_out(const P& p, int l, char* lds) {
  const int tid = otid(), lane = tid & 63, wid = tid >> 6, r32 = lane & 31, hi = lane >> 5, wm = wid >> 1, wn = wid & 1, lr = tid >> 3;
  const u16* proj = (const u16*)(p.ws + OFF_PROJ); const u16* Hin = (const u16*)(p.ws + OFF_HIN); u16* zb = (u16*)(p.ws + OFF_ZB);
  const int per_g = l == NLAYER - 1 ? 32 : 40;
  for (int it = blockIdx.x; it < 16 * per_g; it += gridDim.x) {
    const int g = it / per_g, r = it % per_g, mt = r >> 3, nt = r & 7;
    LdS5A al; LdS5B bl;
#pragma unroll
    for (int j = 0; j < 4; ++j) {
      const int row = mt * 256 + lr + 64 * j;
      al.pu[j] = proj + (size_t)s5_tokbase(row < 1056 ? row : 0) * PROJ_LD + 640 + g * 16;
      al.ph[j] = Hin + ((size_t)(row < 1056 ? row : 0) * 16 + g) * 256;
    }
    const u16* Kc = s5t(p, l) + S5_KC + (size_t)g * 127 * 256; const u16* Mrd = s5t(p, l) + S5_MRD + (size_t)g * 1024 * 256;
#pragma unroll
    for (int j = 0; j < 2; ++j) { const int n = nt * 128 + lr + 64 * j; bl.pk[j] = Kc + ((n >> 4) + 63) * 256 + (n & 15) * 16; bl.pm[j] = Mrd + (size_t)n * 256; }
    f32x4 acc[4][4];
#pragma unroll
    for (int a_ = 0; a_ < 4; ++a_)
#pragma unroll
      for (int b_ = 0; b_ < 4; ++b_) acc[a_][b_] = f32x4{0.f, 0.f, 0.f, 0.f};
    __syncthreads();
    {
      u32x4 ra0[4], rb0[2], ra1[4], rb1[2];
      gemm_issue<4, 2>(tid, al, bl, 20, ra0, rb0, ra1, rb1);
      gemm_run16<false>(tid, lds + LDS_SCR, al, bl, 20, acc, ra0, rb0, ra1, rb1);
    }
#pragma unroll
    for (int tm = 0; tm < 4; ++tm) {
      const int row = mt * 256 + wm * 64 + 16 * tm + (lane & 15);
      if (row < 1056) {
        const int tb = s5_tokbase(row);
#pragma unroll
        for (int tn = 0; tn < 4; ++tn) {
          const int n = nt * 128 + wn * 64 + 16 * tn + 4 * (lane >> 4);
          u16* dst = zb + (size_t)(tb + (n >> 4)) * 256 + g * 16 + (n & 15);
          st4(dst, gelu_tanh(acc[tm][tn][0]), gelu_tanh(acc[tm][tn][1]), gelu_tanh(acc[tm][tn][2]), gelu_tanh(acc[tm][tn][3]));
        }
      }
    }
  }
}

static __device__ __forceinline__ void phase_glu(const P& p, int l, char* lds) {
  const int tid = otid(), lane = tid & 63, wid = tid >> 6, r32 = lane & 31, hi = lane >> 5, wm = wid >> 1, wn = wid & 1, lr = tid >> 3;
  const u16* zb = (const u16*)(p.ws + OFF_ZB); const u16* W = wl(p, l) + W_GLU; u16* mix = (u16*)(p.ws + OFF_MIX); const float* bg = p.b_glu + l * 256;
  const int MT = l == NLAYER - 1 ? 256 : 264;
  for (int s = 0, ns = tile_steps(MT, 2, 16, 2); s < ns; ++s) {
    int mt, nt; if (!tile_get(s, MT, 2, 16, 2, mt, nt)) continue;
    LdRows al, bl;
#pragma unroll
    for (int j = 0; j < 4; ++j) al.p[j] = zb + (size_t)(mt * 256 + lr + 64 * j) * 256;
#pragma unroll
    for (int j = 0; j < 2; ++j) bl.p[j] = W + (size_t)(nt * 128 + lr + 64 * j) * 256;
    bl.p[2] = bl.p[3] = bl.p[0];
    f32x16 acc[2][2]; zero_acc(acc);
    __syncthreads();
    gemm_main<4, 2, 2, 2>(tid, lds + LDS_SCR, al, bl, 4, acc);
    u32x2 zq[2][2][4]; f32x4 bq[2][4];
#pragma unroll
    for (int tn = 0; tn < 2; ++tn)
#pragma unroll
      for (int rg = 0; rg < 4; ++rg) {
        const int n = nt * 128 + wn * 64 + 32 * tn + 8 * rg + 4 * hi; bq[tn][rg] = *(const f32x4*)(bg + n);
#pragma unroll
        for (int tm = 0; tm < 2; ++tm) zq[tm][tn][rg] = *(const u32x2*)(zb + (size_t)(mt * 256 + wm * 64 + 32 * tm + r32) * 256 + n);
      }
#pragma unroll
    for (int tm = 0; tm < 2; ++tm) {
      const int m = mt * 256 + wm * 64 + 32 * tm + r32;
#pragma unroll
      for (int tn = 0; tn < 2; ++tn)
#pragma unroll
        for (int rg = 0; rg < 4; ++rg) {
          const int n = nt * 128 + wn * 64 + 32 * tn + 8 * rg + 4 * hi;
          const u32x2 zw = zq[tm][tn][rg]; const f32x4 bv = bq[tn][rg];
          const float z0 = bflo(zw[0]), z1 = bfhi(zw[0]), z2 = bflo(zw[1]), z3 = bfhi(zw[1]);
          st4(mix + (size_t)m * 1024 + 384 + n, z0 * sigmoid_f(acc[tm][tn][4 * rg] + bv[0]), z1 * sigmoid_f(acc[tm][tn][4 * rg + 1] + bv[1]), z2 * sigmoid_f(acc[tm][tn][4 * rg + 2] + bv[2]),
              z3 * sigmoid_f(acc[tm][tn][4 * rg + 3] + bv[3]));
        }
    }
  }
}

template <int DQK>
DI void attn_unit(int tid, char* lds, const u16* Qp, const u16* K1, const u16* V1, int nt1, int kpos0, const u16* K2, const u16* V2, int nt2, int qpos0, bool mask, float m_init, float l_init, u16* Op) {
  constexpr int KP = DQK * 2 + 16, KB = 64 * KP, VB = 8192, SB = KB + VB, NCH = DQK / 8, NKC = 64 * NCH, ND = DQK / 16;
  const int lane = tid & 63, wid = tid >> 6, r32 = lane & 31, hi = lane >> 5;
  bf16x8 qr[ND];
  {
    const u16* qrow = Qp + (size_t)(wid * 32 + r32) * DQK + hi * 8;
#pragma unroll
    for (int d0 = 0; d0 < ND; ++d0) qr[d0] = *(const bf16x8*)(qrow + d0 * 16);
  }
  const int kk0 = tid / NCH, kc0 = tid % NCH;
  const int id1 = tid + NTHREADS; const bool has1 = id1 < NKC; const int kk1 = id1 / NCH, kc1 = id1 % NCH;
  const int idl = has1 ? id1 : tid;
  const int vkey = tid >> 3, vc = tid & 7;
  const int vst = ((vkey >> 3) * 2 + (vc >> 2)) * 512 + (vkey & 7) * 64 + (vc & 3) * 16;
  const int vrb = ((lane & 3) << 3) | (((lane >> 2) & 3) << 6) | (((lane >> 4) & 1) << 5) | (((lane >> 5) & 1) << 8);
  const int kw0 = kk0 * KP + kc0 * 16, kw1 = kk1 * KP + kc1 * 16, kro = r32 * KP + hi * 16;
  f32x16 o0, o1;
#pragma unroll
  for (int r = 0; r < 16; ++r) { o0[r] = 0.f; o1[r] = 0.f; }
  constexpr float THR = 8.f;
  float mrun = m_init, lrun = hi == 0 ? l_init : 0.f;
  f32x16 negm;
#pragma unroll
  for (int r = 0; r < 16; ++r) negm[r] = -mrun;
  const int NT = nt1 + nt2;
  const int qpos = qpos0 + wid * 32 + r32;
  u32x4 sk0, sk1, sv;
  auto gl = [&](int i) {
    const u16* kp; const u16* vp;
    if (i < nt1) { kp = K1 + (size_t)i * 64 * DQK; vp = V1 + (size_t)i * 4096; } else { kp = K2 + (size_t)(i - nt1) * 64 * DQK; vp = V2 + (size_t)(i - nt1) * 4096; }
    sk0 = *(const u32x4*)(kp + (size_t)tid * 8); sk1 = *(const u32x4*)(kp + (size_t)idl * 8); sv = *(const u32x4*)(vp + (size_t)tid * 8);
  };
  auto sw = [&](int st) {
    char* b = lds + st * SB;
    *(u32x4*)(b + kw0) = sk0; if (has1) *(u32x4*)(b + kw1) = sk1; *(u32x4*)(b + KB + vst) = sv;
  };
  auto qk = [&](int st, f32x16& p0, f32x16& p1) {
    const char* Kb = lds + st * SB + kro;
#pragma unroll
    for (int d0 = 0; d0 < ND; ++d0) {
      const bf16x8 a0 = *(const bf16x8*)(Kb + d0 * 32);
      const bf16x8 a1 = *(const bf16x8*)(Kb + 32 * KP + d0 * 32);
      if (d0 == 0) { p0 = mfma(a0, qr[0], negm); p1 = mfma(a1, qr[0], negm); } else { p0 = mfma(a0, qr[d0], p0); p1 = mfma(a1, qr[d0], p1); }
    }
  };
  const int qw0 = qpos0 + wid * 32;
  auto live = [&](int i) { if (!mask || i >= nt1) return true; const int kb = kpos0 + i * 64; return kb + 63 >= qw0 - 128 && kb <= qw0 + 31 + 128; };
  auto step = [&](f32x16& c0, f32x16& c1, f32x16& n0, f32x16& n1, int i, int s_cur, int s_nxt, int s_wr) {
    const bool has_nxt = i + 1 < NT, has_wr = i + 2 < NT;
    if (has_wr) gl(i + 2);
    if (has_nxt && live(i + 1)) qk(s_nxt, n0, n1);
    if (live(i)) {
    if (mask && i < nt1) {
      const int kb = kpos0 + i * 64 - qpos;
#pragma unroll
      for (int r = 0; r < 16; ++r) {
        const int d0_ = kb + crow(r, hi), d1_ = d0_ + 32;
        if (d0_ > 128 || d0_ < -128) c0[r] = -1e30f;
        if (d1_ > 128 || d1_ < -128) c1[r] = -1e30f;
      }
    }
    float mt = c0[0];
#pragma unroll
    for (int r = 1; r < 16; ++r) mt = fmaxf(mt, c0[r]);
#pragma unroll
    for (int r = 0; r < 16; ++r) mt = fmaxf(mt, c1[r]);
    mt = xmax32(mt);
    if (__any(mt > THR)) {
      const float delta = fmaxf(mt, 0.f), alpha = ex2(-delta);
      mrun += delta; lrun *= alpha;
#pragma unroll
      for (int r = 0; r < 16; ++r) { o0[r] *= alpha; o1[r] *= alpha; c0[r] -= delta; c1[r] -= delta; n0[r] -= delta; n1[r] -= delta; negm[r] = -mrun; }
    }
    float ls = 0.f;
#pragma unroll
    for (int r = 0; r < 16; ++r) { c0[r] = ex2(c0[r]); c1[r] = ex2(c1[r]); ls += c0[r] + c1[r]; }
    lrun += ls;
    bf16x8 pb[4];
    { u32x4 w = {pk2(c0[0], c0[1]), pk2(c0[2], c0[3]), pk2(c0[4], c0[5]), pk2(c0[6], c0[7])}; pb[0] = __builtin_bit_cast(bf16x8, w); }
    { u32x4 w = {pk2(c0[8], c0[9]), pk2(c0[10], c0[11]), pk2(c0[12], c0[13]), pk2(c0[14], c0[15])}; pb[1] = __builtin_bit_cast(bf16x8, w); }
    { u32x4 w = {pk2(c1[0], c1[1]), pk2(c1[2], c1[3]), pk2(c1[4], c1[5]), pk2(c1[6], c1[7])}; pb[2] = __builtin_bit_cast(bf16x8, w); }
    { u32x4 w = {pk2(c1[8], c1[9]), pk2(c1[10], c1[11]), pk2(c1[12], c1[13]), pk2(c1[14], c1[15])}; pb[3] = __builtin_bit_cast(bf16x8, w); }
    LAS char* Vb = (LAS char*)(lds + s_cur * SB + KB + vrb);
#pragma unroll
    for (int ks = 0; ks < 4; ++ks) {
      const s16x4 l0 = __builtin_amdgcn_ds_read_tr16_b64_v4i16((LAS s16x4*)(Vb + ((2 * ks) * 2 + 0) * 512));
      const s16x4 h0 = __builtin_amdgcn_ds_read_tr16_b64_v4i16((LAS s16x4*)(Vb + ((2 * ks + 1) * 2 + 0) * 512));
      const s16x4 l1 = __builtin_amdgcn_ds_read_tr16_b64_v4i16((LAS s16x4*)(Vb + ((2 * ks) * 2 + 1) * 512));
      const s16x4 h1 = __builtin_amdgcn_ds_read_tr16_b64_v4i16((LAS s16x4*)(Vb + ((2 * ks + 1) * 2 + 1) * 512));
      const bf16x8 va0 = {l0[0], l0[1], l0[2], l0[3], h0[0], h0[1], h0[2], h0[3]};
      const bf16x8 va1 = {l1[0], l1[1], l1[2], l1[3], h1[0], h1[1], h1[2], h1[3]};
      o0 = mfma(va0, pb[ks], o0); o1 = mfma(va1, pb[ks], o1);
    }
    }
    if (has_wr) sw(s_wr);
    __syncthreads();
  };
  gl(0); sw(0);
  if (NT > 1) { gl(1); sw(1); }
  __syncthreads();
  f32x16 pA0, pA1, pB0, pB1;
#pragma unroll
  for (int r = 0; r < 16; ++r) { pB0[r] = 0.f; pB1[r] = 0.f; }
  if (live(0)) qk(0, pA0, pA1);
  int s_cur = 0, s_nxt = 1, s_wr = 2;
#pragma unroll 1
  for (int i = 0; i < NT; i += 2) {
    step(pA0, pA1, pB0, pB1, i, s_cur, s_nxt, s_wr);
    if (i + 1 >= NT) break;
    step(pB0, pB1, pA0, pA1, i + 1, s_nxt, s_wr, s_cur);
    const int t_ = s_cur; s_cur = s_wr; s_wr = s_nxt; s_nxt = t_;
  }
  const float inv = rcpf_(xsum32(lrun));
  u16* orow = Op + (size_t)(wid * 32 + r32) * 1024;
#pragma unroll
  for (int rg = 0; rg < 4; ++rg) {
    st4(orow + 8 * rg + 4 * hi, o0[4 * rg] * inv, o0[4 * rg + 1] * inv, o0[4 * rg + 2] * inv, o0[4 * rg + 3] * inv);
    st4(orow + 32 + 8 * rg + 4 * hi, o1[4 * rg] * inv, o1[4 * rg + 1] * inv, o1[4 * rg + 2] * inv, o1[4 * rg + 3] * inv);
  }
}

static __device__ __forceinline__ void phase_attn(const P& p, int l, char* lds) {
  if (blockIdx.x < 32) s5_scan_item(p, l, blockIdx.x);
  const int tid = otid();
  const u16* Qm = (const u16*)(p.ws + OFF_QM); const u16* Km = (const u16*)(p.ws + OFF_KM); const u16* Vm = (const u16*)(p.ws + OFF_VM);
  const u16* Qs = (const u16*)(p.ws + OFF_QS); const u16* Ks = (const u16*)(p.ws + OFF_KS); const u16* Vs = (const u16*)(p.ws + OFF_VS);
  u16* mix = (u16*)(p.ws + OFF_MIX);
  constexpr size_t CTX6 = (size_t)NBATCH * 6 * TLAT, CTX2 = (size_t)NBATCH * 2 * TLAT;
  const int nunits = l == NLAYER - 1 ? 3072 : 3168;
  for (int it = blockIdx.x; it < nunits; it += gridDim.x) {
    __syncthreads();
    if (it < 3072) {
      const int u = it < 1536 ? it : it - 1536;
      const int rr = u >> 8, bb = u & 255, bh = rr * 8 + (bb & 7), qb = bb >> 3, b = bh / 6, h = bh % 6, q0 = qb * 256;
      if (it < 1536) {
        const size_t r0 = (size_t)bh * TLAT, c0 = CTX6 + (size_t)bh * TCTX;
        attn_unit<96>(tid, lds, Qm + (r0 + q0) * 96, Km + r0 * 96, Vm + r0 * 64, 128, 0, Km + c0 * 96, Vm + c0 * 64, 4, q0, false, 0.f, 0.f, mix + (size_t)(b * TLAT + q0) * 1024 + h * 64);
      } else {
        const int kvh = h / 3, lo = q0 - 128 < 0 ? 0 : q0 - 128, hi_ = q0 + 384 > TLAT ? TLAT : q0 + 384;
        const size_t r0 = (size_t)(b * 2 + kvh) * TLAT, c0 = CTX2 + (size_t)(b * 2 + kvh) * TCTX;
        attn_unit<64>(tid, lds, Qs + ((size_t)bh * TLAT + q0) * 64, Ks + (r0 + lo) * 64, Vs + (r0 + lo) * 64, (hi_ - lo) >> 6, lo, Ks + c0 * 64, Vs + c0 * 64, 4, q0, true, p.sink[l * 6 + h] * LOG2E, 1.f,
                      mix + (size_t)(b * TLAT + q0) * 1024 + 640 + h * 64);
      }
    } else {
      const int u = it - 3072, ty = u / 48, bh = u % 48, b = bh / 6, h = bh % 6;
      if (ty == 0) {
        const size_t c0 = CTX6 + (size_t)bh * TCTX;
        attn_unit<96>(tid, lds, Qm + c0 * 96, Km + c0 * 96, Vm + c0 * 64, 4, 0, Km, Vm, 0, 0, false, 0.f, 0.f, mix + (size_t)(MLAT + b * TCTX) * 1024 + h * 64);
      } else {
        const int kvh = h / 3; const size_t c0 = CTX2 + (size_t)(b * 2 + kvh) * TCTX;
        attn_unit<64>(tid, lds, Qs + (CTX6 + (size_t)bh * TCTX) * 64, Ks + c0 * 64, Vs + c0 * 64, 4, 0, Ks, Vs, 0, 0, false, p.sink[l * 6 + h] * LOG2E, 1.f, mix + (size_t)(MLAT + b * TCTX) * 1024 + 640 + h * 64);
      }
    }
  }
}

static __device__ __forceinline__ void phase_resid_gemm(const P& p, int l, const u16* A, const u16* W, int ldk, int gate_off, char* lds, bool from_input = false) {
  const int tid = otid(), lane = tid & 63, wid = tid >> 6, r32 = lane & 31, hi = lane >> 5, wm = wid >> 1, wn = wid & 1, lr = tid >> 3;
  const int MT = l == NLAYER - 1 ? 256 : 264;
  const int ns = tile_steps(MT, 8, 4, 8), nk = ldk >> 6;
  u32x4 ra0[4], rb0[2], ra1[4], rb1[2];
  LdRows al, bl; int mt, nt;
  auto mk = [&](int mt_, int nt_, LdRows& a_, LdRows& b_) {
#pragma unroll
    for (int j = 0; j < 4; ++j) a_.p[j] = A + (size_t)(mt_ * 256 + lr + 64 * j) * ldk;
#pragma unroll
    for (int j = 0; j < 2; ++j) b_.p[j] = W + (size_t)(nt_ * 128 + lr + 64 * j) * ldk;
    b_.p[2] = b_.p[3] = b_.p[0];
  };
  int s = tile_next(0, ns, MT, 8, 4, 8, mt, nt);
  if (s >= 0) { mk(mt, nt, al, bl); gemm_issue<4, 2>(tid, al, bl, nk, ra0, rb0, ra1, rb1); }
  while (s >= 0) {
    f32x16 acc[2][2]; zero_acc(acc);
    __syncthreads();
    gemm_run<4, 2, 2, 2, true>(tid, lds + LDS_SCR, al, bl, nk, acc, ra0, rb0, ra1, rb1);
    int mt2 = 0, nt2 = 0; const int s2 = tile_next(s + 1, ns, MT, 8, 4, 8, mt2, nt2);
    if (s2 >= 0) { mk(mt2, nt2, al, bl); gemm_issue<4, 2>(tid, al, bl, nk, ra0, rb0, ra1, rb1); }
    float* xb = xrow(p, mt * 256); const float* gv = modv(p, l, modidx(mt * 256)) + gate_off;
#pragma unroll
    for (int tn = 0; tn < 2; ++tn) {
      const int n = nt * 128 + wn * 64 + 32 * tn + r32; const float g = gv[n];
      float* xp = xb + (size_t)(wm * 64 + 4 * hi) * DM + n;
      const float* xs = (from_input ? xin(p, mt * 256) : (const float*)xb) + (size_t)(wm * 64 + 4 * hi) * DM + n;
      float xv[2][16];
#pragma unroll
      for (int tm = 0; tm < 2; ++tm)
#pragma unroll
        for (int r = 0; r < 16; ++r) xv[tm][r] = __builtin_nontemporal_load(xs + (size_t)(32 * tm + (r & 3) + 8 * (r >> 2)) * DM);
#pragma unroll
      for (int tm = 0; tm < 2; ++tm)
#pragma unroll
        for (int r = 0; r < 16; ++r) xp[(size_t)(32 * tm + (r & 3) + 8 * (r >> 2)) * DM] = xv[tm][r] + g * acc[tm][tn][r];
    }
    s = s2; mt = mt2; nt = nt2;
  }
}

static __device__ __forceinline__ void phase_ffn_up(const P& p, int l, char* lds) {
  const int tid = otid(), lane = tid & 63, wid = tid >> 6, r32 = lane & 31, hi = lane >> 5, wm = wid >> 1, wn = wid & 1, lr = tid >> 3;
  const u16* H = (const u16*)(p.ws + OFF_H); const u16* W = wl(p, l) + W_UP; u16* act = (u16*)(p.ws + OFF_ACT);
  const float* cw = p.conv_w + (size_t)l * 3 * 5632; const float* cb = p.conv_b + (size_t)l * 5632;
  char* tile = lds + LDS_SCR;
  const int MEND = l == NLAYER - 1 ? MLAT : MTOT;
  const int RT = (MEND + 253) / 254;
  const int ns = tile_steps(RT, 44, 8, 4);
  u32x4 ra0[4], rb0[2], ra1[4], rb1[2];
  LdRows al, bl; int rt, nt;
  auto mk = [&](int rt_, int nt_, LdRows& a_, LdRows& b_) {
    const int ts_ = 254 * rt_ - 1;
#pragma unroll
    for (int j = 0; j < 4; ++j) { const int tt = ts_ + lr + 64 * j; a_.p[j] = (tt >= 0 && tt < MTOT) ? H + (size_t)tt * 1024 : (const u16*)(p.ws + OFF_ZERO); }
#pragma unroll
    for (int j = 0; j < 2; ++j) b_.p[j] = W + (size_t)(nt_ * 128 + lr + 64 * j) * 1024;
    b_.p[2] = b_.p[3] = b_.p[0];
  };
  int s = tile_next(0, ns, RT, 44, 8, 4, rt, nt);
  if (s >= 0) { mk(rt, nt, al, bl); gemm_issue<4, 2>(tid, al, bl, 16, ra0, rb0, ra1, rb1); }
  while (s >= 0) {
    const int tstart = 254 * rt - 1;
    f32x4 acc[4][4];
#pragma unroll
    for (int a_ = 0; a_ < 4; ++a_)
#pragma unroll
      for (int b_ = 0; b_ < 4; ++b_) acc[a_][b_] = f32x4{0.f, 0.f, 0.f, 0.f};
    __syncthreads();
    gemm_run16<false>(tid, lds + LDS_SCR, al, bl, 16, acc, ra0, rb0, ra1, rb1);
    int rt2 = 0, nt2 = 0; const int s2 = tile_next(s + 1, ns, RT, 44, 8, 4, rt2, nt2);
    if (s2 >= 0) { mk(rt2, nt2, al, bl); gemm_issue<4, 2>(tid, al, bl, 16, ra0, rb0, ra1, rb1); }
#pragma unroll
    for (int tm = 0; tm < 4; ++tm) {
      char* trow = tile + (wm * 64 + 16 * tm + (lane & 15)) * 528 + (wn * 64 + 4 * (lane >> 4)) * 4;
#pragma unroll
      for (int tn = 0; tn < 4; ++tn) *(f32x4*)(trow + 64 * tn) = acc[tm][tn];
    }
    __syncthreads();
    {
      const int cgp = tid & 7, wn2 = cgp >> 2, j0 = (cgp & 3) * 8;
      const int ca0 = nt * 64 + wn2 * 32 + j0;
      const int lca = (wn2 * 64 + j0) * 4, lcg = lca + 128;
      float wa0[8], wa1[8], wa2[8], ba[8], wg0[8], wg1[8], wg2[8], bg[8];
#pragma unroll
      for (int e = 0; e < 8; ++e) {
        wa0[e] = cw[ca0 + e]; wa1[e] = cw[5632 + ca0 + e]; wa2[e] = cw[2 * 5632 + ca0 + e]; ba[e] = cb[ca0 + e];
        wg0[e] = cw[DFF + ca0 + e]; wg1[e] = cw[5632 + DFF + ca0 + e]; wg2[e] = cw[2 * 5632 + DFF + ca0 + e]; bg[e] = cb[DFF + ca0 + e];
      }
#pragma unroll
      for (int jj = 0; jj < 4; ++jj) {
        const int r = (tid >> 3) + 64 * jj, tt = tstart + r;
        if (r >= 1 && r <= 254 && tt < MEND) {
          const int pos = tt < MLAT ? (tt & (TLAT - 1)) : ((tt - MLAT) & (TCTX - 1)), slen = tt < MLAT ? TLAT : TCTX;
          const float fm = pos == 0 ? 0.f : 1.f, fp = pos == slen - 1 ? 0.f : 1.f;
          const char* rp = tile + r * 528;
          float o[8];
#pragma unroll
          for (int hf = 0; hf < 2; ++hf) {
            const f32x4 am = *(const f32x4*)(rp - 528 + lca + hf * 16), a0 = *(const f32x4*)(rp + lca + hf * 16), ap = *(const f32x4*)(rp + 528 + lca + hf * 16);
            const f32x4 gm = *(const f32x4*)(rp - 528 + lcg + hf * 16), g0 = *(const f32x4*)(rp + lcg + hf * 16), gp = *(const f32x4*)(rp + 528 + lcg + hf * 16);
#pragma unroll
            for (int e = 0; e < 4; ++e) {
              const int q = hf * 4 + e;
              const float ua = wa0[q] * (fm * am[e]) + wa1[q] * a0[e] + wa2[q] * (fp * ap[e]) + ba[q];
              const float ug = wg0[q] * (fm * gm[e]) + wg1[q] * g0[e] + wg2[q] * (fp * gp[e]) + bg[q];
              o[q] = silu_f(ug) * ua;
            }
          }
          u32x4 w = {pk2(o[0], o[1]), pk2(o[2], o[3]), pk2(o[4], o[5]), pk2(o[6], o[7])};
          *(u32x4*)(act + (size_t)tt * DFF + ca0) = w;
        }
      }
    }
    s = s2; rt = rt2; nt = nt2;
  }
}

#define XB_TMO      128
#define XB_XCNT(j)  (256  + 64 * (j))
#define XB_XSUB(j)  (1280 + 64 * (j))
#define XB_XGEN(j)  (2304 + 64 * (j))
#define XB_TOP      3328
#define XB_TOPGEN   3392
#define XCD_BAR_WORDS 3456
#define XB_SPIN_CAP (1u << 24)
DI unsigned xb_ld(unsigned* p) { return __hip_atomic_load(p, __ATOMIC_RELAXED, __HIP_MEMORY_SCOPE_AGENT); }
DI unsigned xb_add(unsigned* p, unsigned v) { return __hip_atomic_fetch_add(p, v, __ATOMIC_RELAXED, __HIP_MEMORY_SCOPE_AGENT); }
DI unsigned xb_xcc_id() { return (unsigned)__builtin_amdgcn_s_getreg((3 << 11) | 20) & 0xFu; }
#define XB_SPIN(cond, bar) do { unsigned _sp = 0; while (cond) { __builtin_amdgcn_s_sleep(1); \
    if ((++_sp & 255u) == 0u) { if (xb_ld(&(bar)[XB_TMO])) break; if (_sp > XB_SPIN_CAP) { atomicAdd(&(bar)[XB_TMO], 1u); break; } } } } while (0)
struct XcdBarrier { unsigned* bar; unsigned x; volatile LAS unsigned* st; };
DI XcdBarrier xcd_barrier_post(unsigned* bar, volatile LAS unsigned* st) {
  XcdBarrier b; b.bar = bar; b.x = xb_xcc_id(); b.st = st;
  if (threadIdx.x == 0) (void)xb_add(&bar[XB_XCNT(b.x)], 1u);
  return b;
}
DI void xcd_barrier_complete(unsigned* bar, unsigned x, unsigned& nloc, unsigned& nx) {
  const unsigned G = gridDim.x * gridDim.y * gridDim.z;
  unsigned sum, cnt, mine, sp = 0u;
  for (;;) {
    sum = 0u; cnt = 0u; mine = 0u;
#pragma unroll
    for (unsigned j = 0; j < 16; ++j) { const unsigned c = xb_ld(&bar[XB_XCNT(j)]); sum += c; cnt += (c > 0u) ? 1u : 0u; mine = (j == x) ? c : mine; }
    if (sum == G) break;
    __builtin_amdgcn_s_sleep(1);
    if ((++sp & 255u) == 0u) { if (xb_ld(&bar[XB_TMO])) break; if (sp > XB_SPIN_CAP) { atomicAdd(&bar[XB_TMO], 1u); break; } }
  }
  nloc = mine > 0u ? mine : 1u; nx = cnt > 0u ? cnt : 1u;
}
DI void xcd_barrier(const XcdBarrier& b) {
  asm volatile("s_waitcnt vmcnt(0)" ::: "memory");
  __syncthreads();
  if (threadIdx.x == 0) {
    unsigned* bar = b.bar;
    __builtin_amdgcn_s_waitcnt(0);
    unsigned nloc = b.st[0], nx = b.st[1];
    if (nloc == 0u) { xcd_barrier_complete(bar, b.x, nloc, nx); b.st[0] = nloc; b.st[1] = nx; }
    const unsigned old = xb_add(&bar[XB_XSUB(b.x)], 1u);
    const unsigned gen = old / nloc;
    if (old + 1u == (gen + 1u) * nloc) {
      __builtin_amdgcn_fence(__ATOMIC_RELEASE, "agent");
      asm volatile("s_waitcnt vmcnt(0)" ::: "memory");
      const unsigned og = xb_add(&bar[XB_TOP], 1u);
      const unsigned tg = og / nx;
      if (og + 1u == (tg + 1u) * nx) xb_add(&bar[XB_TOPGEN], 1u);
      else XB_SPIN(xb_ld(&bar[XB_TOPGEN]) == tg, bar);
      __builtin_amdgcn_fence(__ATOMIC_ACQUIRE, "agent");
      xb_add(&bar[XB_XGEN(b.x)], 1u);
      asm volatile("s_waitcnt vmcnt(0)" ::: "memory");
    } else {
      XB_SPIN(xb_ld(&bar[XB_XGEN(b.x)]) == gen, bar);
      __builtin_amdgcn_fence(__ATOMIC_ACQUIRE, "agent");
      asm volatile("s_waitcnt vmcnt(0)" ::: "memory");
    }
  }
  __syncthreads();
}

__global__ void __launch_bounds__(NTHREADS) fwd_kernel(P p) {
  extern __shared__ __attribute__((aligned(16))) char lds_raw[];
  char* lds = lds_raw + LDS_FRONT;
  cg::grid_group grid = cg::this_grid();
  if (threadIdx.x == 0) *(u32x4*)lds_raw = u32x4{0u, 0u, 0u, 0u};
  __syncthreads();
  (void)xcd_barrier_post((unsigned*)(p.ws + OFF_BAR), (volatile LAS unsigned*)lds_raw);
#define GBAR() do { XcdBarrier xb_; xb_.bar = (unsigned*)(p.ws + OFF_BAR); xb_.x = xb_xcc_id(); xb_.st = (volatile LAS unsigned*)lds_raw; xcd_barrier(xb_); } while (0)
  phase_pre(p);
  grid.sync();
  phase0(p, lds);
  GBAR();
  for (int l = 0; l < NLAYER; ++l) {
    phase_norm(p, l, 0);
    GBAR();
    phase_inproj(p, l, lds);
    GBAR();
    phase_mla_prep(p, l, lds);
    phase_s5_states(p, l, lds);
    GBAR();
    phase_attn(p, l, lds);
    GBAR();
    phase_s5_out(p, l, lds);
    GBAR();
    phase_glu(p, l, lds);
    GBAR();
    phase_resid_gemm(p, l, (const u16*)(p.ws + OFF_MIX), wl(p, l) + W_OUT, 1024, 2048, lds, l == 0);
    GBAR();
    phase_norm(p, l, 1);
    GBAR();
    phase_ffn_up(p, l, lds);
    GBAR();
    phase_resid_gemm(p, l, (const u16*)(p.ws + OFF_ACT), wl(p, l) + W_DN, DFF, 5120, lds);
    GBAR();
  }
}

extern "C" void kernel_launch(void* const* d_in, const int* in_sizes, int n_in, void* d_out, int out_size, void* d_ws, size_t ws_size, hipStream_t stream) {
  static int grid_blocks = 0;
  if (!grid_blocks) {
    if (ws_size < WS_NEED) { fprintf(stderr, "kernel_launch: workspace too small: %zu < %zu\n", ws_size, (size_t)WS_NEED); return; }
    if (hipFuncSetAttribute((const void*)fwd_kernel, hipFuncAttributeMaxDynamicSharedMemorySize, LDS_TOTAL) != hipSuccess) { fprintf(stderr, "kernel_launch: LDS attribute failed\n"); return; }
    int dev = 0, cus = 0, per_cu = 0;
    hipGetDevice(&dev);
    hipDeviceGetAttribute(&cus, hipDeviceAttributeMultiprocessorCount, dev);
    hipOccupancyMaxActiveBlocksPerMultiprocessor(&per_cu, fwd_kernel, NTHREADS, LDS_TOTAL);
    if (per_cu < 1) { fprintf(stderr, "kernel_launch: occupancy 0\n"); return; }
    grid_blocks = cus;
  }
  P p{};
  const float** fp = (const float**)&p;
  for (int i = 0; i < 33; ++i) fp[i] = (const float*)d_in[i];
  p.out = (float*)d_out; p.ws = (char*)d_ws;
  (void)hipMemsetAsync((char*)d_ws + OFF_BAR, 0, XCD_BAR_WORDS * 4, stream);
  void* args[] = {&p};
  hipError_t e = hipLaunchCooperativeKernel((void*)fwd_kernel, dim3(grid_blocks), dim3(NTHREADS), args, LDS_TOTAL, stream);
  if (e != hipSuccess) fprintf(stderr, "cooperative launch failed: %s (grid %d)\n", hipGetErrorString(e), grid_blocks);
}
```
